# Optimizing an MI355X kernel written in HIP

```python
import jax
import jax.numpy as jnp
from jax import lax
import numpy as np

D_MODEL = 1024
BATCH = 8
SEQ = 4096
DEPTH = 2
DEC_BATCH = 32
DEC_SEQ = 32
PAST_LEN = 1024

CHUNK = 64
N_MIXERS = 2
N_ATTN_LAYERS = (DEPTH + 1) // 2
N_DN_LAYERS = DEPTH // 2
EPS = 1e-6
F32 = jnp.float32

WINDOW = 128
WIN_CHUNKS = WINDOW // CHUNK
ATTN_CACHE = WINDOW
N_HEADS = 16
N_KV_HEADS = 4
HEAD_DIM = 64
GQA_GROUP = N_HEADS // N_KV_HEADS
ATTN_WIDTH = N_HEADS * HEAD_DIM
KV_WIDTH = N_KV_HEADS * HEAD_DIM
ATTN_IN = 2 * ATTN_WIDTH + 2 * KV_WIDTH

DN_HEADS = 8
DN_KEY_DIM = 128
DN_VAL_DIM = 128
DN_QK_WIDTH = DN_HEADS * DN_KEY_DIM
DN_V_WIDTH = DN_HEADS * DN_VAL_DIM
DN_CONV_DIM = 2 * DN_QK_WIDTH + DN_V_WIDTH
CONV_WIDTH = 4
DN_IN = DN_CONV_DIM + DN_V_WIDTH + 2 * DN_HEADS

kernel_name = 'chunk_causal_swa_sink_gated_deltanet_hybrid_step'


def rmsnorm(x, g):
    xf = x.astype(F32)
    y = xf * lax.rsqrt(jnp.mean(xf * xf, axis=-1, keepdims=True) + EPS) * g.astype(F32)
    return y.astype(x.dtype)


def l2norm(x):
    return x * lax.rsqrt(jnp.sum(x * x, axis=-1, keepdims=True) + EPS)


def alibi_slopes():
    return 2.0 ** (-8.0 * jnp.arange(1, N_HEADS + 1, dtype=F32) / N_HEADS)


def sink_attention(q, k, v, q_pos, k_pos, k_valid, sinks):
    s = jnp.einsum('bnqkgd,bnskd->bnkgqs', q.astype(F32), k.astype(F32)) * (HEAD_DIM ** -0.5)
    slopes = alibi_slopes().reshape(N_KV_HEADS, GQA_GROUP, 1, 1)
    dist = jnp.abs(q_pos[:, :, None] - k_pos[:, None, :])
    s = s - slopes * dist[:, None, None]
    s = jnp.where(k_valid[:, None, None, None, :], s, -jnp.inf)
    sink = sinks.astype(F32).reshape(N_KV_HEADS, GQA_GROUP, 1, 1)
    m = jnp.maximum(jnp.max(s, axis=-1, keepdims=True), sink)
    p = jnp.exp(s - m)
    den = jnp.sum(p, axis=-1, keepdims=True) + jnp.exp(sink - m)
    return jnp.einsum('bnkgqs,bnskd->bnqkgd', p / den, v.astype(F32))


def attn_project(h, w_in):
    B, L, _ = h.shape
    q, k, v, gate = jnp.split(h @ w_in, [ATTN_WIDTH, ATTN_WIDTH + KV_WIDTH, ATTN_WIDTH + 2 * KV_WIDTH], axis=-1)
    return (q.reshape(B, L, N_KV_HEADS, GQA_GROUP, HEAD_DIM),
            k.reshape(B, L, N_KV_HEADS, HEAD_DIM),
            v.reshape(B, L, N_KV_HEADS, HEAD_DIM), gate)


def attn_prompt(h, w_in, sinks, w_out):
    B, L, _ = h.shape
    nc = L // CHUNK
    q, k, v, gate = attn_project(h, w_in)

    def band(t):
        tc = t.reshape(B, nc, CHUNK, N_KV_HEADS, HEAD_DIM)
        tp = jnp.pad(tc, ((0, 0), (WIN_CHUNKS, 0), (0, 0), (0, 0), (0, 0)))
        return jnp.concatenate([tp[:, j:j + nc] for j in range(WIN_CHUNKS + 1)], axis=2)

    qb = q.reshape(B, nc, CHUNK, N_KV_HEADS, GQA_GROUP, HEAD_DIM)
    q_pos = (jnp.arange(nc)[:, None] * CHUNK + jnp.arange(CHUNK)[None, :]).astype(F32)
    k_pos = (jnp.arange(nc)[:, None] - WIN_CHUNKS) * CHUNK + jnp.arange((WIN_CHUNKS + 1) * CHUNK)[None, :]
    o = sink_attention(qb, band(k), band(v), q_pos, k_pos.astype(F32), k_pos >= 0, sinks)
    o = o.reshape(B, L, ATTN_WIDTH).astype(h.dtype)
    y = (o * jax.nn.silu(gate)) @ w_out
    return y, k[:, L - ATTN_CACHE:], v[:, L - ATTN_CACHE:]


def attn_sample(h, cache_k, cache_v, w_in, sinks, w_out):
    B, T, _ = h.shape
    C = cache_k.shape[1]
    q, k, v, gate = attn_project(h, w_in)
    k_all = jnp.concatenate([cache_k.astype(k.dtype), k], axis=1)
    v_all = jnp.concatenate([cache_v.astype(v.dtype), v], axis=1)
    q_pos = (PAST_LEN + jnp.arange(T))[None, :].astype(F32)
    k_pos = (PAST_LEN - C + jnp.arange(C + T))[None, :].astype(F32)
    valid = jnp.ones((1, C + T), dtype=bool)
    o = sink_attention(q[:, None], k_all[:, None], v_all[:, None], q_pos, k_pos, valid, sinks)
    o = o.reshape(B, T, ATTN_WIDTH).astype(h.dtype)
    y = (o * jax.nn.silu(gate)) @ w_out
    return y, k_all[:, T:], v_all[:, T:]


def causal_conv(x, hist, w):
    L = x.shape[1]
    xp = jnp.concatenate([hist.astype(x.dtype), x], axis=1)
    y = sum(xp[:, j:j + L] * w[j] for j in range(CONV_WIDTH))
    return jax.nn.silu(y), xp[:, L:]


def gated_delta_chunked(q, k, v, g, beta, s0, chunk):
    B, L, H, dk = q.shape
    dv = v.shape[-1]
    n = L // chunk
    blk4 = lambda t: t.reshape(B, n, chunk, H, t.shape[-1]).transpose(0, 1, 3, 2, 4)
    q, k, v = blk4(q), blk4(k), blk4(v)
    g = g.reshape(B, n, chunk, H).transpose(0, 1, 3, 2)
    beta = beta.reshape(B, n, chunk, H).transpose(0, 1, 3, 2)
    gc = jnp.cumsum(g, axis=-1)
    tri = jnp.tril(jnp.ones((chunk, chunk), dtype=bool))
    strict = jnp.tril(jnp.ones((chunk, chunk), dtype=bool), -1)
    decay = jnp.exp(jnp.where(tri, gc[..., :, None] - gc[..., None, :], -jnp.inf))
    kb = k * beta[..., None]
    vb = v * beta[..., None]
    m = jnp.where(strict, jnp.einsum('bnhid,bnhjd->bnhij', kb, k) * decay, 0.0)
    a = m + jnp.eye(chunk, dtype=F32)
    rhs = jnp.concatenate([vb, kb * jnp.exp(gc)[..., None]], axis=-1)
    sol = lax.linalg.triangular_solve(a, rhs, left_side=True, lower=True, unit_diagonal=True)
    u, w = sol[..., :dv], sol[..., dv:]
    intra = jnp.where(tri, jnp.einsum('bnhid,bnhjd->bnhij', q, k) * decay, 0.0)

    def step(s, xs):
        qi, ki, ui, wi, gi, ai = xs
        v_new = ui - jnp.einsum('bhcd,bhde->bhce', wi, s)
        o = jnp.einsum('bhcd,bhde->bhce', qi * jnp.exp(gi)[..., None], s) + jnp.einsum('bhij,bhje->bhie', ai, v_new)
        g_last = gi[..., -1]
        s = s * jnp.exp(g_last)[..., None, None] + jnp.einsum(
            'bhcd,bhce->bhde', ki * jnp.exp(g_last[..., None] - gi)[..., None], v_new)
        return s, o

    xs = tuple(jnp.moveaxis(t, 1, 0) for t in (q, k, u, w, gc, intra))
    s_fin, o = lax.scan(step, s0, xs)
    o = o.transpose(1, 0, 3, 2, 4).reshape(B, L, H, dv)
    return o, s_fin


def deltanet_branch(h, conv_hist, s0, w_in, conv_w, a_log, dt_bias, norm_g, w_out):
    B, L, _ = h.shape
    qkv, z, b, a = jnp.split(h @ w_in, [DN_CONV_DIM, DN_CONV_DIM + DN_V_WIDTH, DN_CONV_DIM + DN_V_WIDTH + DN_HEADS], axis=-1)
    qkv, new_hist = causal_conv(qkv, conv_hist, conv_w)
    q, k, v = jnp.split(qkv.astype(F32), [DN_QK_WIDTH, 2 * DN_QK_WIDTH], axis=-1)
    q = l2norm(q.reshape(B, L, DN_HEADS, DN_KEY_DIM)) * (DN_KEY_DIM ** -0.5)
    k = l2norm(k.reshape(B, L, DN_HEADS, DN_KEY_DIM))
    v = v.reshape(B, L, DN_HEADS, DN_VAL_DIM)
    beta = jax.nn.sigmoid(b.astype(F32))
    g = -jnp.exp(a_log.astype(F32)) * jax.nn.softplus(a.astype(F32) + dt_bias.astype(F32))
    o, s_new = gated_delta_chunked(q, k, v, g, beta, s0.astype(F32), min(CHUNK, L))
    o = rmsnorm(o, norm_g) * jax.nn.silu(z.astype(F32).reshape(B, L, DN_HEADS, DN_VAL_DIM))
    o = o.reshape(B, L, DN_V_WIDTH).astype(h.dtype)
    return o @ w_out, new_hist, s_new.astype(s0.dtype)


def setup_inputs(seed: int = 0) -> dict:
    key = jax.random.key(seed)
    ks = jax.random.split(key, 20)
    nrm = lambda k, shape, scale: scale * jax.random.normal(k, shape, F32)
    dt = jnp.exp(jax.random.uniform(ks[15], (N_DN_LAYERS, DN_HEADS), F32, np.log(1e-3), np.log(1e-1)))
    return {
        'x_prompt': nrm(ks[0], (BATCH, SEQ, D_MODEL), 1.0),
        'x_sample': nrm(ks[1], (DEC_BATCH, DEC_SEQ, D_MODEL), 1.0),
        'cache_k': nrm(ks[2], (N_ATTN_LAYERS, DEC_BATCH, min(WINDOW, PAST_LEN), N_KV_HEADS, HEAD_DIM), 1.0),
        'cache_v': nrm(ks[3], (N_ATTN_LAYERS, DEC_BATCH, min(WINDOW, PAST_LEN), N_KV_HEADS, HEAD_DIM), 1.0),
        'state_conv': nrm(ks[4], (N_DN_LAYERS, DEC_BATCH, CONV_WIDTH - 1, DN_CONV_DIM), 1.0),
        'state_ssm': nrm(ks[5], (N_DN_LAYERS, DEC_BATCH, DN_HEADS, DN_KEY_DIM, DN_VAL_DIM), 0.1),
        'norm_g': 1.0 + nrm(ks[6], (DEPTH, D_MODEL), 0.02),
        'final_norm_g': 1.0 + nrm(ks[7], (D_MODEL,), 0.02),
        'attn_w_in': nrm(ks[8], (N_ATTN_LAYERS, D_MODEL, ATTN_IN), D_MODEL ** -0.5),
        'attn_sinks': nrm(ks[9], (N_ATTN_LAYERS, N_HEADS), 0.5),
        'attn_w_out': nrm(ks[10], (N_ATTN_LAYERS, ATTN_WIDTH, D_MODEL), ATTN_WIDTH ** -0.5),
        'dn_w_in': nrm(ks[11], (N_DN_LAYERS, D_MODEL, DN_IN), D_MODEL ** -0.5),
        'dn_conv_w': nrm(ks[12], (N_DN_LAYERS, CONV_WIDTH, DN_CONV_DIM), CONV_WIDTH ** -0.5),
        'dn_a_log': jnp.log(jax.random.uniform(ks[13], (N_DN_LAYERS, DN_HEADS), F32, 1.0, 16.0)),
        'dn_dt_bias': dt + jnp.log(-jnp.expm1(-dt)),
        'dn_norm_g': 1.0 + nrm(ks[14], (N_DN_LAYERS, DN_VAL_DIM), 0.02),
        'dn_w_out': nrm(ks[16], (N_DN_LAYERS, DN_V_WIDTH, D_MODEL), DN_V_WIDTH ** -0.5),
    }


def reference(x_prompt, x_sample, cache_k, cache_v, state_conv, state_ssm, norm_g, final_norm_g,
              attn_w_in, attn_sinks, attn_w_out, dn_w_in, dn_conv_w, dn_a_log, dn_dt_bias,
              dn_norm_g, dn_w_out):
    xp, xs = x_prompt, x_sample
    kp_l, vp_l, cp_l, sp_l = [], [], [], []
    ks_l, vs_l, cs_l, ss_l = [], [], [], []
    for i in range(DEPTH):
        hp = rmsnorm(xp, norm_g[i])
        hs = rmsnorm(xs, norm_g[i])
        j = i // N_MIXERS
        if i % N_MIXERS == 0:
            yp, kp, vp = attn_prompt(hp, attn_w_in[j], attn_sinks[j], attn_w_out[j])
            ys, kd, vd = attn_sample(hs, cache_k[j], cache_v[j], attn_w_in[j], attn_sinks[j], attn_w_out[j])
            kp_l.append(kp); vp_l.append(vp); ks_l.append(kd); vs_l.append(vd)
        else:
            hist0 = jnp.zeros((hp.shape[0], CONV_WIDTH - 1, DN_CONV_DIM), hp.dtype)
            s00 = jnp.zeros((hp.shape[0], DN_HEADS, DN_KEY_DIM, DN_VAL_DIM), state_ssm.dtype)
            yp, cp, sp = deltanet_branch(hp, hist0, s00, dn_w_in[j], dn_conv_w[j], dn_a_log[j],
                                         dn_dt_bias[j], dn_norm_g[j], dn_w_out[j])
            ys, cd, sd = deltanet_branch(hs, state_conv[j], state_ssm[j], dn_w_in[j], dn_conv_w[j],
                                         dn_a_log[j], dn_dt_bias[j], dn_norm_g[j], dn_w_out[j])
            cp_l.append(cp); sp_l.append(sp); cs_l.append(cd); ss_l.append(sd)
        xp = xp + yp
        xs = xs + ys
    y_prompt = rmsnorm(xp, final_norm_g)
    y_sample = rmsnorm(xs, final_norm_g)
    return (y_prompt, y_sample,
            jnp.stack(kp_l), jnp.stack(vp_l), jnp.stack(cp_l), jnp.stack(sp_l),
            jnp.stack(ks_l), jnp.stack(vs_l), jnp.stack(cs_l), jnp.stack(ss_l))
```

```cpp
#include <hip/hip_runtime.h>
#include <hip/hip_cooperative_groups.h>
#include <cstdio>
#include <cstdint>
namespace cg = cooperative_groups;
namespace pg8 {
#define PG8_LAS __attribute__((address_space(3)))
typedef unsigned short bf16_t;
typedef short bf16x8 __attribute__((ext_vector_type(8)));
typedef float f32x4 __attribute__((ext_vector_type(4)));
typedef unsigned u32x4 __attribute__((ext_vector_type(4)));
constexpr int BM = 256, BK = 64, HALF = 128, HTB = HALF * BK * 2  , STAGE_BYTES = 8 * HTB, NXCD = 8, WGM = 8;

__host__ __device__ __forceinline__ int lds_byte(int r, int c) { const int st = (r >> 4) * 2 + (c >> 5), rr = r & 15, cc = c & 31, ob = rr * 64 + cc * 2; return st * 1024 + (ob ^ (((ob >> 9) & 1) << 5)); }
__host__ __device__ __forceinline__ void stage_rc(int b, int& R, int& C) { const int st = b / 1024, sb = b % 1024, swz = sb ^ (((sb >> 9) & 1) << 5); R = (st >> 1) * 16 + swz / 64; C = (st & 1) * 32 + (swz % 64) / 2; }
__host__ __device__ __forceinline__ int perm32(int rho) { const int n = rho >> 4, i = rho & 15; return 8 * (i >> 2) + 4 * n + (i & 3); }

struct Unit { int pm, pn; };
struct Gemm { const bf16_t* A; const bf16_t* Bt; int M, N, K; };

struct StaticOrder {
    int nM, nN, nwg, G, c;
    __host__ __device__ void init(int M, int N, int G_, int c_) { nM = M / BM; nN = N / BM; nwg = nM * nN; G = G_; c = c_; }
    __host__ __device__ bool next(int i, Unit& u) const {
        const long L = (long)i * G + c; if (L >= nwg) return false;
        int wgid = (int)L; { const int q = nwg / NXCD, r = nwg % NXCD, xcd = wgid % NXCD, off = wgid / NXCD; wgid = (xcd < r ? xcd * (q + 1) : r * (q + 1) + (xcd - r) * q) + off; }
        const int nig = WGM * nN, gid = wgid / nig, fm = gid * WGM, gsz = (nM - fm) < WGM ? (nM - fm) : WGM;
        u.pm = fm + ((wgid % nig) % gsz); u.pn = (wgid % nig) / gsz; return true;
    }
    __device__ __forceinline__ void a_ready(const Unit&) const {}
    __device__ __forceinline__ void done(const Unit&) const {}
};

__device__ __forceinline__ unsigned cvt_pk_bf16(float lo, float hi) { unsigned r; asm volatile("v_cvt_pk_bf16_f32 %0, %1, %2" : "=v"(r) : "v"(lo), "v"(hi)); return r; }

template <class Epi, class Sched, bool ALIGN_EPI = false, bool SP2 = false>
__device__ __forceinline__ void gemm_phase(PG8_LAS unsigned char* lds, const Gemm g, const Sched& S, const Epi& E) {
    const int tid = threadIdx.x, wid = __builtin_amdgcn_readfirstlane(tid >> 6), lane = tid & 63, wr = wid >> 2, wc = wid & 3, fr = lane & 15, fq = lane >> 4;
    const int K = g.K, nt = K / BK;
    unsigned voffA[2], voffB[2];
#pragma unroll
    for (int i = 0; i < 2; ++i) { int R, C; stage_rc(tid * 16 + i * 8192, R, C); const int Rb = Epi::PERM ? ((R & ~31) + perm32(R & 31)) : R;
        voffA[i] = (unsigned)(R * K + C) * 2u; voffB[i] = (unsigned)(Rb * K + C) * 2u; }
    const size_t kstep = (size_t)(BK * 2);
    const size_t hstep = (size_t)HALF * K * 2;
    const size_t tstep = 2 * hstep;
    const unsigned ldsw = (unsigned)wid * 1024u;
    const int aoff = lds_byte(wr * 64 + fr, fq * 8), boff = lds_byte(wc * 32 + fr, fq * 8);
#define PG8_SA(b, h) (((b) * 2 + (h)) * HTB)
#define PG8_SB(b, h) ((4 + (b) * 2 + (h)) * HTB)
#define PG8_STAGE(bufoff, gbase, voff) do { _Pragma("unroll") for (int _i = 0; _i < 2; ++_i) \
        __builtin_amdgcn_global_load_lds((const unsigned*)((const char*)(gbase) + (voff)[_i]), (PG8_LAS unsigned*)(lds + (bufoff) + ldsw + _i * 8192), 16, 0, 0); } while (0)
#define PG8_LDA(dst, b, h) do { _Pragma("unroll") for (int m = 0; m < 4; ++m) _Pragma("unroll") for (int k = 0; k < 2; ++k) dst[m][k] = *(const PG8_LAS bf16x8*)(lds + PG8_SA(b, h) + aoff + m * 2048 + k * 1024); } while (0)
#define PG8_LDB(dst, b, h) do { _Pragma("unroll") for (int n = 0; n < 2; ++n) _Pragma("unroll") for (int k = 0; k < 2; ++k) dst[n][k] = *(const PG8_LAS bf16x8*)(lds + PG8_SB(b, h) + boff + n * 2048 + k * 1024); } while (0)
#define PG8_MMA(ai, bj, At, Bt) do { __builtin_amdgcn_s_setprio(1); _Pragma("unroll") for (int m = 0; m < 4; ++m) _Pragma("unroll") for (int n = 0; n < 2; ++n) _Pragma("unroll") for (int k = 0; k < 2; ++k) \
        acc[ai][bj][m][n] = __builtin_amdgcn_mfma_f32_16x16x32_bf16(Bt[n][k], At[m][k], acc[ai][bj][m][n], 0, 0, 0); __builtin_amdgcn_s_setprio(0); } while (0)
#define PG8_WAIT_V(n) asm volatile("s_waitcnt vmcnt(" #n ")" ::: "memory")
#define PG8_WAIT_L(n) asm volatile("s_waitcnt lgkmcnt(" #n ")" ::: "memory")
#define PG8_BAR __builtin_amdgcn_s_barrier()
#define PG8_SCHED __builtin_amdgcn_sched_barrier(0)
    Unit cur, nxt; int ui = 0;
    if (!S.next(0, cur)) return;
    f32x4 acc[2][2][4][2];
#pragma unroll
    for (int a = 0; a < 2; ++a)
#pragma unroll
        for (int b = 0; b < 2; ++b)
#pragma unroll
            for (int m = 0; m < 4; ++m)
#pragma unroll
                for (int n = 0; n < 2; ++n) acc[a][b][m][n] = (f32x4){0.f, 0.f, 0.f, 0.f};
    bf16x8 At[4][2], B0[2][2], B1[2][2];
    const char* cA = (const char*)g.A + (size_t)cur.pm * tstep; const char* cB = (const char*)g.Bt + (size_t)cur.pn * tstep;
    S.a_ready(cur);
    if constexpr (SP2) {
        PG8_STAGE(PG8_SB(0, 0), cB, voffB); PG8_STAGE(PG8_SB(0, 1), cB + hstep, voffB); PG8_STAGE(PG8_SA(0, 0), cA, voffA); PG8_STAGE(PG8_SA(0, 1), cA + hstep, voffA);
        if (wr == 1) PG8_BAR;
        PG8_WAIT_V(2); PG8_BAR;
        PG8_STAGE(PG8_SB(1, 0), cB + kstep, voffB); PG8_STAGE(PG8_SA(1, 0), cA + kstep, voffA); PG8_STAGE(PG8_SB(1, 1), cB + hstep + kstep, voffB);
        PG8_WAIT_V(6); PG8_BAR;
    } else {
        PG8_STAGE(PG8_SB(0, 0), cB, voffB); PG8_STAGE(PG8_SA(0, 0), cA, voffA); PG8_STAGE(PG8_SB(0, 1), cB + hstep, voffB); PG8_STAGE(PG8_SA(0, 1), cA + hstep, voffA);
        if (wr == 1) PG8_BAR;
        PG8_WAIT_V(4); PG8_BAR;
        PG8_STAGE(PG8_SB(1, 0), cB + kstep, voffB); PG8_STAGE(PG8_SA(1, 0), cA + kstep, voffA); PG8_STAGE(PG8_SB(1, 1), cB + hstep + kstep, voffB);
        PG8_WAIT_V(6); PG8_BAR;
    }
    for (;;) {
        const bool has_next = S.next(ui + 1, nxt);
        const char* nA = has_next ? (const char*)g.A + (size_t)nxt.pm * tstep : cA; const char* nB = has_next ? (const char*)g.Bt + (size_t)nxt.pn * tstep : cB;
        for (int t = 0; t < nt; t += 2) {
            const bool last = (t == nt - 2);
            const char* a1 = cA + (size_t)(t + 1) * kstep;
            const char* a2 = last ? nA : cA + (size_t)(t + 2) * kstep; const char* b2 = last ? nB : cB + (size_t)(t + 2) * kstep;
            const char* a3 = a2 + kstep; const char* b3 = b2 + kstep;
            if (last && has_next) S.a_ready(nxt);
            if constexpr (SP2) {
            PG8_LDB(B0, 0, 0); PG8_LDB(B1, 0, 1); PG8_SCHED; PG8_LDA(At, 0, 0); PG8_STAGE(PG8_SA(1, 1), a1 + hstep, voffA);
            PG8_WAIT_V(8); PG8_WAIT_L(0); PG8_BAR; PG8_MMA(0, 0, At, B0); PG8_MMA(0, 1, At, B1); PG8_BAR; PG8_SCHED;
            PG8_LDA(At, 0, 1); PG8_STAGE(PG8_SB(0, 0), b2, voffB); PG8_STAGE(PG8_SB(0, 1), b2 + hstep, voffB); PG8_STAGE(PG8_SA(0, 0), a2, voffA);
            PG8_WAIT_V(8); PG8_WAIT_L(0); PG8_BAR; PG8_MMA(1, 0, At, B0); PG8_MMA(1, 1, At, B1); PG8_BAR; PG8_SCHED;
            PG8_LDB(B0, 1, 0); PG8_LDB(B1, 1, 1); PG8_SCHED; PG8_LDA(At, 1, 0); PG8_STAGE(PG8_SA(0, 1), a2 + hstep, voffA);
            PG8_WAIT_V(8); PG8_WAIT_L(0); PG8_BAR; PG8_MMA(0, 0, At, B0); PG8_MMA(0, 1, At, B1); PG8_BAR; PG8_SCHED;
            PG8_LDA(At, 1, 1); PG8_STAGE(PG8_SB(1, 0), b3, voffB); PG8_STAGE(PG8_SB(1, 1), b3 + hstep, voffB); PG8_STAGE(PG8_SA(1, 0), a3, voffA);
            PG8_WAIT_V(8); PG8_WAIT_L(0); PG8_BAR; PG8_MMA(1, 0, At, B0); PG8_MMA(1, 1, At, B1); PG8_BAR; PG8_SCHED;
            } else {
            PG8_LDB(B0, 0, 0); PG8_SCHED; PG8_LDA(At, 0, 0); PG8_STAGE(PG8_SA(1, 1), a1 + hstep, voffA);
            PG8_WAIT_L(8); PG8_BAR; PG8_WAIT_L(0); PG8_MMA(0, 0, At, B0); PG8_BAR; PG8_SCHED;
            PG8_LDB(B1, 0, 1); PG8_STAGE(PG8_SB(0, 0), b2, voffB);
            PG8_BAR; PG8_WAIT_L(0); PG8_MMA(0, 1, At, B1); PG8_BAR;
            PG8_LDA(At, 0, 1); PG8_STAGE(PG8_SA(0, 0), a2, voffA);
            PG8_BAR; PG8_WAIT_L(0); PG8_MMA(1, 0, At, B0); PG8_BAR; PG8_SCHED;
            PG8_STAGE(PG8_SB(0, 1), b2 + hstep, voffB);
            PG8_WAIT_V(6); PG8_BAR; PG8_MMA(1, 1, At, B1); PG8_BAR;
            PG8_LDB(B0, 1, 0); PG8_SCHED; PG8_LDA(At, 1, 0); PG8_STAGE(PG8_SA(0, 1), a2 + hstep, voffA);
            PG8_WAIT_L(8); PG8_BAR; PG8_WAIT_L(0); PG8_MMA(0, 0, At, B0); PG8_BAR; PG8_SCHED;
            PG8_LDB(B1, 1, 1); PG8_STAGE(PG8_SB(1, 0), b3, voffB);
            PG8_BAR; PG8_WAIT_L(0); PG8_MMA(0, 1, At, B1); PG8_BAR;
            PG8_LDA(At, 1, 1); PG8_STAGE(PG8_SA(1, 0), a3, voffA);
            PG8_BAR; PG8_WAIT_L(0); PG8_MMA(1, 0, At, B0); PG8_BAR; PG8_SCHED;
            PG8_STAGE(PG8_SB(1, 1), b3 + hstep, voffB);
            PG8_WAIT_V(6); PG8_BAR; PG8_MMA(1, 1, At, B1); PG8_BAR;
            }
        }
        if constexpr (ALIGN_EPI) { if (wr == 0) PG8_BAR; }
        if constexpr (!Epi::AFTER_DRAIN) { E(acc, cur, wr, wc, fr, fq); S.done(cur); }
        if (!has_next) break;
#pragma unroll
        for (int a = 0; a < 2; ++a)
#pragma unroll
            for (int b = 0; b < 2; ++b)
#pragma unroll
                for (int m = 0; m < 4; ++m)
#pragma unroll
                    for (int n = 0; n < 2; ++n) acc[a][b][m][n] = (f32x4){0.f, 0.f, 0.f, 0.f};
        cur = nxt; cA = nA; cB = nB; ++ui;
        if constexpr (ALIGN_EPI) { if (wr == 1) PG8_BAR; }
    }
    PG8_WAIT_V(0);
    if constexpr (!ALIGN_EPI) { if (wr == 0) PG8_BAR; }
    PG8_BAR;
    if constexpr (Epi::AFTER_DRAIN) { E.fused(acc, cur, wr, wc, fr, fq, lds, wid, lane); S.done(cur); }
#undef PG8_SA
#undef PG8_SB
#undef PG8_STAGE
#undef PG8_LDA
#undef PG8_LDB
#undef PG8_MMA
#undef PG8_WAIT_V
#undef PG8_WAIT_L
#undef PG8_BAR
#undef PG8_SCHED
}
}

#define LAS __attribute__((address_space(3)))
typedef unsigned short bf16;
typedef short bf16x8 __attribute__((ext_vector_type(8)));
typedef float f32x4 __attribute__((ext_vector_type(4)));
typedef float f32x16 __attribute__((ext_vector_type(16)));
typedef unsigned u32x4 __attribute__((ext_vector_type(4)));
typedef unsigned u32x2 __attribute__((ext_vector_type(2)));
typedef __bf16 bf16x2_t __attribute__((ext_vector_type(2)));
typedef float f32x2_t __attribute__((ext_vector_type(2)));
#define MFMA32(a, b, c) __builtin_amdgcn_mfma_f32_32x32x16_bf16((a), (b), (c), 0, 0, 0)
#define MFMA16(a, b, c) __builtin_amdgcn_mfma_f32_16x16x32_bf16((a), (b), (c), 0, 0, 0)
#define DI __device__ __forceinline__

constexpr int DM = 1024, MROWS = 33792, MP = 32768;
constexpr float EPS = 1e-6f;
constexpr float LOG2E = 1.4426950408889634f;
constexpr float QSCALE = 0.125f * LOG2E;
constexpr size_t O_KWP = 34603008, O_VWP = 34865152, O_CONVP = 35127296, O_SSMP = 35201024, O_KWS = 36249600, O_VWS = 37298176, O_CONVS = 38346752, O_SSMS = 38641664;
constexpr size_t MiB = 1u << 20;
constexpr size_t WS_W1T = 1 * MiB, WS_WO1T = 6 * MiB, WS_W2T = 8 * MiB, WS_WO2T = 17 * MiB, WS_BA = 19 * MiB, WS_SS1 = 22 * MiB, WS_SS2 = 22 * MiB + 512 * 1024,
                 WS_HALO = 23 * MiB, WS_SCAL = 33 * MiB, WS_XN = 40 * MiB  , WS_BIG = 110 * MiB  , WS_OG = 374 * MiB, WS_KT = 440 * MiB, WS_END = 508 * MiB;
constexpr int LDS_BYTES = 143360;

DI unsigned pk2(float lo, float hi) { f32x2_t v = {lo, hi}; bf16x2_t b = __builtin_convertvector(v, bf16x2_t); return __builtin_bit_cast(unsigned, b); }
DI float bflo(unsigned u) { return __builtin_bit_cast(float, u << 16); }
DI float bfhi(unsigned u) { return __builtin_bit_cast(float, u & 0xffff0000u); }
DI float bf2f(bf16 u) { return __builtin_bit_cast(float, (unsigned)u << 16); }
DI bf16 f2bf(float f) { return (bf16)(pk2(f, 0.f) & 0xffffu); }
DI int crow(int i, int h) { return (i & 3) + 8 * (i >> 2) + 4 * h; }
DI float fexp2(float x) { return __builtin_amdgcn_exp2f(x); }
DI float silu(float x) { return x / (1.f + __expf(-x)); }
DI float wave_sum(float v) {
#pragma unroll
    for (int o = 1; o < 64; o <<= 1) v += __shfl_xor(v, o);
    return v;
}
DI u32x4 pack8f(const float* p) { u32x4 r; r.x = pk2(p[0], p[1]); r.y = pk2(p[2], p[3]); r.z = pk2(p[4], p[5]); r.w = pk2(p[6], p[7]); return r; }
DI u32x4 ld8f_bf(const float* p) { const f32x4 a = *(const f32x4*)p, b = *(const f32x4*)(p + 4); u32x4 r; r.x = pk2(a.x, a.y); r.y = pk2(a.z, a.w); r.z = pk2(b.x, b.y); r.w = pk2(b.z, b.w); return r; }

struct EpiQKVG {
    static constexpr bool PERM = true, AFTER_DRAIN = false;
    bf16* O; float* dout;
    DI void operator()(const pg8::f32x4 (&acc)[2][2][4][2], const pg8::Unit& u, int wr, int wc, int fr, int fq) const {
        const float sc = (u.pn < 4) ? QSCALE : 1.f;
        const bool kv = (u.pn == 4 || u.pn == 5);
#pragma unroll
        for (int ai = 0; ai < 2; ++ai)
#pragma unroll
            for (int m = 0; m < 4; ++m) {
                const int row = u.pm * 256 + ai * 128 + wr * 64 + m * 16 + fr;
                float* wdst = nullptr;
                if (kv) {
                    if (row < MP) { const int t = row & 4095; if (t >= 3968) wdst = dout + (u.pn == 4 ? O_KWP : O_VWP) + ((size_t)((row >> 12) * 128 + (t - 3968))) * 256; }
                    else { const int s = row - MP; wdst = dout + (u.pn == 4 ? O_KWS : O_VWS) + ((size_t)((s >> 5) * 128 + 96 + (s & 31))) * 256; }
                }
#pragma unroll
                for (int bj = 0; bj < 2; ++bj) {
                    const int cin = bj * 128 + wc * 32 + 8 * fq;
                    const f32x4 v0 = acc[ai][bj][m][0] * sc, v1 = acc[ai][bj][m][1] * sc;
                    u32x4 w; w.x = pk2(v0[0], v0[1]); w.y = pk2(v0[2], v0[3]); w.z = pk2(v1[0], v1[1]); w.w = pk2(v1[2], v1[3]);
                    *(u32x4*)(O + (size_t)row * 2560 + u.pn * 256 + cin) = w;
                    if (wdst) { *(f32x4*)(wdst + cin) = v0; *(f32x4*)(wdst + cin + 4) = v1; }
                }
            }
    }
};

struct EpiRes {
    static constexpr bool PERM = true, AFTER_DRAIN = false;
    const float* xp; const float* xs; float* y; bf16* XN; const float* g; float* ss;
    DI void operator()(const pg8::f32x4 (&acc)[2][2][4][2], const pg8::Unit& u, int wr, int wc, int fr, int fq) const {
#pragma unroll
        for (int ai = 0; ai < 2; ++ai)
#pragma unroll
            for (int m = 0; m < 4; ++m) {
                const int row = u.pm * 256 + ai * 128 + wr * 64 + m * 16 + fr;
                const float* xr = (row < MP || xs == nullptr) ? xp + (size_t)row * DM : xs + (size_t)(row - MP) * DM;
                float s = 0.f;
#pragma unroll
                for (int bj = 0; bj < 2; ++bj) {
                    const int col = u.pn * 256 + bj * 128 + wc * 32 + 8 * fq;
                    const f32x4 a0 = *(const f32x4*)(xr + col), a1 = *(const f32x4*)(xr + col + 4);
                    const f32x4 v0 = acc[ai][bj][m][0] + a0, v1 = acc[ai][bj][m][1] + a1;
                    *(f32x4*)(y + (size_t)row * DM + col) = v0; *(f32x4*)(y + (size_t)row * DM + col + 4) = v1;
                    s += (v0[0] * v0[0] + v0[1] * v0[1]) + (v0[2] * v0[2] + v0[3] * v0[3]) + (v1[0] * v1[0] + v1[1] * v1[1]) + (v1[2] * v1[2] + v1[3] * v1[3]);
                    if (XN) {
                        const f32x4 g0 = *(const f32x4*)(g + col), g1 = *(const f32x4*)(g + col + 4);
                        u32x4 w; w.x = pk2(v0[0] * g0[0], v0[1] * g0[1]); w.y = pk2(v0[2] * g0[2], v0[3] * g0[3]); w.z = pk2(v1[0] * g1[0], v1[1] * g1[1]); w.w = pk2(v1[2] * g1[2], v1[3] * g1[3]);
                        *(u32x4*)(XN + (size_t)row * DM + col) = w;
                    }
                }
                s += __shfl_xor(s, 16); s += __shfl_xor(s, 32);
                if (fq == 0) atomicAdd(ss + row, s);
            }
    }
};

struct EpiDN {
    static constexpr bool PERM = true, AFTER_DRAIN = false;
    bf16* O; bf16* halo; float* ba; const float* ss; float* dout;
    DI void operator()(const pg8::f32x4 (&acc)[2][2][4][2], const pg8::Unit& u, int wr, int wc, int fr, int fq) const {
#pragma unroll
        for (int ai = 0; ai < 2; ++ai)
#pragma unroll
            for (int m = 0; m < 4; ++m) {
                const int row = u.pm * 256 + ai * 128 + wr * 64 + m * 16 + fr;
                const float sc = rsqrtf(ss[row] * (1.f / DM) + EPS);
                if (u.pn < 16) {
                    bf16* hdst = nullptr; float* cdst = nullptr;
                    if (u.pn < 12) {
                        if (row < MP) { const int t = row & 63; if (t >= 61) hdst = halo + ((size_t)(row >> 6) * 3 + (t - 61)) * 3072;
                                        const int t4 = row & 4095; if (t4 >= 4093) cdst = dout + O_CONVP + ((size_t)(row >> 12) * 3 + (t4 - 4093)) * 3072; }
                        else { const int s = row - MP, t = s & 31; if (t >= 29) cdst = dout + O_CONVS + ((size_t)(s >> 5) * 3 + (t - 29)) * 3072; }
                    }
#pragma unroll
                    for (int bj = 0; bj < 2; ++bj) {
                        const int col = u.pn * 256 + bj * 128 + wc * 32 + 8 * fq;
                        const f32x4 v0 = acc[ai][bj][m][0] * sc, v1 = acc[ai][bj][m][1] * sc;
                        u32x4 w; w.x = pk2(v0[0], v0[1]); w.y = pk2(v0[2], v0[3]); w.z = pk2(v1[0], v1[1]); w.w = pk2(v1[2], v1[3]);
                        *(u32x4*)(O + (size_t)row * 4096 + col) = w;
                        if (hdst) *(u32x4*)(hdst + col) = w;
                        if (cdst) { *(f32x4*)(cdst + col) = v0; *(f32x4*)(cdst + col + 4) = v1; }
                    }
                } else if (wc == 0 && fq < 2) {
                    const f32x4 v0 = acc[ai][0][m][0] * sc, v1 = acc[ai][0][m][1] * sc;
                    *(f32x4*)(ba + (size_t)row * 16 + 8 * fq) = v0; *(f32x4*)(ba + (size_t)row * 16 + 8 * fq + 4) = v1;
                }
            }
    }
};

DI void p0_transpose_item(const float* W, int K, int ld, int nblk, bf16* WT, LAS float* scr, int item, int lane) {
    const int kb = item / nblk, nb = item % nblk, k0 = 64 * kb, n0 = 32 * nb;
#pragma unroll 8
    for (int i = 0; i < 32; ++i) { const int kk = 2 * i + (lane >> 5); scr[kk * 33 + (lane & 31)] = W[(size_t)(k0 + kk) * ld + n0 + (lane & 31)]; }
    asm volatile("s_waitcnt lgkmcnt(0)" ::: "memory");
    const int c = lane & 7;
#pragma unroll
    for (int j = 0; j < 4; ++j) { const int n = (lane >> 3) + 8 * j; const LAS float* s = scr + (8 * c) * 33 + n;
        u32x4 o; o.x = pk2(s[0 * 33], s[1 * 33]); o.y = pk2(s[2 * 33], s[3 * 33]); o.z = pk2(s[4 * 33], s[5 * 33]); o.w = pk2(s[6 * 33], s[7 * 33]);
        *(u32x4*)(WT + (size_t)(n0 + n) * K + k0 + 8 * c) = o; }
    asm volatile("s_waitcnt lgkmcnt(0)" ::: "memory");
}

struct Args { const float* in[17]; float* out; unsigned char* ws; };

DI void p0_prologue(const Args& a, LAS unsigned char* lds, int tid, int lane, int w) {
    LAS float* scr = (LAS float*)(lds + w * 16384);
    const int gw = blockIdx.x * 8 + w, NGW = gridDim.x * 8;
    const float* W1 = a.in[8]; const float* Wo1 = a.in[10]; const float* W2 = a.in[11]; const float* Wo2 = a.in[16];
    bf16* W1T = (bf16*)(a.ws + WS_W1T); bf16* WO1T = (bf16*)(a.ws + WS_WO1T); bf16* W2T = (bf16*)(a.ws + WS_W2T); bf16* WO2T = (bf16*)(a.ws + WS_WO2T);
    constexpr int I1 = 16 * 80, I2 = 16 * 32, I3 = 16 * 128, I4 = 16 * 32;
    for (int it = gw; it < I1 + I2 + I3 + I4; it += NGW) {
        int r = it;
        if (r < I1) { p0_transpose_item(W1, 1024, 2560, 80, W1T, scr, r, lane); continue; } r -= I1;
        if (r < I2) { p0_transpose_item(Wo1, 1024, 1024, 32, WO1T, scr, r, lane); continue; } r -= I2;
        if (r < I3) { p0_transpose_item(W2, 1024, 4112, 128, W2T, scr, r, lane); continue; } r -= I3;
        p0_transpose_item(Wo2, 1024, 1024, 32, WO2T, scr, r, lane);
    }
    const int gt = blockIdx.x * 512 + tid, NGT = gridDim.x * 512;
    for (int i = gt; i < 16 * 1024; i += NGT) { const int n = i >> 10, k = i & 1023; W2T[(size_t)(4096 + n) * 1024 + k] = f2bf(W2[(size_t)k * 4112 + 4096 + n]); }
    for (int i = gt; i < 240 * 1024 / 8; i += NGT) *(u32x4*)(W2T + (size_t)4112 * 1024 + (size_t)i * 8) = (u32x4){0u, 0u, 0u, 0u};
    float* ss1 = (float*)(a.ws + WS_SS1); float* ss2 = (float*)(a.ws + WS_SS2);
    for (int i = gt; i < MROWS; i += NGT) { ss1[i] = 0.f; ss2[i] = 0.f; }
    const float* ck = a.in[2]; const float* cv = a.in[3];
    for (int i = gt; i < 32 * 96 * 64; i += NGT) { const int sb = i / (96 * 64), rem = i % (96 * 64);
        *(f32x4*)(a.out + O_KWS + (size_t)sb * 32768 + (size_t)rem * 4) = *(const f32x4*)(ck + (size_t)sb * 32768 + 32 * 256 + (size_t)rem * 4);
        *(f32x4*)(a.out + O_VWS + (size_t)sb * 32768 + (size_t)rem * 4) = *(const f32x4*)(cv + (size_t)sb * 32768 + 32 * 256 + (size_t)rem * 4); }
    const float* g0 = a.in[6]; bf16* XN = (bf16*)(a.ws + WS_XN);
    f32x4 gv[4];
#pragma unroll
    for (int j = 0; j < 4; ++j) gv[j] = *(const f32x4*)(g0 + 4 * lane + 256 * j);
    for (int m = gw; m < MROWS; m += NGW) {
        const float* xr = (m < MP) ? a.in[0] + (size_t)m * DM : a.in[1] + (size_t)(m - MP) * DM;
        f32x4 v[4]; float s = 0.f;
#pragma unroll
        for (int j = 0; j < 4; ++j) { v[j] = *(const f32x4*)(xr + 4 * lane + 256 * j); s += (v[j].x * v[j].x + v[j].y * v[j].y) + (v[j].z * v[j].z + v[j].w * v[j].w); }
        const float rs = rsqrtf(wave_sum(s) * (1.f / DM) + EPS);
#pragma unroll
        for (int j = 0; j < 4; ++j) { u32x2 o; o.x = pk2(v[j].x * rs * gv[j].x, v[j].y * rs * gv[j].y); o.y = pk2(v[j].z * rs * gv[j].z, v[j].w * rs * gv[j].w);
            *(u32x2*)(XN + (size_t)m * DM + 4 * lane + 256 * j) = o; }
    }
}

DI void attn_phase(LAS unsigned char* lds, const bf16* QKVG, const float* cache_k, const float* cache_v, const float* sinks, bf16* OG, int tid, int lane, int w) {
    LAS bf16* Ks = (LAS bf16*)lds;
    LAS bf16* VT = (LAS bf16*)(lds + 192 * 72 * 2);
    for (int u = blockIdx.x; u < 2176; u += gridDim.x) {
        asm volatile("" : "+v"(lane), "+v"(tid));
        const int r = lane & 31, hh = lane >> 5;
        int kvh, jmin, jmax, qrow0, sb = 0; bool sample;
        if (u < 2048) { kvh = u & 3; const int bn = u >> 2, b = bn >> 6, n = bn & 63; qrow0 = b * 4096 + 64 * n; jmin = n < 2 ? 64 * (2 - n) : 0; jmax = 192; sample = false; }
        else { const int su = u - 2048; kvh = su & 3; sb = su >> 2; qrow0 = MP + 32 * sb; jmin = 0; jmax = 160; sample = true; }
        __syncthreads();
#pragma unroll
        for (int i = 0; i < 3; ++i) {
            const int id = tid + 512 * i, j = id >> 3, c8 = id & 7;
            u32x4 kv = (u32x4){0u, 0u, 0u, 0u}, vv = (u32x4){0u, 0u, 0u, 0u};
            if (!sample) {
                if (j >= jmin) { const size_t row = (size_t)(qrow0 - 128 + j); kv = *(const u32x4*)(QKVG + row * 2560 + 1024 + kvh * 64 + c8 * 8); vv = *(const u32x4*)(QKVG + row * 2560 + 1280 + kvh * 64 + c8 * 8); }
            } else {
                if (j < 128) { const size_t off = ((size_t)(sb * 128 + j) * 4 + kvh) * 64 + c8 * 8; kv = ld8f_bf(cache_k + off); vv = ld8f_bf(cache_v + off); }
                else if (j < 160) { const size_t row = (size_t)(qrow0 + j - 128); kv = *(const u32x4*)(QKVG + row * 2560 + 1024 + kvh * 64 + c8 * 8); vv = *(const u32x4*)(QKVG + row * 2560 + 1280 + kvh * 64 + c8 * 8); }
            }
            *(LAS u32x4*)(Ks + j * 72 + c8 * 8) = kv;
            const int pos = (j & ~31) | (((j >> 4) & 1) << 4) | (((j >> 2) & 1) << 3) | (((j >> 3) & 1) << 2) | (j & 3);
#pragma unroll
            for (int e = 0; e < 4; ++e) { VT[(c8 * 8 + 2 * e) * 200 + pos] = (bf16)(vv[e] & 0xffffu); VT[(c8 * 8 + 2 * e + 1) * 200 + pos] = (bf16)(vv[e] >> 16); }
        }
        __syncthreads();
        const int g = w >> 1, th = w & 1;
        if (!(sample && th == 1)) {
            const int head = kvh * 4 + g;
            const size_t qrow = (size_t)(qrow0 + 32 * th + r);
            bf16x8 qf[4];
#pragma unroll
            for (int s = 0; s < 4; ++s) qf[s] = *(const bf16x8*)(QKVG + qrow * 2560 + head * 64 + 16 * s + 8 * hh);
            f32x16 sc[6];
#pragma unroll
            for (int kt = 0; kt < 6; ++kt) {
#pragma unroll
                for (int i = 0; i < 16; ++i) sc[kt][i] = 0.f;
#pragma unroll
                for (int s = 0; s < 4; ++s) { const bf16x8 kf = *(const LAS bf16x8*)(Ks + (32 * kt + r) * 72 + 16 * s + 8 * hh); sc[kt] = MFMA32(kf, qf[s], sc[kt]); }
                __builtin_amdgcn_sched_barrier(0);
            }
            const float slope2 = fexp2(-0.5f * (float)(head + 1)) * LOG2E;
            const float sink2 = sinks[head] * LOG2E;
            const int t = 32 * th + r;
            float mx = sink2;
#pragma unroll
            for (int kt = 0; kt < 6; ++kt)
#pragma unroll
                for (int i = 0; i < 16; ++i) { const int j = 32 * kt + crow(i, hh); const float dist = fabsf((float)(128 + t - j));
                    float l = sc[kt][i] - slope2 * dist; l = (j >= jmin && j < jmax) ? l : -INFINITY; sc[kt][i] = l; mx = fmaxf(mx, l); }
            mx = fmaxf(mx, __shfl_xor(mx, 32));
            float sum = 0.f;
#pragma unroll
            for (int kt = 0; kt < 6; ++kt)
#pragma unroll
                for (int i = 0; i < 16; ++i) { const float p = fexp2(sc[kt][i] - mx); sc[kt][i] = p; sum += p; }
            sum += __shfl_xor(sum, 32);
            const float inv = 1.f / (sum + fexp2(sink2 - mx));
            f32x16 o[2];
#pragma unroll
            for (int i = 0; i < 16; ++i) { o[0][i] = 0.f; o[1][i] = 0.f; }
#pragma unroll
            for (int kt = 0; kt < 6; ++kt)
#pragma unroll
                for (int s = 0; s < 2; ++s) {
                    u32x4 pp; pp.x = pk2(sc[kt][8 * s], sc[kt][8 * s + 1]); pp.y = pk2(sc[kt][8 * s + 2], sc[kt][8 * s + 3]); pp.z = pk2(sc[kt][8 * s + 4], sc[kt][8 * s + 5]); pp.w = pk2(sc[kt][8 * s + 6], sc[kt][8 * s + 7]);
                    const bf16x8 pf = __builtin_bit_cast(bf16x8, pp);
#pragma unroll
                    for (int mt = 0; mt < 2; ++mt) { const bf16x8 vf = *(const LAS bf16x8*)(VT + (32 * mt + r) * 200 + 32 * kt + 16 * s + 8 * hh); o[mt] = MFMA32(vf, pf, o[mt]); }
                    __builtin_amdgcn_sched_barrier(0);
                }
#pragma unroll
            for (int mt = 0; mt < 2; ++mt)
#pragma unroll
                for (int i4 = 0; i4 < 4; ++i4) {
                    const int d0 = 32 * mt + 8 * i4 + 4 * hh;
                    const u32x2 gz = *(const u32x2*)(QKVG + qrow * 2560 + 1536 + head * 64 + d0);
                    const float o0 = o[mt][4 * i4] * inv * silu(bflo(gz.x)), o1 = o[mt][4 * i4 + 1] * inv * silu(bfhi(gz.x));
                    const float o2 = o[mt][4 * i4 + 2] * inv * silu(bflo(gz.y)), o3 = o[mt][4 * i4 + 3] * inv * silu(bfhi(gz.y));
                    u32x2 ov; ov.x = pk2(o0, o1); ov.y = pk2(o2, o3);
                    *(u32x2*)(OG + qrow * 1024 + head * 64 + d0) = ov;
                }
        }
    }
    __syncthreads();
}

DI u32x4 zero4() { return (u32x4){0u, 0u, 0u, 0u}; }
DI float bfe(const u32x4& v, int e) { const unsigned u = v[e >> 1]; return (e & 1) ? bfhi(u) : bflo(u); }

DI void dn_pre_phase(const Args& a, int lane, int w) {
    bf16* DNP = (bf16*)(a.ws + WS_BIG); const bf16* HALO = (const bf16*)(a.ws + WS_HALO); float* BA = (float*)(a.ws + WS_BA);
    const float* state_conv = a.in[4]; const float* conv_w = a.in[12]; const float* a_log = a.in[13]; const float* dt_bias = a.in[14];
    const int gw = blockIdx.x * 8 + w, NGW = gridDim.x * 8;
    for (int it = gw; it < 528 * 25; it += NGW) {
        asm volatile("" : "+v"(lane));
        const int ch = it / 25, sub = it % 25;
        if (sub == 24) {
            const size_t row = (size_t)64 * ch + lane; const int width = ch < 512 ? 64 : 32;
            float bv[8], gv[8];
#pragma unroll
            for (int hh = 0; hh < 8; ++hh) { bv[hh] = BA[row * 16 + hh]; gv[hh] = BA[row * 16 + 8 + hh]; }
#pragma unroll
            for (int hh = 0; hh < 8; ++hh) {
                const float beta = 1.f / (1.f + __expf(-bv[hh]));
                const float x = gv[hh] + dt_bias[hh]; const float sp = x > 20.f ? x : log1pf(expf(x));
                float gg = -expf(a_log[hh]) * sp;
#pragma unroll
                for (int d = 1; d < 64; d <<= 1) { const float t = __shfl_up(gg, d, 64); if ((lane & (width - 1)) >= d && d < width) gg += t; }
                BA[row * 16 + hh] = beta; BA[row * 16 + 8 + hh] = gg;
            }
            continue;
        }
        const int h = sub / 3, sec = sub % 3;
        const int g = lane >> 4, cl = lane & 15;
        const int col = sec * 1024 + h * 128 + 8 * cl;
        const size_t R0 = (size_t)64 * ch + 16 * g;
        u32x4 xin[19];
#pragma unroll
        for (int i = 0; i < 16; ++i) xin[3 + i] = *(const u32x4*)(DNP + (R0 + i) * 4096 + col);
        if (ch < 512) {
            if (g > 0) {
#pragma unroll
                for (int i = 0; i < 3; ++i) xin[i] = *(const u32x4*)(DNP + (R0 - 3 + i) * 4096 + col);
            } else if ((ch & 63) == 0) { xin[0] = zero4(); xin[1] = zero4(); xin[2] = zero4(); }
            else {
#pragma unroll
                for (int i = 0; i < 3; ++i) xin[i] = *(const u32x4*)(HALO + ((size_t)(ch - 1) * 3 + i) * 3072 + col);
            }
        } else {
            if (g & 1) {
#pragma unroll
                for (int i = 0; i < 3; ++i) xin[i] = *(const u32x4*)(DNP + (R0 - 3 + i) * 4096 + col);
            } else { const int sb = 2 * (ch - 512) + (g >> 1);
#pragma unroll
                for (int i = 0; i < 3; ++i) xin[i] = ld8f_bf(state_conv + ((size_t)sb * 3 + i) * 3072 + col);
            }
        }
        float wv[4][8];
#pragma unroll
        for (int j = 0; j < 4; ++j) { const f32x4 w0 = *(const f32x4*)(conv_w + (size_t)j * 3072 + col), w1 = *(const f32x4*)(conv_w + (size_t)j * 3072 + col + 4);
            wv[j][0] = w0.x; wv[j][1] = w0.y; wv[j][2] = w0.z; wv[j][3] = w0.w; wv[j][4] = w1.x; wv[j][5] = w1.y; wv[j][6] = w1.z; wv[j][7] = w1.w; }
        asm volatile("s_waitcnt vmcnt(0)" ::: "memory");
        const int clp = cl & 3, pos0 = 32 * (cl >> 2) + 16 * (clp & 1) + 4 * (clp >> 1);
#pragma unroll
        for (int i = 0; i < 16; ++i) {
            float y[8]; float ssq = 0.f;
#pragma unroll
            for (int e = 0; e < 8; ++e) { float t = wv[0][e] * bfe(xin[i], e) + wv[1][e] * bfe(xin[i + 1], e) + wv[2][e] * bfe(xin[i + 2], e) + wv[3][e] * bfe(xin[i + 3], e);
                t = silu(t); y[e] = t; ssq += t * t; }
            if (sec < 2) {
                ssq += __shfl_xor(ssq, 1); ssq += __shfl_xor(ssq, 2); ssq += __shfl_xor(ssq, 4); ssq += __shfl_xor(ssq, 8);
                const float scl = rsqrtf(ssq + EPS) * (sec == 0 ? 0.08838834764831845f : 1.f);
                u32x2 lo, hi; lo.x = pk2(y[0] * scl, y[1] * scl); lo.y = pk2(y[2] * scl, y[3] * scl); hi.x = pk2(y[4] * scl, y[5] * scl); hi.y = pk2(y[6] * scl, y[7] * scl);
                bf16* dst = DNP + (R0 + i) * 4096 + sec * 1024 + h * 128 + pos0;
                *(u32x2*)dst = lo; *(u32x2*)(dst + 8) = hi;
            } else {
                *(u32x4*)(DNP + (R0 + i) * 4096 + col) = pack8f(y);
            }
        }
    }
}


template <int I, int J4> DI void fs_cols(float& acc, float (&T)[64], const LAS float* Ms) {
    if constexpr (4 * J4 < I) {
        const f32x4 m = *(const LAS f32x4*)(Ms + I * 64 + 4 * J4);
        if constexpr (4 * J4 + 0 < I) acc -= m[0] * T[4 * J4 + 0];
        if constexpr (4 * J4 + 1 < I) acc -= m[1] * T[4 * J4 + 1];
        if constexpr (4 * J4 + 2 < I) acc -= m[2] * T[4 * J4 + 2];
        if constexpr (4 * J4 + 3 < I) acc -= m[3] * T[4 * J4 + 3];
        fs_cols<I, J4 + 1>(acc, T, Ms);
    }
}
template <int I> DI void fs_all(float (&T)[64], const LAS float* Ms, int lane) {
    if constexpr (I < 64) {
        float acc = (lane == I) ? 1.f : 0.f;
        fs_cols<I, 0>(acc, T, Ms);
        T[I] = acc;
        fs_all<I + 1>(T, Ms, lane);
    }
}
template <int I> DI void tb_store(float (&T)[64], LAS bf16* TbI, int lane, float betal) {
    if constexpr (I < 64) { TbI[I * 64 + lane] = f2bf(T[I] * betal); tb_store<I + 1>(T, TbI, lane, betal); }
}
DI void dn_prep_phase(const Args& a, LAS unsigned char* lds, int lane, int w) {
    const bf16* DNP = (const bf16*)(a.ws + WS_BIG); const float* BA = (const float*)(a.ws + WS_BA);
    unsigned char* TBI = a.ws + WS_XN; unsigned char* KTG = a.ws + WS_KT; float* SCAL = (float*)(a.ws + WS_SCAL);
    LAS float* Ms = (LAS float*)(lds + w * 17408);
    LAS bf16* TbI = (LAS bf16*)Ms; LAS bf16* InI = TbI + 4096; LAS bf16* Kl = (LAS bf16*)Ms;
    const int gw = blockIdx.x * 8 + w, NGW = gridDim.x * 8;
    for (int uid = gw; uid < 4352; uid += NGW) {
        asm volatile("" : "+v"(lane));
        const int r = lane & 31, hh = lane >> 5;
        int h, nv; size_t R0;
        if (uid < 4096) { h = uid & 7; R0 = (size_t)64 * (uid >> 3); nv = 64; } else { const int su = uid - 4096; h = su & 7; R0 = (size_t)MP + 32 * (su >> 3); nv = 32; }
        const int lr = lane < nv ? lane : nv - 1;
        const float gcl = BA[(R0 + lr) * 16 + 8 + h];
        const float betal = lane < nv ? BA[(R0 + lane) * 16 + h] : 0.f;
        const bf16* kbase = DNP + R0 * 4096 + 1024 + h * 128; const bf16* qbase = DNP + R0 * 4096 + h * 128;
        bf16x8 kf[2][8];
#pragma unroll
        for (int mt = 0; mt < 2; ++mt)
#pragma unroll
            for (int s = 0; s < 8; ++s) kf[mt][s] = (32 * mt + r < nv) ? *(const bf16x8*)(kbase + (size_t)(32 * mt + r) * 4096 + 16 * s + 8 * hh) : (bf16x8){0, 0, 0, 0, 0, 0, 0, 0};
        f32x16 in00, in10, in11;
#pragma unroll
        for (int tl = 0; tl < 3; ++tl) {
            const int mt = tl > 0 ? 1 : 0, nt = tl > 1 ? 1 : 0;
            f32x16 kk, qk;
#pragma unroll
            for (int i = 0; i < 16; ++i) { kk[i] = 0.f; qk[i] = 0.f; }
#pragma unroll
            for (int s = 0; s < 8; ++s) {
                const bf16x8 qf = (32 * mt + r < nv) ? *(const bf16x8*)(qbase + (size_t)(32 * mt + r) * 4096 + 16 * s + 8 * hh) : (bf16x8){0, 0, 0, 0, 0, 0, 0, 0};
                kk = MFMA32(kf[mt][s], kf[nt][s], kk); qk = MFMA32(qf, kf[nt][s], qk);
            }
            const int j = 32 * nt + r; const float gcj = __shfl(gcl, j);
#pragma unroll
            for (int i = 0; i < 16; ++i) {
                const int ii = 32 * mt + crow(i, hh);
                const float gci = __shfl(gcl, ii), bi = __shfl(betal, ii);
                const float dec = __expf(fminf(gci - gcj, 0.f));
                Ms[ii * 64 + j] = (ii > j) ? kk[i] * bi * dec : 0.f;
                const float iv = (ii >= j) ? qk[i] * dec : 0.f;
                if (tl == 0) in00[i] = iv; else if (tl == 1) in10[i] = iv; else in11[i] = iv;
            }
        }
        float T[64];
        fs_all<0>(T, Ms, lane);
        tb_store<0>(T, TbI, lane, betal);
#pragma unroll
        for (int i = 0; i < 16; ++i) {
            InI[crow(i, hh) * 64 + r] = f2bf(in00[i]); InI[crow(i, hh) * 64 + 32 + r] = 0;
            InI[(32 + crow(i, hh)) * 64 + r] = f2bf(in10[i]); InI[(32 + crow(i, hh)) * 64 + 32 + r] = f2bf(in11[i]);
        }
        const int row = lane & 15, quad = lane >> 4;
#pragma unroll
        for (int f = 0; f < 8; ++f) {
            const int i = 16 * (f >> 1) + row, c0 = 32 * (f & 1) + 4 * quad;
            const u32x2 tlo = *(const LAS u32x2*)(TbI + i * 64 + c0), thi = *(const LAS u32x2*)(TbI + i * 64 + c0 + 16);
            *(u32x4*)(TBI + (size_t)uid * 16384 + (size_t)(f * 64 + lane) * 16) = (u32x4){tlo.x, tlo.y, thi.x, thi.y};
            const u32x2 ilo = *(const LAS u32x2*)(InI + i * 64 + c0), ihi = *(const LAS u32x2*)(InI + i * 64 + c0 + 16);
            *(u32x4*)(TBI + (size_t)uid * 16384 + 8192 + (size_t)(f * 64 + lane) * 16) = (u32x4){ilo.x, ilo.y, ihi.x, ihi.y};
        }
#pragma unroll
        for (int i = 0; i < 16; ++i) { const int id = lane + 64 * i, rr = id >> 4, c16 = id & 15;
            const u32x4 v = (rr < nv) ? *(const u32x4*)(kbase + (size_t)rr * 4096 + 8 * c16) : zero4();
            *(LAS u32x4*)(Kl + rr * 136 + 8 * c16) = v; }
#pragma unroll
        for (int f = 0; f < 16; ++f) {
            const int dk = 16 * (f >> 1) + row, dkp = dk & 31, pos = (dk & ~31) + 8 * ((dkp >> 2) & 3) + 4 * (dkp >> 4) + (dkp & 3);
            u32x4 o;
#pragma unroll
            for (int j2 = 0; j2 < 4; ++j2) { const int tok = 32 * (f & 1) + 16 * (j2 >> 1) + 4 * quad + 2 * (j2 & 1);
                o[j2] = (unsigned)Kl[tok * 136 + pos] | ((unsigned)Kl[(tok + 1) * 136 + pos] << 16); }
            *(u32x4*)(KTG + (size_t)uid * 16384 + (size_t)(f * 64 + lane) * 16) = o;
        }
        const float gl = __shfl(gcl, 63);
        SCAL[(size_t)uid * 256 + lane] = __expf(gcl); SCAL[(size_t)uid * 256 + 64 + lane] = __expf(gl - gcl);
        if (lane == 0) SCAL[(size_t)uid * 256 + 128] = __expf(gl);
    }
}

constexpr int SC_K = 0, SC_Q = 17408, SC_V = 34816, SC_Z = 52224, SC_TB = 69632, SC_IN = 77824, SC_KT = 86016, SC_SC = 102400, SC_RED = 103424;
DI void dn_scan_phase(const Args& a, LAS unsigned char* lds, int tid, int lane, int w) {
    const bf16* DNP = (const bf16*)(a.ws + WS_BIG); const unsigned char* TBI = a.ws + WS_XN; const unsigned char* KTG = a.ws + WS_KT; const float* SCAL = (const float*)(a.ws + WS_SCAL);
    bf16* OG = (bf16*)(a.ws + WS_OG); const float* state_ssm = a.in[5]; const float* ng = a.in[15];
    const float ngc = ng[16 * w + (lane & 15)];
    for (int job = blockIdx.x; job < 320; job += gridDim.x) {
        int h, nsteps, nv; size_t Rbase; int uid0, ustep; float* sout; f32x4 S[8];
        if (job < 64) { const int b = job >> 3; h = job & 7; nsteps = 64; nv = 64; Rbase = (size_t)b * 4096; uid0 = b * 512 + h; ustep = 8; sout = a.out + O_SSMP + (size_t)(b * 8 + h) * 16384;
#pragma unroll
            for (int t = 0; t < 8; ++t) S[t] = (f32x4){0.f, 0.f, 0.f, 0.f};
        } else { const int s = job - 64, sb = s >> 3; h = s & 7; nsteps = 1; nv = 32; Rbase = (size_t)MP + 32 * sb; uid0 = 4096 + s; ustep = 0; sout = a.out + O_SSMS + (size_t)(sb * 8 + h) * 16384;
            const float* sin = state_ssm + (size_t)(sb * 8 + h) * 16384; const int quad = lane >> 4, dvc = 16 * w + (lane & 15);
#pragma unroll
            for (int t = 0; t < 8; ++t)
#pragma unroll
                for (int i = 0; i < 4; ++i) S[t][i] = sin[(size_t)(16 * t + 4 * quad + i) * 128 + dvc];
        }
        u32x4 pf[12]; float pfs = 0.f;
#define SCAN_PREFETCH(n) do { const size_t R0_ = Rbase + (size_t)64 * (n); const int uid_ = uid0 + ustep * (n); \
            _Pragma("unroll") for (int i_ = 0; i_ < 2; ++i_) { const int id_ = tid + 512 * i_, rr_ = id_ >> 4, c16_ = id_ & 15; const bool ok_ = rr_ < nv; \
                const bf16* src_ = DNP + (R0_ + rr_) * 4096 + h * 128 + 8 * c16_; \
                pf[i_] = ok_ ? *(const u32x4*)(src_ + 1024) : zero4(); pf[2 + i_] = ok_ ? *(const u32x4*)(src_) : zero4(); \
                pf[4 + i_] = ok_ ? *(const u32x4*)(src_ + 2048) : zero4(); pf[6 + i_] = ok_ ? *(const u32x4*)(src_ + 3072) : zero4(); \
                pf[10 + i_] = *(const u32x4*)(KTG + (size_t)uid_ * 16384 + (size_t)id_ * 16); } \
            pf[8] = *(const u32x4*)(TBI + (size_t)uid_ * 16384 + (size_t)tid * 16); pf[9] = *(const u32x4*)(TBI + (size_t)uid_ * 16384 + 8192 + (size_t)tid * 16); \
            if (tid < 132) pfs = SCAL[(size_t)uid_ * 256 + tid]; } while (0)
        SCAN_PREFETCH(0);
        for (int n = 0; n < nsteps; ++n) {
            asm volatile("" : "+v"(lane), "+v"(tid));
            const int col = lane & 15, quad = lane >> 4, dvc = 16 * w + col;
            __syncthreads();
#pragma unroll
            for (int i = 0; i < 2; ++i) { const int id = tid + 512 * i, rr = id >> 4, c16 = id & 15; const int off = rr * 272 + c16 * 16;
                *(LAS u32x4*)(lds + SC_K + off) = pf[i]; *(LAS u32x4*)(lds + SC_Q + off) = pf[2 + i]; *(LAS u32x4*)(lds + SC_V + off) = pf[4 + i]; *(LAS u32x4*)(lds + SC_Z + off) = pf[6 + i];
                *(LAS u32x4*)(lds + SC_KT + id * 16) = pf[10 + i]; }
            *(LAS u32x4*)(lds + SC_TB + tid * 16) = pf[8]; *(LAS u32x4*)(lds + SC_IN + tid * 16) = pf[9];
            if (tid < 132) *(LAS float*)(lds + SC_SC + tid * 4) = pfs;
            __syncthreads();
            if (n + 1 < nsteps) SCAN_PREFETCH(n + 1);
            bf16x8 sB[4];
#pragma unroll
            for (int ks = 0; ks < 4; ++ks) { u32x4 p; p.x = pk2(S[2 * ks][0], S[2 * ks][1]); p.y = pk2(S[2 * ks][2], S[2 * ks][3]); p.z = pk2(S[2 * ks + 1][0], S[2 * ks + 1][1]); p.w = pk2(S[2 * ks + 1][2], S[2 * ks + 1][3]); sB[ks] = __builtin_bit_cast(bf16x8, p); }
            f32x4 kS[4], qS[4];
#pragma unroll
            for (int mt = 0; mt < 4; ++mt) { kS[mt] = (f32x4){0.f, 0.f, 0.f, 0.f}; qS[mt] = (f32x4){0.f, 0.f, 0.f, 0.f};
#pragma unroll
                for (int ks = 0; ks < 4; ++ks) { const int off = (16 * mt + col) * 272 + 64 * ks + 16 * quad;
                    const bf16x8 ka = *(const LAS bf16x8*)(lds + SC_K + off), qa = *(const LAS bf16x8*)(lds + SC_Q + off);
                    kS[mt] = MFMA16(ka, sB[ks], kS[mt]); qS[mt] = MFMA16(qa, sB[ks], qS[mt]); } }
            f32x4 ev[4], dv[4], rr4[4];
#pragma unroll
            for (int mt = 0; mt < 4; ++mt) { ev[mt] = *(const LAS f32x4*)(lds + SC_SC + (16 * mt + 4 * quad) * 4); dv[mt] = *(const LAS f32x4*)(lds + SC_SC + (64 + 16 * mt + 4 * quad) * 4);
#pragma unroll
                for (int i = 0; i < 4; ++i) { const float vv = bf2f(*(const LAS bf16*)(lds + SC_V + (16 * mt + 4 * quad + i) * 272 + dvc * 2)); rr4[mt][i] = vv - ev[mt][i] * kS[mt][i]; } }
            const float gam = *(const LAS float*)(lds + SC_SC + 128 * 4);
            bf16x8 rB[2];
#pragma unroll
            for (int k2 = 0; k2 < 2; ++k2) { u32x4 p; p.x = pk2(rr4[2 * k2][0], rr4[2 * k2][1]); p.y = pk2(rr4[2 * k2][2], rr4[2 * k2][3]); p.z = pk2(rr4[2 * k2 + 1][0], rr4[2 * k2 + 1][1]); p.w = pk2(rr4[2 * k2 + 1][2], rr4[2 * k2 + 1][3]); rB[k2] = __builtin_bit_cast(bf16x8, p); }
            f32x4 vn[4];
#pragma unroll
            for (int mt = 0; mt < 4; ++mt) { vn[mt] = (f32x4){0.f, 0.f, 0.f, 0.f};
#pragma unroll
                for (int k2 = 0; k2 < 2; ++k2) { if (k2 == 1 && mt < 2) continue; const bf16x8 ta = *(const LAS bf16x8*)(lds + SC_TB + ((mt * 2 + k2) * 64 + lane) * 16); vn[mt] = MFMA16(ta, rB[k2], vn[mt]); } }
            bf16x8 vB[2], vdB[2];
#pragma unroll
            for (int k2 = 0; k2 < 2; ++k2) { u32x4 p, q;
                p.x = pk2(vn[2 * k2][0], vn[2 * k2][1]); p.y = pk2(vn[2 * k2][2], vn[2 * k2][3]); p.z = pk2(vn[2 * k2 + 1][0], vn[2 * k2 + 1][1]); p.w = pk2(vn[2 * k2 + 1][2], vn[2 * k2 + 1][3]);
                q.x = pk2(vn[2 * k2][0] * dv[2 * k2][0], vn[2 * k2][1] * dv[2 * k2][1]); q.y = pk2(vn[2 * k2][2] * dv[2 * k2][2], vn[2 * k2][3] * dv[2 * k2][3]);
                q.z = pk2(vn[2 * k2 + 1][0] * dv[2 * k2 + 1][0], vn[2 * k2 + 1][1] * dv[2 * k2 + 1][1]); q.w = pk2(vn[2 * k2 + 1][2] * dv[2 * k2 + 1][2], vn[2 * k2 + 1][3] * dv[2 * k2 + 1][3]);
                vB[k2] = __builtin_bit_cast(bf16x8, p); vdB[k2] = __builtin_bit_cast(bf16x8, q); }
            f32x4 o[4];
#pragma unroll
            for (int mt = 0; mt < 4; ++mt) { o[mt] = ev[mt] * qS[mt];
#pragma unroll
                for (int k2 = 0; k2 < 2; ++k2) { if (k2 == 1 && mt < 2) continue; const bf16x8 ia = *(const LAS bf16x8*)(lds + SC_IN + ((mt * 2 + k2) * 64 + lane) * 16); o[mt] = MFMA16(ia, vB[k2], o[mt]); } }
#pragma unroll
            for (int t = 0; t < 8; ++t) { S[t] = S[t] * gam;
#pragma unroll
                for (int k2 = 0; k2 < 2; ++k2) { const bf16x8 kt = *(const LAS bf16x8*)(lds + SC_KT + ((t * 2 + k2) * 64 + lane) * 16); S[t] = MFMA16(kt, vdB[k2], S[t]); } }
            f32x4 ssq[4];
#pragma unroll
            for (int mt = 0; mt < 4; ++mt) { ssq[mt] = o[mt] * o[mt];
#pragma unroll
                for (int i = 0; i < 4; ++i) { float s = ssq[mt][i]; s += __shfl_xor(s, 1); s += __shfl_xor(s, 2); s += __shfl_xor(s, 4); s += __shfl_xor(s, 8); ssq[mt][i] = s; }
                if (col == 0) *(LAS f32x4*)(lds + SC_RED + (w * 64 + 16 * mt + 4 * quad) * 4) = ssq[mt]; }
            __syncthreads();
            const size_t R0 = Rbase + (size_t)64 * n;
#pragma unroll
            for (int mt = 0; mt < 4; ++mt) { f32x4 tot = (f32x4){0.f, 0.f, 0.f, 0.f};
#pragma unroll
                for (int ww = 0; ww < 8; ++ww) tot += *(const LAS f32x4*)(lds + SC_RED + (ww * 64 + 16 * mt + 4 * quad) * 4);
#pragma unroll
                for (int i = 0; i < 4; ++i) { const int tok = 16 * mt + 4 * quad + i;
                    const float z = bf2f(*(const LAS bf16*)(lds + SC_Z + tok * 272 + dvc * 2));
                    const float ov = o[mt][i] * rsqrtf(tot[i] * (1.f / 128.f) + EPS) * ngc * silu(z);
                    if (tok < nv) OG[(R0 + tok) * 1024 + h * 128 + dvc] = f2bf(ov); } }
        }
        const int quad = lane >> 4, dvc = 16 * w + (lane & 15);
#pragma unroll
        for (int t = 0; t < 8; ++t)
#pragma unroll
            for (int i = 0; i < 4; ++i) sout[(size_t)(16 * t + 4 * quad + i) * 128 + dvc] = S[t][i];
    }
    __syncthreads();
#undef SCAN_PREFETCH
}

DI void final_norm_phase(const Args& a, int lane, int w) {
    const float* gf = a.in[7]; const float* ss2 = (const float*)(a.ws + WS_SS2);
    const int gw = blockIdx.x * 8 + w, NGW = gridDim.x * 8;
    f32x4 gv[4];
#pragma unroll
    for (int j = 0; j < 4; ++j) gv[j] = *(const f32x4*)(gf + 4 * lane + 256 * j);
    for (int m = gw; m < MROWS; m += NGW) {
        float* yr = a.out + (size_t)m * DM; const float rs = rsqrtf(ss2[m] * (1.f / DM) + EPS);
#pragma unroll
        for (int j = 0; j < 4; ++j) { f32x4 v = *(const f32x4*)(yr + 4 * lane + 256 * j); v = v * rs * gv[j]; *(f32x4*)(yr + 4 * lane + 256 * j) = v; }
    }
}

#ifndef N_PHASES
#define N_PHASES 10
#endif
__global__ void __launch_bounds__(512, 2) mega_fwd(Args a, int ph_lo, int ph_hi, int coop) {
    extern __shared__ __attribute__((aligned(16))) unsigned char lds_raw[];
    LAS unsigned char* lds = (LAS unsigned char*)lds_raw;
    const int tid = threadIdx.x, lane = tid & 63, w = __builtin_amdgcn_readfirstlane(tid >> 6);
    cg::grid_group grid = cg::this_grid();
    bf16* XN = (bf16*)(a.ws + WS_XN); bf16* BIG = (bf16*)(a.ws + WS_BIG); bf16* OG = (bf16*)(a.ws + WS_OG);
    float* ss1 = (float*)(a.ws + WS_SS1); float* ss2 = (float*)(a.ws + WS_SS2);
#ifndef PH_MASK
#define PH_MASK 0x3ff
#endif
#define IN(k) (((PH_MASK >> (k)) & 1) && ph_lo <= (k) && (k) < ph_hi)
#define SEAM(k) do { if (coop && IN(k) && IN((k) + 1)) grid.sync(); } while (0)
    if (IN(0)) { p0_prologue(a, lds, tid, lane, w); }
    SEAM(0);
    if (IN(1)) { pg8::Gemm g{XN, (const bf16*)(a.ws + WS_W1T), MROWS, 2560, 1024}; pg8::StaticOrder S; S.init(MROWS, 2560, gridDim.x, blockIdx.x);
        EpiQKVG E{BIG, a.out}; pg8::gemm_phase<EpiQKVG, pg8::StaticOrder, true, true>(lds, g, S, E); }
    SEAM(1);
    if (IN(2)) { attn_phase(lds, BIG, a.in[2], a.in[3], a.in[9], OG, tid, lane, w); }
    SEAM(2);
    if (IN(3)) { pg8::Gemm g{OG, (const bf16*)(a.ws + WS_WO1T), MROWS, 1024, 1024}; pg8::StaticOrder S; S.init(MROWS, 1024, gridDim.x, blockIdx.x);
        EpiRes E{a.in[0], a.in[1], a.out, XN, a.in[6] + 1024, ss1}; pg8::gemm_phase<EpiRes, pg8::StaticOrder, true, true>(lds, g, S, E); }
    SEAM(3);
    if (IN(4)) { pg8::Gemm g{XN, (const bf16*)(a.ws + WS_W2T), MROWS, 4352, 1024}; pg8::StaticOrder S; S.init(MROWS, 4352, gridDim.x, blockIdx.x);
        EpiDN E{BIG, (bf16*)(a.ws + WS_HALO), (float*)(a.ws + WS_BA), ss1, a.out}; pg8::gemm_phase<EpiDN, pg8::StaticOrder, true, true>(lds, g, S, E); }
    SEAM(4);
    if (IN(5)) { dn_pre_phase(a, lane, w); }
    SEAM(5);
    if (IN(6)) { dn_prep_phase(a, lds, lane, w); }
    SEAM(6);
    if (IN(7)) { dn_scan_phase(a, lds, tid, lane, w); }
    SEAM(7);
    if (IN(8)) { pg8::Gemm g{OG, (const bf16*)(a.ws + WS_WO2T), MROWS, 1024, 1024}; pg8::StaticOrder S; S.init(MROWS, 1024, gridDim.x, blockIdx.x);
        EpiRes E{a.out, nullptr, a.out, nullptr, nullptr, ss2}; pg8::gemm_phase<EpiRes, pg8::StaticOrder, true, true>(lds, g, S, E); }
    SEAM(8);
    if (IN(9)) { final_norm_phase(a, lane, w); }
#undef IN
#undef SEAM
}

#ifndef MULTI_LAUNCH
#define MULTI_LAUNCH 0
#endif
extern "C" void kernel_launch(void* const* d_in, const int* in_sizes, int n_in, void* d_out, int out_size, void* d_ws, size_t ws_size, hipStream_t stream) {
    static int grid = 0;
    if (grid == 0) {
        int dev = 0, cus = 0, per_cu = 0;
        if (n_in != 17 || ws_size < WS_END) { fprintf(stderr, "kernel_launch: unexpected n_in %d / ws_size %zu\n", n_in, ws_size); grid = -1; return; }
        if (hipGetDevice(&dev) != hipSuccess || hipDeviceGetAttribute(&cus, hipDeviceAttributeMultiprocessorCount, dev) != hipSuccess) { grid = -1; return; }
        if (hipFuncSetAttribute((const void*)mega_fwd, hipFuncAttributeMaxDynamicSharedMemorySize, LDS_BYTES) != hipSuccess) { fprintf(stderr, "kernel_launch: hipFuncSetAttribute failed\n"); grid = -1; return; }
        if (hipOccupancyMaxActiveBlocksPerMultiprocessor(&per_cu, (const void*)mega_fwd, 512, LDS_BYTES) != hipSuccess || per_cu < 1) { fprintf(stderr, "kernel_launch: occupancy query gave %d\n", per_cu); per_cu = 1; }
        (void)hipGetLastError();
        grid = cus * (per_cu > 1 ? 1 : per_cu);
        if (grid < 64) grid = 64;
    }
    if (grid < 0) return;
    Args a{};
    for (int i = 0; i < 17; ++i) a.in[i] = (const float*)d_in[i];
    a.out = (float*)d_out; a.ws = (unsigned char*)d_ws;
#if MULTI_LAUNCH
    for (int p = 0; p < N_PHASES; ++p) { int lo = p, hi = p + 1, coop = 0; hipLaunchKernelGGL(mega_fwd, dim3(grid), dim3(512), LDS_BYTES, stream, a, lo, hi, coop); }
#else
    int lo = 0, hi = N_PHASES, coop = 1;
    void* args[] = {&a, &lo, &hi, &coop};
    hipError_t e = hipLaunchCooperativeKernel((const void*)mega_fwd, dim3(grid), dim3(512), args, LDS_BYTES, stream);
    if (e != hipSuccess) fprintf(stderr, "kernel_launch: cooperative launch failed: %s (grid %d)\n", hipGetErrorString(e), grid);
#endif
}
```

```cpp
#include <hip/hip_runtime.h>
#include <hip/hip_cooperative_groups.h>
#include <cstdio>
#include <cstdint>
namespace cg = cooperative_groups;
namespace pg8 {
#define PG8_LAS __attribute__((address_space(3)))
typedef unsigned short bf16_t;
typedef short bf16x8 __attribute__((ext_vector_type(8)));
typedef float f32x4 __attribute__((ext_vector_type(4)));
typedef unsigned u32x4 __attribute__((ext_vector_type(4)));
constexpr int BM = 256, BK = 64, HALF = 128, HTB = HALF * BK * 2  , STAGE_BYTES = 8 * HTB, NXCD = 8, WGM = 8;

__host__ __device__ __forceinline__ int lds_byte(int r, int c) { const int st = (r >> 4) * 2 + (c >> 5), rr = r & 15, cc = c & 31, ob = rr * 64 + cc * 2; return st * 1024 + (ob ^ (((ob >> 9) & 1) << 5)); }
__host__ __device__ __forceinline__ void stage_rc(int b, int& R, int& C) { const int st = b / 1024, sb = b % 1024, swz = sb ^ (((sb >> 9) & 1) << 5); R = (st >> 1) * 16 + swz / 64; C = (st & 1) * 32 + (swz % 64) / 2; }
__host__ __device__ __forceinline__ int perm32(int rho) { const int n = rho >> 4, i = rho & 15; return 8 * (i >> 2) + 4 * n + (i & 3); }

struct Unit { int pm, pn; };
struct Gemm { const bf16_t* A; const bf16_t* Bt; int M, N, K; };

struct StaticOrder {
    int nM, nN, nwg, G, c;
    __host__ __device__ void init(int M, int N, int G_, int c_) { nM = M / BM; nN = N / BM; nwg = nM * nN; G = G_; c = c_; }
    __host__ __device__ bool next(int i, Unit& u) const {
        const long L = (long)i * G + c; if (L >= nwg) return false;
        int wgid = (int)L; { const int q = nwg / NXCD, r = nwg % NXCD, xcd = wgid % NXCD, off = wgid / NXCD; wgid = (xcd < r ? xcd * (q + 1) : r * (q + 1) + (xcd - r) * q) + off; }
        const int nig = WGM * nN, gid = wgid / nig, fm = gid * WGM, gsz = (nM - fm) < WGM ? (nM - fm) : WGM;
        u.pm = fm + ((wgid % nig) % gsz); u.pn = (wgid % nig) / gsz; return true;
    }
    __device__ __forceinline__ void a_ready(const Unit&) const {}
    __device__ __forceinline__ void done(const Unit&) const {}
};

__device__ __forceinline__ unsigned cvt_pk_bf16(float lo, float hi) { unsigned r; asm volatile("v_cvt_pk_bf16_f32 %0, %1, %2" : "=v"(r) : "v"(lo), "v"(hi)); return r; }

template <class Epi, class Sched, bool ALIGN_EPI = false, bool SP2 = false>
__device__ __forceinline__ void gemm_phase(PG8_LAS unsigned char* lds, const Gemm g, const Sched& S, const Epi& E) {
    const int tid = threadIdx.x, wid = __builtin_amdgcn_readfirstlane(tid >> 6), lane = tid & 63, wr = wid >> 2, wc = wid & 3, fr = lane & 15, fq = lane >> 4;
    const int K = g.K, nt = K / BK;
    unsigned voffA[2], voffB[2];
#pragma unroll
    for (int i = 0; i < 2; ++i) { int R, C; stage_rc(tid * 16 + i * 8192, R, C); const int Rb = Epi::PERM ? ((R & ~31) + perm32(R & 31)) : R;
        voffA[i] = (unsigned)(R * K + C) * 2u; voffB[i] = (unsigned)(Rb * K + C) * 2u; }
    const size_t kstep = (size_t)(BK * 2);
    const size_t hstep = (size_t)HALF * K * 2;
    const size_t tstep = 2 * hstep;
    const unsigned ldsw = (unsigned)wid * 1024u;
    const int aoff = lds_byte(wr * 64 + fr, fq * 8), boff = lds_byte(wc * 32 + fr, fq * 8);
#define PG8_SA(b, h) (((b) * 2 + (h)) * HTB)
#define PG8_SB(b, h) ((4 + (b) * 2 + (h)) * HTB)
#define PG8_STAGE(bufoff, gbase, voff) do { _Pragma("unroll") for (int _i = 0; _i < 2; ++_i) \
        __builtin_amdgcn_global_load_lds((const unsigned*)((const char*)(gbase) + (voff)[_i]), (PG8_LAS unsigned*)(lds + (bufoff) + ldsw + _i * 8192), 16, 0, 0); } while (0)
#define PG8_LDA(dst, b, h) do { _Pragma("unroll") for (int m = 0; m < 4; ++m) _Pragma("unroll") for (int k = 0; k < 2; ++k) dst[m][k] = *(const PG8_LAS bf16x8*)(lds + PG8_SA(b, h) + aoff + m * 2048 + k * 1024); } while (0)
#define PG8_LDB(dst, b, h) do { _Pragma("unroll") for (int n = 0; n < 2; ++n) _Pragma("unroll") for (int k = 0; k < 2; ++k) dst[n][k] = *(const PG8_LAS bf16x8*)(lds + PG8_SB(b, h) + boff + n * 2048 + k * 1024); } while (0)
#define PG8_MMA(ai, bj, At, Bt) do { __builtin_amdgcn_s_setprio(1); _Pragma("unroll") for (int m = 0; m < 4; ++m) _Pragma("unroll") for (int n = 0; n < 2; ++n) _Pragma("unroll") for (int k = 0; k < 2; ++k) \
        acc[ai][bj][m][n] = __builtin_amdgcn_mfma_f32_16x16x32_bf16(Bt[n][k], At[m][k], acc[ai][bj][m][n], 0, 0, 0); __builtin_amdgcn_s_setprio(0); } while (0)
#define PG8_WAIT_V(n) asm volatile("s_waitcnt vmcnt(" #n ")" ::: "memory")
#define PG8_WAIT_L(n) asm volatile("s_waitcnt lgkmcnt(" #n ")" ::: "memory")
#define PG8_BAR __builtin_amdgcn_s_barrier()
#define PG8_SCHED __builtin_amdgcn_sched_barrier(0)
    Unit cur, nxt; int ui = 0;
    if (!S.next(0, cur)) return;
    f32x4 acc[2][2][4][2];
#pragma unroll
    for (int a = 0; a < 2; ++a)
#pragma unroll
        for (int b = 0; b < 2; ++b)
#pragma unroll
            for (int m = 0; m < 4; ++m)
#pragma unroll
                for (int n = 0; n < 2; ++n) acc[a][b][m][n] = (f32x4){0.f, 0.f, 0.f, 0.f};
    bf16x8 At[4][2], B0[2][2], B1[2][2];
    const char* cA = (const char*)g.A + (size_t)cur.pm * tstep; const char* cB = (const char*)g.Bt + (size_t)cur.pn * tstep;
    S.a_ready(cur);
    if constexpr (SP2) {
        PG8_STAGE(PG8_SB(0, 0), cB, voffB); PG8_STAGE(PG8_SB(0, 1), cB + hstep, voffB); PG8_STAGE(PG8_SA(0, 0), cA, voffA); PG8_STAGE(PG8_SA(0, 1), cA + hstep, voffA);
        if (wr == 1) PG8_BAR;
        PG8_WAIT_V(2); PG8_BAR;
        PG8_STAGE(PG8_SB(1, 0), cB + kstep, voffB); PG8_STAGE(PG8_SA(1, 0), cA + kstep, voffA); PG8_STAGE(PG8_SB(1, 1), cB + hstep + kstep, voffB);
        PG8_WAIT_V(6); PG8_BAR;
    } else {
        PG8_STAGE(PG8_SB(0, 0), cB, voffB); PG8_STAGE(PG8_SA(0, 0), cA, voffA); PG8_STAGE(PG8_SB(0, 1), cB + hstep, voffB); PG8_STAGE(PG8_SA(0, 1), cA + hstep, voffA);
        if (wr == 1) PG8_BAR;
        PG8_WAIT_V(4); PG8_BAR;
        PG8_STAGE(PG8_SB(1, 0), cB + kstep, voffB); PG8_STAGE(PG8_SA(1, 0), cA + kstep, voffA); PG8_STAGE(PG8_SB(1, 1), cB + hstep + kstep, voffB);
        PG8_WAIT_V(6); PG8_BAR;
    }
    for (;;) {
        const bool has_next = S.next(ui + 1, nxt);
        const char* nA = has_next ? (const char*)g.A + (size_t)nxt.pm * tstep : cA; const char* nB = has_next ? (const char*)g.Bt + (size_t)nxt.pn * tstep : cB;
        for (int t = 0; t < nt; t += 2) {
            const bool last = (t == nt - 2);
            const char* a1 = cA + (size_t)(t + 1) * kstep;
            const char* a2 = last ? nA : cA + (size_t)(t + 2) * kstep; const char* b2 = last ? nB : cB + (size_t)(t + 2) * kstep;
            const char* a3 = a2 + kstep; const char* b3 = b2 + kstep;
            if (last && has_next) S.a_ready(nxt);
            if constexpr (SP2) {
            PG8_LDB(B0, 0, 0); PG8_LDB(B1, 0, 1); PG8_SCHED; PG8_LDA(At, 0, 0); PG8_STAGE(PG8_SA(1, 1), a1 + hstep, voffA);
            PG8_WAIT_V(8); PG8_WAIT_L(0); PG8_BAR; PG8_MMA(0, 0, At, B0); PG8_MMA(0, 1, At, B1); PG8_BAR; PG8_SCHED;
            PG8_LDA(At, 0, 1); PG8_STAGE(PG8_SB(0, 0), b2, voffB); PG8_STAGE(PG8_SB(0, 1), b2 + hstep, voffB); PG8_STAGE(PG8_SA(0, 0), a2, voffA);
            PG8_WAIT_V(8); PG8_WAIT_L(0); PG8_BAR; PG8_MMA(1, 0, At, B0); PG8_MMA(1, 1, At, B1); PG8_BAR; PG8_SCHED;
            PG8_LDB(B0, 1, 0); PG8_LDB(B1, 1, 1); PG8_SCHED; PG8_LDA(At, 1, 0); PG8_STAGE(PG8_SA(0, 1), a2 + hstep, voffA);
            PG8_WAIT_V(8); PG8_WAIT_L(0); PG8_BAR; PG8_MMA(0, 0, At, B0); PG8_MMA(0, 1, At, B1); PG8_BAR; PG8_SCHED;
            PG8_LDA(At, 1, 1); PG8_STAGE(PG8_SB(1, 0), b3, voffB); PG8_STAGE(PG8_SB(1, 1), b3 + hstep, voffB); PG8_STAGE(PG8_SA(1, 0), a3, voffA);
            PG8_WAIT_V(8); PG8_WAIT_L(0); PG8_BAR; PG8_MMA(1, 0, At, B0); PG8_MMA(1, 1, At, B1); PG8_BAR; PG8_SCHED;
            } else {
            PG8_LDB(B0, 0, 0); PG8_SCHED; PG8_LDA(At, 0, 0); PG8_STAGE(PG8_SA(1, 1), a1 + hstep, voffA);
            PG8_WAIT_L(8); PG8_BAR; PG8_WAIT_L(0); PG8_MMA(0, 0, At, B0); PG8_BAR; PG8_SCHED;
            PG8_LDB(B1, 0, 1); PG8_STAGE(PG8_SB(0, 0), b2, voffB);
            PG8_BAR; PG8_WAIT_L(0); PG8_MMA(0, 1, At, B1); PG8_BAR;
            PG8_LDA(At, 0, 1); PG8_STAGE(PG8_SA(0, 0), a2, voffA);
            PG8_BAR; PG8_WAIT_L(0); PG8_MMA(1, 0, At, B0); PG8_BAR; PG8_SCHED;
            PG8_STAGE(PG8_SB(0, 1), b2 + hstep, voffB);
            PG8_WAIT_V(6); PG8_BAR; PG8_MMA(1, 1, At, B1); PG8_BAR;
            PG8_LDB(B0, 1, 0); PG8_SCHED; PG8_LDA(At, 1, 0); PG8_STAGE(PG8_SA(0, 1), a2 + hstep, voffA);
            PG8_WAIT_L(8); PG8_BAR; PG8_WAIT_L(0); PG8_MMA(0, 0, At, B0); PG8_BAR; PG8_SCHED;
            PG8_LDB(B1, 1, 1); PG8_STAGE(PG8_SB(1, 0), b3, voffB);
            PG8_BAR; PG8_WAIT_L(0); PG8_MMA(0, 1, At, B1); PG8_BAR;
            PG8_LDA(At, 1, 1); PG8_STAGE(PG8_SA(1, 0), a3, voffA);
            PG8_BAR; PG8_WAIT_L(0); PG8_MMA(1, 0, At, B0); PG8_BAR; PG8_SCHED;
            PG8_STAGE(PG8_SB(1, 1), b3 + hstep, voffB);
            PG8_WAIT_V(6); PG8_BAR; PG8_MMA(1, 1, At, B1); PG8_BAR;
            }
        }
        if constexpr (ALIGN_EPI) { if (wr == 0) PG8_BAR; }
        if constexpr (!Epi::AFTER_DRAIN) { E(acc, cur, wr, wc, fr, fq); S.done(cur); }
        if (!has_next) break;
#pragma unroll
        for (int a = 0; a < 2; ++a)
#pragma unroll
            for (int b = 0; b < 2; ++b)
#pragma unroll
                for (int m = 0; m < 4; ++m)
#pragma unroll
                    for (int n = 0; n < 2; ++n) acc[a][b][m][n] = (f32x4){0.f, 0.f, 0.f, 0.f};
        cur = nxt; cA = nA; cB = nB; ++ui;
        if constexpr (ALIGN_EPI) { if (wr == 1) PG8_BAR; }
    }
    PG8_WAIT_V(0);
    if constexpr (!ALIGN_EPI) { if (wr == 0) PG8_BAR; }
    PG8_BAR;
    if constexpr (Epi::AFTER_DRAIN) { E.fused(acc, cur, wr, wc, fr, fq, lds, wid, lane); S.done(cur); }
#undef PG8_SA
#undef PG8_SB
#undef PG8_STAGE
#undef PG8_LDA
#undef PG8_LDB
#undef PG8_MMA
#undef PG8_WAIT_V
#undef PG8_WAIT_L
#undef PG8_BAR
#undef PG8_SCHED
}
}

#define LAS __attribute__((address_space(3)))
typedef unsigned short bf16;
typedef short bf16x8 __attribute__((ext_vector_type(8)));
typedef float f32x4 __attribute__((ext_vector_type(4)));
typedef float f32x16 __attribute__((ext_vector_type(16)));
typedef unsigned u32x4 __attribute__((ext_vector_type(4)));
typedef unsigned u32x2 __attribute__((ext_vector_type(2)));
typedef __bf16 bf16x2_t __attribute__((ext_vector_type(2)));
typedef float f32x2_t __attribute__((ext_vector_type(2)));
#define MFMA32(a, b, c) __builtin_amdgcn_mfma_f32_32x32x16_bf16((a), (b), (c), 0, 0, 0)
#define MFMA16(a, b, c) __builtin_amdgcn_mfma_f32_16x16x32_bf16((a), (b), (c), 0, 0, 0)
#define DI __device__ __forceinline__
#define LDS_BARRIER() do { asm volatile("s_waitcnt lgkmcnt(0)" ::: "memory"); __builtin_amdgcn_s_barrier(); asm volatile("" ::: "memory"); } while (0)

constexpr int DM = 1024, MROWS = 33792, MP = 32768;
constexpr float EPS = 1e-6f;
constexpr float LOG2E = 1.4426950408889634f;
constexpr float QSCALE = 0.125f * LOG2E;
constexpr size_t O_KWP = 34603008, O_VWP = 34865152, O_CONVP = 35127296, O_SSMP = 35201024, O_KWS = 36249600, O_VWS = 37298176, O_CONVS = 38346752, O_SSMS = 38641664;
constexpr size_t MiB = 1u << 20;
constexpr size_t WS_W1T = 1 * MiB, WS_WO1T = 6 * MiB, WS_W2T = 8 * MiB, WS_WO2T = 17 * MiB, WS_BA = 19 * MiB, WS_SS1 = 22 * MiB, WS_SS2 = 22 * MiB + 512 * 1024,
                 WS_HALO = 23 * MiB, WS_SCAL = 33 * MiB, WS_XN = 40 * MiB  , WS_BIG = 110 * MiB  , WS_OG = 374 * MiB, WS_KT = 440 * MiB, WS_END = 508 * MiB;
constexpr int LDS_BYTES = 143360;

DI unsigned pk2(float lo, float hi) { f32x2_t v = {lo, hi}; bf16x2_t b = __builtin_convertvector(v, bf16x2_t); return __builtin_bit_cast(unsigned, b); }
DI float bflo(unsigned u) { return __builtin_bit_cast(float, u << 16); }
DI float bfhi(unsigned u) { return __builtin_bit_cast(float, u & 0xffff0000u); }
DI float bf2f(bf16 u) { return __builtin_bit_cast(float, (unsigned)u << 16); }
DI bf16 f2bf(float f) { return (bf16)(pk2(f, 0.f) & 0xffffu); }
DI int crow(int i, int h) { return (i & 3) + 8 * (i >> 2) + 4 * h; }
DI float fexp2(float x) { return __builtin_amdgcn_exp2f(x); }
DI float silu(float x) { return x / (1.f + __expf(-x)); }
DI float wave_sum(float v) {
#pragma unroll
    for (int o = 1; o < 64; o <<= 1) v += __shfl_xor(v, o);
    return v;
}
DI u32x4 pack8f(const float* p) { u32x4 r; r.x = pk2(p[0], p[1]); r.y = pk2(p[2], p[3]); r.z = pk2(p[4], p[5]); r.w = pk2(p[6], p[7]); return r; }
DI u32x4 ld8f_bf(const float* p) { const f32x4 a = *(const f32x4*)p, b = *(const f32x4*)(p + 4); u32x4 r; r.x = pk2(a.x, a.y); r.y = pk2(a.z, a.w); r.z = pk2(b.x, b.y); r.w = pk2(b.z, b.w); return r; }

#define XB_TMO      128
#define XB_XCNT(j)  (256  + 64 * (j))
#define XB_XSUB(j)  (1280 + 64 * (j))
#define XB_XGEN(j)  (2304 + 64 * (j))
#define XB_TOP      3328
#define XB_TOPGEN   3392
#define XCD_BAR_WORDS 3456
#define XB_SPIN_CAP (1u << 18)

__device__ __forceinline__ unsigned xb_ld(unsigned* p)              { return __hip_atomic_load(p, __ATOMIC_RELAXED, __HIP_MEMORY_SCOPE_AGENT); }
__device__ __forceinline__ unsigned xb_add(unsigned* p, unsigned v) { return __hip_atomic_fetch_add(p, v, __ATOMIC_RELAXED, __HIP_MEMORY_SCOPE_AGENT); }
__device__ __forceinline__ unsigned xb_xcc_id() { return (unsigned)__builtin_amdgcn_s_getreg((3 << 11) | 20) & 0xFu; }
#define XB_SPIN(cond, bar) do { unsigned _sp = 0; while (cond) { __builtin_amdgcn_s_sleep(1); \
    if ((++_sp & 255u) == 0u) { if (xb_ld(&(bar)[XB_TMO])) break; if (_sp > XB_SPIN_CAP) { atomicAdd(&(bar)[XB_TMO], 1u); break; } } } } while (0)

struct XcdBarrier {
    unsigned* bar; unsigned x;
    volatile LAS unsigned* st;
};

__device__ __forceinline__ XcdBarrier xcd_barrier_post(unsigned* bar, volatile LAS unsigned* st) {
    XcdBarrier b; b.bar = bar; b.x = xb_xcc_id(); b.st = st;
    if (threadIdx.x == 0) (void)xb_add(&bar[XB_XCNT(b.x)], 1u);
    return b;
}
__device__ __forceinline__ void xcd_barrier_complete(unsigned* bar, unsigned x, unsigned& nloc, unsigned& nx) {
    const unsigned G = gridDim.x * gridDim.y * gridDim.z;
    unsigned sum, cnt, mine, sp = 0u;
    for (;;) {
        sum = 0u; cnt = 0u; mine = 0u;
#pragma unroll
        for (unsigned j = 0; j < 16; ++j) { const unsigned c = xb_ld(&bar[XB_XCNT(j)]); sum += c; cnt += (c > 0u) ? 1u : 0u; mine = (j == x) ? c : mine; }
        if (sum == G) break;
        __builtin_amdgcn_s_sleep(1);
        if ((++sp & 255u) == 0u) { if (xb_ld(&bar[XB_TMO])) break; if (sp > XB_SPIN_CAP) { atomicAdd(&bar[XB_TMO], 1u); break; } }
    }
    nloc = mine > 0u ? mine : 1u; nx = cnt > 0u ? cnt : 1u;
}

__device__ __forceinline__ void xcd_barrier(const XcdBarrier& b) {
    asm volatile("s_waitcnt vmcnt(0)" ::: "memory");
    __syncthreads();
    if (threadIdx.x == 0) {
        unsigned* bar = b.bar;
        __builtin_amdgcn_s_waitcnt(0);
        unsigned nloc = b.st[0], nx = b.st[1];
        if (nloc == 0u) { xcd_barrier_complete(bar, b.x, nloc, nx); b.st[0] = nloc; b.st[1] = nx; }
        const unsigned old = xb_add(&bar[XB_XSUB(b.x)], 1u);
        const unsigned gen = old / nloc;
        if (old + 1u == (gen + 1u) * nloc) {
            __builtin_amdgcn_fence(__ATOMIC_RELEASE, "agent");
            asm volatile("s_waitcnt vmcnt(0)" ::: "memory");
            const unsigned og = xb_add(&bar[XB_TOP], 1u);
            const unsigned tg = og / nx;
            if (og + 1u == (tg + 1u) * nx) xb_add(&bar[XB_TOPGEN], 1u);
            else XB_SPIN(xb_ld(&bar[XB_TOPGEN]) == tg, bar);
            __builtin_amdgcn_fence(__ATOMIC_ACQUIRE, "agent");
            xb_add(&bar[XB_XGEN(b.x)], 1u);
            asm volatile("s_waitcnt vmcnt(0)" ::: "memory");
        } else {
            XB_SPIN(xb_ld(&bar[XB_XGEN(b.x)]) == gen, bar);
            __builtin_amdgcn_fence(__ATOMIC_ACQUIRE, "agent");
            asm volatile("s_waitcnt vmcnt(0)" ::: "memory");
        }
    }
    __syncthreads();
}

struct EpiQKVG {
    static constexpr bool PERM = true, AFTER_DRAIN = false;
    bf16* O; float* dout;
    DI void operator()(const pg8::f32x4 (&acc)[2][2][4][2], const pg8::Unit& u, int wr, int wc, int fr, int fq) const {
        const float sc = (u.pn < 4) ? QSCALE : 1.f;
        const bool kv = (u.pn == 4 || u.pn == 5);
#pragma unroll
        for (int ai = 0; ai < 2; ++ai)
#pragma unroll
            for (int m = 0; m < 4; ++m) {
                const int row = u.pm * 256 + ai * 128 + wr * 64 + m * 16 + fr;
                float* wdst = nullptr;
                if (kv) {
                    if (row < MP) { const int t = row & 4095; if (t >= 3968) wdst = dout + (u.pn == 4 ? O_KWP : O_VWP) + ((size_t)((row >> 12) * 128 + (t - 3968))) * 256; }
                    else { const int s = row - MP; wdst = dout + (u.pn == 4 ? O_KWS : O_VWS) + ((size_t)((s >> 5) * 128 + 96 + (s & 31))) * 256; }
                }
#pragma unroll
                for (int bj = 0; bj < 2; ++bj) {
                    const int cin = bj * 128 + wc * 32 + 8 * fq;
                    const f32x4 v0 = acc[ai][bj][m][0] * sc, v1 = acc[ai][bj][m][1] * sc;
                    u32x4 w; w.x = pk2(v0[0], v0[1]); w.y = pk2(v0[2], v0[3]); w.z = pk2(v1[0], v1[1]); w.w = pk2(v1[2], v1[3]);
                    *(u32x4*)(O + (size_t)row * 2560 + u.pn * 256 + cin) = w;
                    if (wdst) { *(f32x4*)(wdst + cin) = v0; *(f32x4*)(wdst + cin + 4) = v1; }
                }
            }
    }
};

struct EpiRes {
    static constexpr bool PERM = true, AFTER_DRAIN = false;
    const float* xp; const float* xs; float* y; bf16* XN; const float* g; float* ss;
    DI void operator()(const pg8::f32x4 (&acc)[2][2][4][2], const pg8::Unit& u, int wr, int wc, int fr, int fq) const {
#pragma unroll
        for (int ai = 0; ai < 2; ++ai)
#pragma unroll
            for (int m = 0; m < 4; ++m) {
                const int row = u.pm * 256 + ai * 128 + wr * 64 + m * 16 + fr;
                const float* xr = (row < MP || xs == nullptr) ? xp + (size_t)row * DM : xs + (size_t)(row - MP) * DM;
                float s = 0.f;
#pragma unroll
                for (int bj = 0; bj < 2; ++bj) {
                    const int col = u.pn * 256 + bj * 128 + wc * 32 + 8 * fq;
                    const f32x4 a0 = *(const f32x4*)(xr + col), a1 = *(const f32x4*)(xr + col + 4);
                    const f32x4 v0 = acc[ai][bj][m][0] + a0, v1 = acc[ai][bj][m][1] + a1;
                    *(f32x4*)(y + (size_t)row * DM + col) = v0; *(f32x4*)(y + (size_t)row * DM + col + 4) = v1;
                    s += (v0[0] * v0[0] + v0[1] * v0[1]) + (v0[2] * v0[2] + v0[3] * v0[3]) + (v1[0] * v1[0] + v1[1] * v1[1]) + (v1[2] * v1[2] + v1[3] * v1[3]);
                    if (XN) {
                        const f32x4 g0 = *(const f32x4*)(g + col), g1 = *(const f32x4*)(g + col + 4);
                        u32x4 w; w.x = pk2(v0[0] * g0[0], v0[1] * g0[1]); w.y = pk2(v0[2] * g0[2], v0[3] * g0[3]); w.z = pk2(v1[0] * g1[0], v1[1] * g1[1]); w.w = pk2(v1[2] * g1[2], v1[3] * g1[3]);
                        *(u32x4*)(XN + (size_t)row * DM + col) = w;
                    }
                }
                s += __shfl_xor(s, 16); s += __shfl_xor(s, 32);
                if (fq == 0) atomicAdd(ss + row, s);
            }
    }
};

struct EpiDN {
    static constexpr bool PERM = true, AFTER_DRAIN = false;
    bf16* O; bf16* halo; float* ba; const float* ss; float* dout;
    DI void operator()(const pg8::f32x4 (&acc)[2][2][4][2], const pg8::Unit& u, int wr, int wc, int fr, int fq) const {
#pragma unroll
        for (int ai = 0; ai < 2; ++ai)
#pragma unroll
            for (int m = 0; m < 4; ++m) {
                const int row = u.pm * 256 + ai * 128 + wr * 64 + m * 16 + fr;
                const float sc = rsqrtf(ss[row] * (1.f / DM) + EPS);
                if (u.pn < 16) {
                    bf16* hdst = nullptr; float* cdst = nullptr;
                    if (u.pn < 12) {
                        if (row < MP) { const int t = row & 63; if (t >= 61) hdst = halo + ((size_t)(row >> 6) * 3 + (t - 61)) * 3072;
                                        const int t4 = row & 4095; if (t4 >= 4093) cdst = dout + O_CONVP + ((size_t)(row >> 12) * 3 + (t4 - 4093)) * 3072; }
                        else { const int s = row - MP, t = s & 31; if (t >= 29) cdst = dout + O_CONVS + ((size_t)(s >> 5) * 3 + (t - 29)) * 3072; }
                    }
#pragma unroll
                    for (int bj = 0; bj < 2; ++bj) {
                        const int col = u.pn * 256 + bj * 128 + wc * 32 + 8 * fq;
                        const f32x4 v0 = acc[ai][bj][m][0] * sc, v1 = acc[ai][bj][m][1] * sc;
                        u32x4 w; w.x = pk2(v0[0], v0[1]); w.y = pk2(v0[2], v0[3]); w.z = pk2(v1[0], v1[1]); w.w = pk2(v1[2], v1[3]);
                        *(u32x4*)(O + (size_t)row * 4096 + col) = w;
                        if (hdst) *(u32x4*)(hdst + col) = w;
                        if (cdst) { *(f32x4*)(cdst + col) = v0; *(f32x4*)(cdst + col + 4) = v1; }
                    }
                } else if (wc == 0 && fq < 2) {
                    const f32x4 v0 = acc[ai][0][m][0] * sc, v1 = acc[ai][0][m][1] * sc;
                    *(f32x4*)(ba + (size_t)row * 16 + 8 * fq) = v0; *(f32x4*)(ba + (size_t)row * 16 + 8 * fq + 4) = v1;
                }
            }
    }
};

DI void p0_transpose_item(const float* W, int K, int ld, int nblk, bf16* WT, LAS float* scr, int item, int lane) {
    const int kb = item / nblk, nb = item % nblk, k0 = 64 * kb, n0 = 32 * nb;
#pragma unroll 8
    for (int i = 0; i < 32; ++i) { const int kk = 2 * i + (lane >> 5); scr[kk * 33 + (lane & 31)] = W[(size_t)(k0 + kk) * ld + n0 + (lane & 31)]; }
    asm volatile("s_waitcnt lgkmcnt(0)" ::: "memory");
    const int c = lane & 7;
#pragma unroll
    for (int j = 0; j < 4; ++j) { const int n = (lane >> 3) + 8 * j; const LAS float* s = scr + (8 * c) * 33 + n;
        u32x4 o; o.x = pk2(s[0 * 33], s[1 * 33]); o.y = pk2(s[2 * 33], s[3 * 33]); o.z = pk2(s[4 * 33], s[5 * 33]); o.w = pk2(s[6 * 33], s[7 * 33]);
        *(u32x4*)(WT + (size_t)(n0 + n) * K + k0 + 8 * c) = o; }
    asm volatile("s_waitcnt lgkmcnt(0)" ::: "memory");
}

struct Args { const float* in[17]; float* out; unsigned char* ws; };

DI void p0_prologue(const Args& a, LAS unsigned char* lds, int tid, int lane, int w) {
    LAS float* scr = (LAS float*)(lds + w * 16384);
    const int gw = blockIdx.x * 8 + w, NGW = gridDim.x * 8;
    const float* W1 = a.in[8]; const float* Wo1 = a.in[10]; const float* W2 = a.in[11]; const float* Wo2 = a.in[16];
    bf16* W1T = (bf16*)(a.ws + WS_W1T); bf16* WO1T = (bf16*)(a.ws + WS_WO1T); bf16* W2T = (bf16*)(a.ws + WS_W2T); bf16* WO2T = (bf16*)(a.ws + WS_WO2T);
    constexpr int I1 = 16 * 80, I2 = 16 * 32, I3 = 16 * 128, I4 = 16 * 32;
    for (int it = gw; it < I1 + I2 + I3 + I4; it += NGW) {
        int r = it;
        if (r < I1) { p0_transpose_item(W1, 1024, 2560, 80, W1T, scr, r, lane); continue; } r -= I1;
        if (r < I2) { p0_transpose_item(Wo1, 1024, 1024, 32, WO1T, scr, r, lane); continue; } r -= I2;
        if (r < I3) { p0_transpose_item(W2, 1024, 4112, 128, W2T, scr, r, lane); continue; } r -= I3;
        p0_transpose_item(Wo2, 1024, 1024, 32, WO2T, scr, r, lane);
    }
    const int gt = blockIdx.x * 512 + tid, NGT = gridDim.x * 512;
    for (int i = gt; i < 16 * 1024; i += NGT) { const int n = i >> 10, k = i & 1023; W2T[(size_t)(4096 + n) * 1024 + k] = f2bf(W2[(size_t)k * 4112 + 4096 + n]); }
    for (int i = gt; i < 240 * 1024 / 8; i += NGT) *(u32x4*)(W2T + (size_t)4112 * 1024 + (size_t)i * 8) = (u32x4){0u, 0u, 0u, 0u};
    float* ss1 = (float*)(a.ws + WS_SS1); float* ss2 = (float*)(a.ws + WS_SS2);
    for (int i = gt; i < MROWS; i += NGT) { ss1[i] = 0.f; ss2[i] = 0.f; }
    const float* ck = a.in[2]; const float* cv = a.in[3];
    for (int i = gt; i < 32 * 96 * 64; i += NGT) { const int sb = i / (96 * 64), rem = i % (96 * 64);
        *(f32x4*)(a.out + O_KWS + (size_t)sb * 32768 + (size_t)rem * 4) = *(const f32x4*)(ck + (size_t)sb * 32768 + 32 * 256 + (size_t)rem * 4);
        *(f32x4*)(a.out + O_VWS + (size_t)sb * 32768 + (size_t)rem * 4) = *(const f32x4*)(cv + (size_t)sb * 32768 + 32 * 256 + (size_t)rem * 4); }
    const float* g0 = a.in[6]; bf16* XN = (bf16*)(a.ws + WS_XN);
    f32x4 gv[4];
#pragma unroll
    for (int j = 0; j < 4; ++j) gv[j] = *(const f32x4*)(g0 + 4 * lane + 256 * j);
    for (int m = gw; m < MROWS; m += NGW) {
        const float* xr = (m < MP) ? a.in[0] + (size_t)m * DM : a.in[1] + (size_t)(m - MP) * DM;
        f32x4 v[4]; float s = 0.f;
#pragma unroll
        for (int j = 0; j < 4; ++j) { v[j] = *(const f32x4*)(xr + 4 * lane + 256 * j); s += (v[j].x * v[j].x + v[j].y * v[j].y) + (v[j].z * v[j].z + v[j].w * v[j].w); }
        const float rs = rsqrtf(wave_sum(s) * (1.f / DM) + EPS);
#pragma unroll
        for (int j = 0; j < 4; ++j) { u32x2 o; o.x = pk2(v[j].x * rs * gv[j].x, v[j].y * rs * gv[j].y); o.y = pk2(v[j].z * rs * gv[j].z, v[j].w * rs * gv[j].w);
            *(u32x2*)(XN + (size_t)m * DM + 4 * lane + 256 * j) = o; }
    }
}

DI void attn_phase(LAS unsigned char* lds, const bf16* QKVG, const float* cache_k, const float* cache_v, const float* sinks, bf16* OG, int tid, int lane, int w) {
    LAS bf16* Ks = (LAS bf16*)lds;
    LAS bf16* VT = (LAS bf16*)(lds + 192 * 72 * 2);
    for (int u = blockIdx.x; u < 2176; u += gridDim.x) {
        asm volatile("" : "+v"(lane), "+v"(tid));
        const int r = lane & 31, hh = lane >> 5;
        int kvh, jmin, jmax, qrow0, sb = 0; bool sample;
        if (u < 2048) { kvh = u & 3; const int bn = u >> 2, b = bn >> 6, n = bn & 63; qrow0 = b * 4096 + 64 * n; jmin = n < 2 ? 64 * (2 - n) : 0; jmax = 192; sample = false; }
        else { const int su = u - 2048; kvh = su & 3; sb = su >> 2; qrow0 = MP + 32 * sb; jmin = 0; jmax = 160; sample = true; }
        __syncthreads();
#pragma unroll
        for (int i = 0; i < 3; ++i) {
            const int id = tid + 512 * i, j = id >> 3, c8 = id & 7;
            u32x4 kv = (u32x4){0u, 0u, 0u, 0u}, vv = (u32x4){0u, 0u, 0u, 0u};
            if (!sample) {
                if (j >= jmin) { const size_t row = (size_t)(qrow0 - 128 + j); kv = *(const u32x4*)(QKVG + row * 2560 + 1024 + kvh * 64 + c8 * 8); vv = *(const u32x4*)(QKVG + row * 2560 + 1280 + kvh * 64 + c8 * 8); }
            } else {
                if (j < 128) { const size_t off = ((size_t)(sb * 128 + j) * 4 + kvh) * 64 + c8 * 8; kv = ld8f_bf(cache_k + off); vv = ld8f_bf(cache_v + off); }
                else if (j < 160) { const size_t row = (size_t)(qrow0 + j - 128); kv = *(const u32x4*)(QKVG + row * 2560 + 1024 + kvh * 64 + c8 * 8); vv = *(const u32x4*)(QKVG + row * 2560 + 1280 + kvh * 64 + c8 * 8); }
            }
            *(LAS u32x4*)(Ks + j * 72 + c8 * 8) = kv;
            const int pos = (j & ~31) | (((j >> 4) & 1) << 4) | (((j >> 2) & 1) << 3) | (((j >> 3) & 1) << 2) | (j & 3);
#pragma unroll
            for (int e = 0; e < 4; ++e) { VT[(c8 * 8 + 2 * e) * 200 + pos] = (bf16)(vv[e] & 0xffffu); VT[(c8 * 8 + 2 * e + 1) * 200 + pos] = (bf16)(vv[e] >> 16); }
        }
        __syncthreads();
        const int g = w >> 1, th = w & 1;
        if (!(sample && th == 1)) {
            const int head = kvh * 4 + g;
            const size_t qrow = (size_t)(qrow0 + 32 * th + r);
            bf16x8 qf[4];
#pragma unroll
            for (int s = 0; s < 4; ++s) qf[s] = *(const bf16x8*)(QKVG + qrow * 2560 + head * 64 + 16 * s + 8 * hh);
            f32x16 sc[6];
#pragma unroll
            for (int kt = 0; kt < 6; ++kt) {
#pragma unroll
                for (int i = 0; i < 16; ++i) sc[kt][i] = 0.f;
#pragma unroll
                for (int s = 0; s < 4; ++s) { const bf16x8 kf = *(const LAS bf16x8*)(Ks + (32 * kt + r) * 72 + 16 * s + 8 * hh); sc[kt] = MFMA32(kf, qf[s], sc[kt]); }
                __builtin_amdgcn_sched_barrier(0);
            }
            const float slope2 = fexp2(-0.5f * (float)(head + 1)) * LOG2E;
            const float sink2 = sinks[head] * LOG2E;
            const int t = 32 * th + r;
            float mx = sink2;
#pragma unroll
            for (int kt = 0; kt < 6; ++kt)
#pragma unroll
                for (int i = 0; i < 16; ++i) { const int j = 32 * kt + crow(i, hh); const float dist = fabsf((float)(128 + t - j));
                    float l = sc[kt][i] - slope2 * dist; l = (j >= jmin && j < jmax) ? l : -INFINITY; sc[kt][i] = l; mx = fmaxf(mx, l); }
            mx = fmaxf(mx, __shfl_xor(mx, 32));
            float sum = 0.f;
#pragma unroll
            for (int kt = 0; kt < 6; ++kt)
#pragma unroll
                for (int i = 0; i < 16; ++i) { const float p = fexp2(sc[kt][i] - mx); sc[kt][i] = p; sum += p; }
            sum += __shfl_xor(sum, 32);
            const float inv = 1.f / (sum + fexp2(sink2 - mx));
            f32x16 o[2];
#pragma unroll
            for (int i = 0; i < 16; ++i) { o[0][i] = 0.f; o[1][i] = 0.f; }
#pragma unroll
            for (int kt = 0; kt < 6; ++kt)
#pragma unroll
                for (int s = 0; s < 2; ++s) {
                    u32x4 pp; pp.x = pk2(sc[kt][8 * s], sc[kt][8 * s + 1]); pp.y = pk2(sc[kt][8 * s + 2], sc[kt][8 * s + 3]); pp.z = pk2(sc[kt][8 * s + 4], sc[kt][8 * s + 5]); pp.w = pk2(sc[kt][8 * s + 6], sc[kt][8 * s + 7]);
                    const bf16x8 pf = __builtin_bit_cast(bf16x8, pp);
#pragma unroll
                    for (int mt = 0; mt < 2; ++mt) { const bf16x8 vf = *(const LAS bf16x8*)(VT + (32 * mt + r) * 200 + 32 * kt + 16 * s + 8 * hh); o[mt] = MFMA32(vf, pf, o[mt]); }
                    __builtin_amdgcn_sched_barrier(0);
                }
#pragma unroll
            for (int mt = 0; mt < 2; ++mt)
#pragma unroll
                for (int i4 = 0; i4 < 4; ++i4) {
                    const int d0 = 32 * mt + 8 * i4 + 4 * hh;
                    const u32x2 gz = *(const u32x2*)(QKVG + qrow * 2560 + 1536 + head * 64 + d0);
                    const float o0 = o[mt][4 * i4] * inv * silu(bflo(gz.x)), o1 = o[mt][4 * i4 + 1] * inv * silu(bfhi(gz.x));
                    const float o2 = o[mt][4 * i4 + 2] * inv * silu(bflo(gz.y)), o3 = o[mt][4 * i4 + 3] * inv * silu(bfhi(gz.y));
                    u32x2 ov; ov.x = pk2(o0, o1); ov.y = pk2(o2, o3);
                    *(u32x2*)(OG + qrow * 1024 + head * 64 + d0) = ov;
                }
        }
    }
    __syncthreads();
}

DI u32x4 zero4() { return (u32x4){0u, 0u, 0u, 0u}; }
DI float bfe(const u32x4& v, int e) { const unsigned u = v[e >> 1]; return (e & 1) ? bfhi(u) : bflo(u); }

DI void dn_pre_phase(const Args& a, int lane, int w) {
    bf16* DNP = (bf16*)(a.ws + WS_BIG); const bf16* HALO = (const bf16*)(a.ws + WS_HALO); float* BA = (float*)(a.ws + WS_BA);
    const float* state_conv = a.in[4]; const float* conv_w = a.in[12]; const float* a_log = a.in[13]; const float* dt_bias = a.in[14];
    const int gw = blockIdx.x * 8 + w, NGW = gridDim.x * 8;
    for (int it = gw; it < 528 * 25; it += NGW) {
        asm volatile("" : "+v"(lane));
        const int ch = it / 25, sub = it % 25;
        if (sub == 24) {
            const size_t row = (size_t)64 * ch + lane; const int width = ch < 512 ? 64 : 32;
            float bv[8], gv[8];
#pragma unroll
            for (int hh = 0; hh < 8; ++hh) { bv[hh] = BA[row * 16 + hh]; gv[hh] = BA[row * 16 + 8 + hh]; }
#pragma unroll
            for (int hh = 0; hh < 8; ++hh) {
                const float beta = 1.f / (1.f + __expf(-bv[hh]));
                const float x = gv[hh] + dt_bias[hh]; const float sp = x > 20.f ? x : log1pf(expf(x));
                float gg = -expf(a_log[hh]) * sp;
#pragma unroll
                for (int d = 1; d < 64; d <<= 1) { const float t = __shfl_up(gg, d, 64); if ((lane & (width - 1)) >= d && d < width) gg += t; }
                BA[row * 16 + hh] = beta; BA[row * 16 + 8 + hh] = gg;
            }
            continue;
        }
        const int h = sub / 3, sec = sub % 3;
        const int g = lane >> 4, cl = lane & 15;
        const int col = sec * 1024 + h * 128 + 8 * cl;
        const size_t R0 = (size_t)64 * ch + 16 * g;
        u32x4 xin[19];
#pragma unroll
        for (int i = 0; i < 16; ++i) xin[3 + i] = *(const u32x4*)(DNP + (R0 + i) * 4096 + col);
        if (ch < 512) {
            if (g > 0) {
#pragma unroll
                for (int i = 0; i < 3; ++i) xin[i] = *(const u32x4*)(DNP + (R0 - 3 + i) * 4096 + col);
            } else if ((ch & 63) == 0) { xin[0] = zero4(); xin[1] = zero4(); xin[2] = zero4(); }
            else {
#pragma unroll
                for (int i = 0; i < 3; ++i) xin[i] = *(const u32x4*)(HALO + ((size_t)(ch - 1) * 3 + i) * 3072 + col);
            }
        } else {
            if (g & 1) {
#pragma unroll
                for (int i = 0; i < 3; ++i) xin[i] = *(const u32x4*)(DNP + (R0 - 3 + i) * 4096 + col);
            } else { const int sb = 2 * (ch - 512) + (g >> 1);
#pragma unroll
                for (int i = 0; i < 3; ++i) xin[i] = ld8f_bf(state_conv + ((size_t)sb * 3 + i) * 3072 + col);
            }
        }
        float wv[4][8];
#pragma unroll
        for (int j = 0; j < 4; ++j) { const f32x4 w0 = *(const f32x4*)(conv_w + (size_t)j * 3072 + col), w1 = *(const f32x4*)(conv_w + (size_t)j * 3072 + col + 4);
            wv[j][0] = w0.x; wv[j][1] = w0.y; wv[j][2] = w0.z; wv[j][3] = w0.w; wv[j][4] = w1.x; wv[j][5] = w1.y; wv[j][6] = w1.z; wv[j][7] = w1.w; }
        asm volatile("s_waitcnt vmcnt(0)" ::: "memory");
        const int clp = cl & 3, pos0 = 32 * (cl >> 2) + 16 * (clp & 1) + 4 * (clp >> 1);
#pragma unroll
        for (int i = 0; i < 16; ++i) {
            float y[8]; float ssq = 0.f;
#pragma unroll
            for (int e = 0; e < 8; ++e) { float t = wv[0][e] * bfe(xin[i], e) + wv[1][e] * bfe(xin[i + 1], e) + wv[2][e] * bfe(xin[i + 2], e) + wv[3][e] * bfe(xin[i + 3], e);
                t = silu(t); y[e] = t; ssq += t * t; }
            if (sec < 2) {
                ssq += __shfl_xor(ssq, 1); ssq += __shfl_xor(ssq, 2); ssq += __shfl_xor(ssq, 4); ssq += __shfl_xor(ssq, 8);
                const float scl = rsqrtf(ssq + EPS) * (sec == 0 ? 0.08838834764831845f : 1.f);
                u32x2 lo, hi; lo.x = pk2(y[0] * scl, y[1] * scl); lo.y = pk2(y[2] * scl, y[3] * scl); hi.x = pk2(y[4] * scl, y[5] * scl); hi.y = pk2(y[6] * scl, y[7] * scl);
                bf16* dst = DNP + (R0 + i) * 4096 + sec * 1024 + h * 128 + pos0;
                *(u32x2*)dst = lo; *(u32x2*)(dst + 8) = hi;
            } else {
                *(u32x4*)(DNP + (R0 + i) * 4096 + col) = pack8f(y);
            }
        }
    }
}


template <int I, int J4> DI void fs_cols(float& acc, float (&T)[64], const LAS float* Ms) {
    if constexpr (4 * J4 < I) {
        const f32x4 m = *(const LAS f32x4*)(Ms + I * 64 + 4 * J4);
        if constexpr (4 * J4 + 0 < I) acc -= m[0] * T[4 * J4 + 0];
        if constexpr (4 * J4 + 1 < I) acc -= m[1] * T[4 * J4 + 1];
        if constexpr (4 * J4 + 2 < I) acc -= m[2] * T[4 * J4 + 2];
        if constexpr (4 * J4 + 3 < I) acc -= m[3] * T[4 * J4 + 3];
        fs_cols<I, J4 + 1>(acc, T, Ms);
    }
}
template <int I> DI void fs_all(float (&T)[64], const LAS float* Ms, int lane) {
    if constexpr (I < 64) {
        float acc = (lane == I) ? 1.f : 0.f;
        fs_cols<I, 0>(acc, T, Ms);
        T[I] = acc;
        fs_all<I + 1>(T, Ms, lane);
    }
}
template <int I> DI void tb_store(float (&T)[64], LAS bf16* TbI, int lane, float betal) {
    if constexpr (I < 64) { TbI[I * 64 + lane] = f2bf(T[I] * betal); tb_store<I + 1>(T, TbI, lane, betal); }
}
DI void dn_prep_phase(const Args& a, LAS unsigned char* lds, int lane, int w) {
    const bf16* DNP = (const bf16*)(a.ws + WS_BIG); const float* BA = (const float*)(a.ws + WS_BA);
    unsigned char* TBI = a.ws + WS_XN; unsigned char* KTG = a.ws + WS_KT; float* SCAL = (float*)(a.ws + WS_SCAL);
    LAS float* Ms = (LAS float*)(lds + w * 17408);
    LAS bf16* TbI = (LAS bf16*)Ms; LAS bf16* InI = TbI + 4096; LAS bf16* Kl = (LAS bf16*)Ms;
    const int gw = blockIdx.x * 8 + w, NGW = gridDim.x * 8;
    for (int uid = gw; uid < 4352; uid += NGW) {
        asm volatile("" : "+v"(lane));
        const int r = lane & 31, hh = lane >> 5;
        int h, nv; size_t R0;
        if (uid < 4096) { h = uid & 7; R0 = (size_t)64 * (uid >> 3); nv = 64; } else { const int su = uid - 4096; h = su & 7; R0 = (size_t)MP + 32 * (su >> 3); nv = 32; }
        const int lr = lane < nv ? lane : nv - 1;
        const float gcl = BA[(R0 + lr) * 16 + 8 + h];
        const float betal = lane < nv ? BA[(R0 + lane) * 16 + h] : 0.f;
        const bf16* kbase = DNP + R0 * 4096 + 1024 + h * 128; const bf16* qbase = DNP + R0 * 4096 + h * 128;
        bf16x8 kf[2][8];
#pragma unroll
        for (int mt = 0; mt < 2; ++mt)
#pragma unroll
            for (int s = 0; s < 8; ++s) kf[mt][s] = (32 * mt + r < nv) ? *(const bf16x8*)(kbase + (size_t)(32 * mt + r) * 4096 + 16 * s + 8 * hh) : (bf16x8){0, 0, 0, 0, 0, 0, 0, 0};
        f32x16 in00, in10, in11;
#pragma unroll
        for (int tl = 0; tl < 3; ++tl) {
            const int mt = tl > 0 ? 1 : 0, nt = tl > 1 ? 1 : 0;
            f32x16 kk, qk;
#pragma unroll
            for (int i = 0; i < 16; ++i) { kk[i] = 0.f; qk[i] = 0.f; }
#pragma unroll
            for (int s = 0; s < 8; ++s) {
                const bf16x8 qf = (32 * mt + r < nv) ? *(const bf16x8*)(qbase + (size_t)(32 * mt + r) * 4096 + 16 * s + 8 * hh) : (bf16x8){0, 0, 0, 0, 0, 0, 0, 0};
                kk = MFMA32(kf[mt][s], kf[nt][s], kk); qk = MFMA32(qf, kf[nt][s], qk);
            }
            const int j = 32 * nt + r; const float gcj = __shfl(gcl, j);
#pragma unroll
            for (int i = 0; i < 16; ++i) {
                const int ii = 32 * mt + crow(i, hh);
                const float gci = __shfl(gcl, ii), bi = __shfl(betal, ii);
                const float dec = __expf(fminf(gci - gcj, 0.f));
                Ms[ii * 64 + j] = (ii > j) ? kk[i] * bi * dec : 0.f;
                const float iv = (ii >= j) ? qk[i] * dec : 0.f;
                if (tl == 0) in00[i] = iv; else if (tl == 1) in10[i] = iv; else in11[i] = iv;
            }
        }
        float T[64];
        fs_all<0>(T, Ms, lane);
        tb_store<0>(T, TbI, lane, betal);
#pragma unroll
        for (int i = 0; i < 16; ++i) {
            InI[crow(i, hh) * 64 + r] = f2bf(in00[i]); InI[crow(i, hh) * 64 + 32 + r] = 0;
            InI[(32 + crow(i, hh)) * 64 + r] = f2bf(in10[i]); InI[(32 + crow(i, hh)) * 64 + 32 + r] = f2bf(in11[i]);
        }
        const int row = lane & 15, quad = lane >> 4;
#pragma unroll
        for (int f = 0; f < 8; ++f) {
            const int i = 16 * (f >> 1) + row, c0 = 32 * (f & 1) + 4 * quad;
            const u32x2 tlo = *(const LAS u32x2*)(TbI + i * 64 + c0), thi = *(const LAS u32x2*)(TbI + i * 64 + c0 + 16);
            *(u32x4*)(TBI + (size_t)uid * 16384 + (size_t)(f * 64 + lane) * 16) = (u32x4){tlo.x, tlo.y, thi.x, thi.y};
            const u32x2 ilo = *(const LAS u32x2*)(InI + i * 64 + c0), ihi = *(const LAS u32x2*)(InI + i * 64 + c0 + 16);
            *(u32x4*)(TBI + (size_t)uid * 16384 + 8192 + (size_t)(f * 64 + lane) * 16) = (u32x4){ilo.x, ilo.y, ihi.x, ihi.y};
        }
#pragma unroll
        for (int i = 0; i < 16; ++i) { const int id = lane + 64 * i, rr = id >> 4, c16 = id & 15;
            const u32x4 v = (rr < nv) ? *(const u32x4*)(kbase + (size_t)rr * 4096 + 8 * c16) : zero4();
            *(LAS u32x4*)(Kl + rr * 136 + 8 * c16) = v; }
#pragma unroll
        for (int f = 0; f < 16; ++f) {
            const int dk = 16 * (f >> 1) + row, dkp = dk & 31, pos = (dk & ~31) + 8 * ((dkp >> 2) & 3) + 4 * (dkp >> 4) + (dkp & 3);
            u32x4 o;
#pragma unroll
            for (int j2 = 0; j2 < 4; ++j2) { const int tok = 32 * (f & 1) + 16 * (j2 >> 1) + 4 * quad + 2 * (j2 & 1);
                o[j2] = (unsigned)Kl[tok * 136 + pos] | ((unsigned)Kl[(tok + 1) * 136 + pos] << 16); }
            *(u32x4*)(KTG + (size_t)uid * 16384 + (size_t)(f * 64 + lane) * 16) = o;
        }
        const float gl = __shfl(gcl, 63);
        SCAL[(size_t)uid * 256 + lane] = __expf(gcl); SCAL[(size_t)uid * 256 + 64 + lane] = __expf(gl - gcl);
        if (lane == 0) SCAL[(size_t)uid * 256 + 128] = __expf(gl);
    }
}

constexpr int SC_K = 0, SC_Q = 17408, SC_V = 34816, SC_Z = 52224, SC_TB = 69632, SC_IN = 77824, SC_KT = 86016, SC_SC = 102400, SC_RED = 103424;
DI void dn_scan_phase(const Args& a, LAS unsigned char* lds, int tid, int lane, int w) {
    const bf16* DNP = (const bf16*)(a.ws + WS_BIG); const unsigned char* TBI = a.ws + WS_XN; const unsigned char* KTG = a.ws + WS_KT; const float* SCAL = (const float*)(a.ws + WS_SCAL);
    bf16* OG = (bf16*)(a.ws + WS_OG); const float* state_ssm = a.in[5]; const float* ng = a.in[15];
    const float ngc = ng[16 * w + (lane & 15)];
    for (int job = blockIdx.x; job < 320; job += gridDim.x) {
        int h, nsteps, nv; size_t Rbase; int uid0, ustep; float* sout; f32x4 S[8];
        if (job < 64) { const int b = job >> 3; h = job & 7; nsteps = 64; nv = 64; Rbase = (size_t)b * 4096; uid0 = b * 512 + h; ustep = 8; sout = a.out + O_SSMP + (size_t)(b * 8 + h) * 16384;
#pragma unroll
            for (int t = 0; t < 8; ++t) S[t] = (f32x4){0.f, 0.f, 0.f, 0.f};
        } else { const int s = job - 64, sb = s >> 3; h = s & 7; nsteps = 1; nv = 32; Rbase = (size_t)MP + 32 * sb; uid0 = 4096 + s; ustep = 0; sout = a.out + O_SSMS + (size_t)(sb * 8 + h) * 16384;
            const float* sin = state_ssm + (size_t)(sb * 8 + h) * 16384; const int quad = lane >> 4, dvc = 16 * w + (lane & 15);
#pragma unroll
            for (int t = 0; t < 8; ++t)
#pragma unroll
                for (int i = 0; i < 4; ++i) S[t][i] = sin[(size_t)(16 * t + 4 * quad + i) * 128 + dvc];
        }
        u32x4 pf[12]; float pfs = 0.f;
#define SCAN_PREFETCH(n) do { const size_t R0_ = Rbase + (size_t)64 * (n); const int uid_ = uid0 + ustep * (n); \
            _Pragma("unroll") for (int i_ = 0; i_ < 2; ++i_) { const int id_ = tid + 512 * i_, rr_ = id_ >> 4, c16_ = id_ & 15; const bool ok_ = rr_ < nv; \
                const bf16* src_ = DNP + (R0_ + rr_) * 4096 + h * 128 + 8 * c16_; \
                pf[i_] = ok_ ? *(const u32x4*)(src_ + 1024) : zero4(); pf[2 + i_] = ok_ ? *(const u32x4*)(src_) : zero4(); \
                pf[4 + i_] = ok_ ? *(const u32x4*)(src_ + 2048) : zero4(); pf[6 + i_] = ok_ ? *(const u32x4*)(src_ + 3072) : zero4(); \
                pf[10 + i_] = *(const u32x4*)(KTG + (size_t)uid_ * 16384 + (size_t)id_ * 16); } \
            pf[8] = *(const u32x4*)(TBI + (size_t)uid_ * 16384 + (size_t)tid * 16); pf[9] = *(const u32x4*)(TBI + (size_t)uid_ * 16384 + 8192 + (size_t)tid * 16); \
            if (tid < 132) pfs = SCAL[(size_t)uid_ * 256 + tid]; } while (0)
        SCAN_PREFETCH(0);
        for (int n = 0; n < nsteps; ++n) {
            asm volatile("" : "+v"(lane), "+v"(tid));
            const int col = lane & 15, quad = lane >> 4, dvc = 16 * w + col;
            LDS_BARRIER();
#pragma unroll
            for (int i = 0; i < 2; ++i) { const int id = tid + 512 * i, rr = id >> 4, c16 = id & 15; const int off = rr * 272 + c16 * 16;
                *(LAS u32x4*)(lds + SC_K + off) = pf[i]; *(LAS u32x4*)(lds + SC_Q + off) = pf[2 + i]; *(LAS u32x4*)(lds + SC_V + off) = pf[4 + i]; *(LAS u32x4*)(lds + SC_Z + off) = pf[6 + i];
                *(LAS u32x4*)(lds + SC_KT + id * 16) = pf[10 + i]; }
            *(LAS u32x4*)(lds + SC_TB + tid * 16) = pf[8]; *(LAS u32x4*)(lds + SC_IN + tid * 16) = pf[9];
            if (tid < 132) *(LAS float*)(lds + SC_SC + tid * 4) = pfs;
            LDS_BARRIER();
            if (n + 1 < nsteps) SCAN_PREFETCH(n + 1);
            bf16x8 sB[4];
#pragma unroll
            for (int ks = 0; ks < 4; ++ks) { u32x4 p; p.x = pk2(S[2 * ks][0], S[2 * ks][1]); p.y = pk2(S[2 * ks][2], S[2 * ks][3]); p.z = pk2(S[2 * ks + 1][0], S[2 * ks + 1][1]); p.w = pk2(S[2 * ks + 1][2], S[2 * ks + 1][3]); sB[ks] = __builtin_bit_cast(bf16x8, p); }
            f32x4 kS[4], qS[4];
#pragma unroll
            for (int mt = 0; mt < 4; ++mt) { kS[mt] = (f32x4){0.f, 0.f, 0.f, 0.f}; qS[mt] = (f32x4){0.f, 0.f, 0.f, 0.f};
#pragma unroll
                for (int ks = 0; ks < 4; ++ks) { const int off = (16 * mt + col) * 272 + 64 * ks + 16 * quad;
                    const bf16x8 ka = *(const LAS bf16x8*)(lds + SC_K + off), qa = *(const LAS bf16x8*)(lds + SC_Q + off);
                    kS[mt] = MFMA16(ka, sB[ks], kS[mt]); qS[mt] = MFMA16(qa, sB[ks], qS[mt]); } }
            f32x4 ev[4], dv[4], rr4[4];
#pragma unroll
            for (int mt = 0; mt < 4; ++mt) { ev[mt] = *(const LAS f32x4*)(lds + SC_SC + (16 * mt + 4 * quad) * 4); dv[mt] = *(const LAS f32x4*)(lds + SC_SC + (64 + 16 * mt + 4 * quad) * 4);
#pragma unroll
                for (int i = 0; i < 4; ++i) { const float vv = bf2f(*(const LAS bf16*)(lds + SC_V + (16 * mt + 4 * quad + i) * 272 + dvc * 2)); rr4[mt][i] = vv - ev[mt][i] * kS[mt][i]; } }
            const float gam = *(const LAS float*)(lds + SC_SC + 128 * 4);
            bf16x8 rB[2];
#pragma unroll
            for (int k2 = 0; k2 < 2; ++k2) { u32x4 p; p.x = pk2(rr4[2 * k2][0], rr4[2 * k2][1]); p.y = pk2(rr4[2 * k2][2], rr4[2 * k2][3]); p.z = pk2(rr4[2 * k2 + 1][0], rr4[2 * k2 + 1][1]); p.w = pk2(rr4[2 * k2 + 1][2], rr4[2 * k2 + 1][3]); rB[k2] = __builtin_bit_cast(bf16x8, p); }
            f32x4 vn[4];
#pragma unroll
            for (int mt = 0; mt < 4; ++mt) { vn[mt] = (f32x4){0.f, 0.f, 0.f, 0.f};
#pragma unroll
                for (int k2 = 0; k2 < 2; ++k2) { if (k2 == 1 && mt < 2) continue; const bf16x8 ta = *(const LAS bf16x8*)(lds + SC_TB + ((mt * 2 + k2) * 64 + lane) * 16); vn[mt] = MFMA16(ta, rB[k2], vn[mt]); } }
            bf16x8 vB[2], vdB[2];
#pragma unroll
            for (int k2 = 0; k2 < 2; ++k2) { u32x4 p, q;
                p.x = pk2(vn[2 * k2][0], vn[2 * k2][1]); p.y = pk2(vn[2 * k2][2], vn[2 * k2][3]); p.z = pk2(vn[2 * k2 + 1][0], vn[2 * k2 + 1][1]); p.w = pk2(vn[2 * k2 + 1][2], vn[2 * k2 + 1][3]);
                q.x = pk2(vn[2 * k2][0] * dv[2 * k2][0], vn[2 * k2][1] * dv[2 * k2][1]); q.y = pk2(vn[2 * k2][2] * dv[2 * k2][2], vn[2 * k2][3] * dv[2 * k2][3]);
                q.z = pk2(vn[2 * k2 + 1][0] * dv[2 * k2 + 1][0], vn[2 * k2 + 1][1] * dv[2 * k2 + 1][1]); q.w = pk2(vn[2 * k2 + 1][2] * dv[2 * k2 + 1][2], vn[2 * k2 + 1][3] * dv[2 * k2 + 1][3]);
                vB[k2] = __builtin_bit_cast(bf16x8, p); vdB[k2] = __builtin_bit_cast(bf16x8, q); }
            f32x4 o[4];
#pragma unroll
            for (int mt = 0; mt < 4; ++mt) { o[mt] = ev[mt] * qS[mt];
#pragma unroll
                for (int k2 = 0; k2 < 2; ++k2) { if (k2 == 1 && mt < 2) continue; const bf16x8 ia = *(const LAS bf16x8*)(lds + SC_IN + ((mt * 2 + k2) * 64 + lane) * 16); o[mt] = MFMA16(ia, vB[k2], o[mt]); } }
#pragma unroll
            for (int t = 0; t < 8; ++t) { S[t] = S[t] * gam;
#pragma unroll
                for (int k2 = 0; k2 < 2; ++k2) { const bf16x8 kt = *(const LAS bf16x8*)(lds + SC_KT + ((t * 2 + k2) * 64 + lane) * 16); S[t] = MFMA16(kt, vdB[k2], S[t]); } }
            f32x4 ssq[4];
#pragma unroll
            for (int mt = 0; mt < 4; ++mt) { ssq[mt] = o[mt] * o[mt];
#pragma unroll
                for (int i = 0; i < 4; ++i) { float s = ssq[mt][i]; s += __shfl_xor(s, 1); s += __shfl_xor(s, 2); s += __shfl_xor(s, 4); s += __shfl_xor(s, 8); ssq[mt][i] = s; }
                if (col == 0) *(LAS f32x4*)(lds + SC_RED + (w * 64 + 16 * mt + 4 * quad) * 4) = ssq[mt]; }
            LDS_BARRIER();
            const size_t R0 = Rbase + (size_t)64 * n;
#pragma unroll
            for (int mt = 0; mt < 4; ++mt) { f32x4 tot = (f32x4){0.f, 0.f, 0.f, 0.f};
#pragma unroll
                for (int ww = 0; ww < 8; ++ww) tot += *(const LAS f32x4*)(lds + SC_RED + (ww * 64 + 16 * mt + 4 * quad) * 4);
#pragma unroll
                for (int i = 0; i < 4; ++i) { const int tok = 16 * mt + 4 * quad + i;
                    const float z = bf2f(*(const LAS bf16*)(lds + SC_Z + tok * 272 + dvc * 2));
                    const float ov = o[mt][i] * rsqrtf(tot[i] * (1.f / 128.f) + EPS) * ngc * silu(z);
                    if (tok < nv) OG[(R0 + tok) * 1024 + h * 128 + dvc] = f2bf(ov); } }
        }
        const int quad = lane >> 4, dvc = 16 * w + (lane & 15);
#pragma unroll
        for (int t = 0; t < 8; ++t)
#pragma unroll
            for (int i = 0; i < 4; ++i) sout[(size_t)(16 * t + 4 * quad + i) * 128 + dvc] = S[t][i];
    }
    __syncthreads();
#undef SCAN_PREFETCH
}

DI void final_norm_phase(const Args& a, int lane, int w) {
    const float* gf = a.in[7]; const float* ss2 = (const float*)(a.ws + WS_SS2);
    const int gw = blockIdx.x * 8 + w, NGW = gridDim.x * 8;
    f32x4 gv[4];
#pragma unroll
    for (int j = 0; j < 4; ++j) gv[j] = *(const f32x4*)(gf + 4 * lane + 256 * j);
    for (int m = gw; m < MROWS; m += NGW) {
        float* yr = a.out + (size_t)m * DM; const float rs = rsqrtf(ss2[m] * (1.f / DM) + EPS);
#pragma unroll
        for (int j = 0; j < 4; ++j) { f32x4 v = *(const f32x4*)(yr + 4 * lane + 256 * j); v = v * rs * gv[j]; *(f32x4*)(yr + 4 * lane + 256 * j) = v; }
    }
}

#ifndef N_PHASES
#define N_PHASES 10
#endif
__global__ void __launch_bounds__(512, 2) mega_fwd(Args a, int ph_lo, int ph_hi, int coop) {
    extern __shared__ __attribute__((aligned(16))) unsigned char lds_raw[];
    LAS unsigned char* lds = (LAS unsigned char*)lds_raw;
    const int tid = threadIdx.x, lane = tid & 63, w = __builtin_amdgcn_readfirstlane(tid >> 6);
    cg::grid_group grid = cg::this_grid();
    unsigned* barw = (unsigned*)a.ws;
    volatile LAS unsigned* bst = (volatile LAS unsigned*)(lds + LDS_BYTES - 64);
    if (tid < 16) bst[tid] = 0u;
    if (coop && blockIdx.x == 0) for (int i = tid; i < XCD_BAR_WORDS; i += 512) barw[i] = 0u;
    __syncthreads();
    XcdBarrier xbar; xbar.bar = barw; xbar.x = 0; xbar.st = bst;
    bf16* XN = (bf16*)(a.ws + WS_XN); bf16* BIG = (bf16*)(a.ws + WS_BIG); bf16* OG = (bf16*)(a.ws + WS_OG);
    float* ss1 = (float*)(a.ws + WS_SS1); float* ss2 = (float*)(a.ws + WS_SS2);
#ifndef PH_MASK
#define PH_MASK 0x3ff
#endif
#define IN(k) (((PH_MASK >> (k)) & 1) && ph_lo <= (k) && (k) < ph_hi)
#define SEAM(k) do { if (coop && IN(k) && IN((k) + 1)) { if ((k) == 0) { grid.sync(); xbar = xcd_barrier_post(barw, bst); } else xcd_barrier(xbar); } } while (0)
#ifndef REP_MASK
#define REP_MASK 0
#endif
#define REP(k) for (int rep_ = 0; rep_ < 1 + ((REP_MASK >> (k)) & 1); ++rep_)
    if (IN(0)) REP(0) { p0_prologue(a, lds, tid, lane, w); }
    SEAM(0);
#ifdef EXTRA_SYNCS
    if (coop) for (int es_ = 0; es_ < EXTRA_SYNCS; ++es_) grid.sync();
#endif
    if (IN(1)) REP(1) { pg8::Gemm g{XN, (const bf16*)(a.ws + WS_W1T), MROWS, 2560, 1024}; pg8::StaticOrder S; S.init(MROWS, 2560, gridDim.x, blockIdx.x);
        EpiQKVG E{BIG, a.out}; pg8::gemm_phase<EpiQKVG, pg8::StaticOrder, true, true>(lds, g, S, E); }
    SEAM(1);
    if (IN(2)) REP(2) { attn_phase(lds, BIG, a.in[2], a.in[3], a.in[9], OG, tid, lane, w); }
    SEAM(2);
    if (IN(3)) { pg8::Gemm g{OG, (const bf16*)(a.ws + WS_WO1T), MROWS, 1024, 1024}; pg8::StaticOrder S; S.init(MROWS, 1024, gridDim.x, blockIdx.x);
        EpiRes E{a.in[0], a.in[1], a.out, XN, a.in[6] + 1024, ss1}; pg8::gemm_phase<EpiRes, pg8::StaticOrder, true, true>(lds, g, S, E); }
    SEAM(3);
    if (IN(4)) REP(4) { pg8::Gemm g{XN, (const bf16*)(a.ws + WS_W2T), MROWS, 4352, 1024}; pg8::StaticOrder S; S.init(MROWS, 4352, gridDim.x, blockIdx.x);
        EpiDN E{BIG, (bf16*)(a.ws + WS_HALO), (float*)(a.ws + WS_BA), ss1, a.out}; pg8::gemm_phase<EpiDN, pg8::StaticOrder, true, true>(lds, g, S, E); }
    SEAM(4);
    if (IN(5)) { dn_pre_phase(a, lane, w); }
    SEAM(5);
    if (IN(6)) REP(6) { dn_prep_phase(a, lds, lane, w); }
    SEAM(6);
    if (IN(7)) REP(7) { dn_scan_phase(a, lds, tid, lane, w); }
    SEAM(7);
    if (IN(8)) { pg8::Gemm g{OG, (const bf16*)(a.ws + WS_WO2T), MROWS, 1024, 1024}; pg8::StaticOrder S; S.init(MROWS, 1024, gridDim.x, blockIdx.x);
        EpiRes E{a.out, nullptr, a.out, nullptr, nullptr, ss2}; pg8::gemm_phase<EpiRes, pg8::StaticOrder, true, true>(lds, g, S, E); }
    SEAM(8);
    if (IN(9)) { final_norm_phase(a, lane, w); }
#undef IN
#undef SEAM
}

#ifndef MULTI_LAUNCH
#define MULTI_LAUNCH 0
#endif
extern "C" void kernel_launch(void* const* d_in, const int* in_sizes, int n_in, void* d_out, int out_size, void* d_ws, size_t ws_size, hipStream_t stream) {
    static int grid = 0;
    if (grid == 0) {
        int dev = 0, cus = 0, per_cu = 0;
        if (n_in != 17 || ws_size < WS_END) { fprintf(stderr, "kernel_launch: unexpected n_in %d / ws_size %zu\n", n_in, ws_size); grid = -1; return; }
        if (hipGetDevice(&dev) != hipSuccess || hipDeviceGetAttribute(&cus, hipDeviceAttributeMultiprocessorCount, dev) != hipSuccess) { grid = -1; return; }
        if (hipFuncSetAttribute((const void*)mega_fwd, hipFuncAttributeMaxDynamicSharedMemorySize, LDS_BYTES) != hipSuccess) { fprintf(stderr, "kernel_launch: hipFuncSetAttribute failed\n"); grid = -1; return; }
        if (hipOccupancyMaxActiveBlocksPerMultiprocessor(&per_cu, (const void*)mega_fwd, 512, LDS_BYTES) != hipSuccess || per_cu < 1) { fprintf(stderr, "kernel_launch: occupancy query gave %d\n", per_cu); per_cu = 1; }
        (void)hipGetLastError();
        grid = cus * (per_cu > 1 ? 1 : per_cu);
        if (grid < 64) grid = 64;
    }
    if (grid < 0) return;
    Args a{};
    for (int i = 0; i < 17; ++i) a.in[i] = (const float*)d_in[i];
    a.out = (float*)d_out; a.ws = (unsigned char*)d_ws;
#if MULTI_LAUNCH
    for (int p = 0; p < N_PHASES; ++p) { int lo = p, hi = p + 1, coop = 0; hipLaunchKernelGGL(mega_fwd, dim3(grid), dim3(512), LDS_BYTES, stream, a, lo, hi, coop); }
#else
    int lo = 0, hi = N_PHASES, coop = 1;
    void* args[] = {&a, &lo, &hi, &coop};
    hipError_t e = hipLaunchCooperativeKernel((const void*)mega_fwd, dim3(grid), dim3(512), args, LDS_BYTES, stream);
    if (e != hipSuccess) fprintf(stderr, "kernel_launch: cooperative launch failed: %s (grid %d)\n", hipGetErrorString(e), grid);
#endif
}
```

```cpp
#include <hip/hip_runtime.h>
#include <hip/hip_cooperative_groups.h>
#include <cstdio>
#include <cstdint>
namespace cg = cooperative_groups;
namespace pg8 {
#define PG8_LAS __attribute__((address_space(3)))
typedef unsigned short bf16_t;
typedef short bf16x8 __attribute__((ext_vector_type(8)));
typedef float f32x4 __attribute__((ext_vector_type(4)));
typedef unsigned u32x4 __attribute__((ext_vector_type(4)));
constexpr int BM = 256, BK = 64, HALF = 128, HTB = HALF * BK * 2  , STAGE_BYTES = 8 * HTB, NXCD = 8, WGM = 8;

__host__ __device__ __forceinline__ int lds_byte(int r, int c) { const int st = (r >> 4) * 2 + (c >> 5), rr = r & 15, cc = c & 31, ob = rr * 64 + cc * 2; return st * 1024 + (ob ^ (((ob >> 9) & 1) << 5)); }
__host__ __device__ __forceinline__ void stage_rc(int b, int& R, int& C) { const int st = b / 1024, sb = b % 1024, swz = sb ^ (((sb >> 9) & 1) << 5); R = (st >> 1) * 16 + swz / 64; C = (st & 1) * 32 + (swz % 64) / 2; }
__host__ __device__ __forceinline__ int perm32(int rho) { const int n = rho >> 4, i = rho & 15; return 8 * (i >> 2) + 4 * n + (i & 3); }

struct Unit { int pm, pn; };
struct Gemm { const bf16_t* A; const bf16_t* Bt; int M, N, K; };

struct StaticOrder {
    int nM, nN, nwg, G, c;
    __host__ __device__ void init(int M, int N, int G_, int c_) { nM = M / BM; nN = N / BM; nwg = nM * nN; G = G_; c = c_; }
    __host__ __device__ bool next(int i, Unit& u) const {
        const long L = (long)i * G + c; if (L >= nwg) return false;
        int wgid = (int)L; { const int q = nwg / NXCD, r = nwg % NXCD, xcd = wgid % NXCD, off = wgid / NXCD; wgid = (xcd < r ? xcd * (q + 1) : r * (q + 1) + (xcd - r) * q) + off; }
        const int nig = WGM * nN, gid = wgid / nig, fm = gid * WGM, gsz = (nM - fm) < WGM ? (nM - fm) : WGM;
        u.pm = fm + ((wgid % nig) % gsz); u.pn = (wgid % nig) / gsz; return true;
    }
    __device__ __forceinline__ void a_ready(const Unit&) const {}
    __device__ __forceinline__ void done(const Unit&) const {}
};

__device__ __forceinline__ unsigned cvt_pk_bf16(float lo, float hi) { unsigned r; asm volatile("v_cvt_pk_bf16_f32 %0, %1, %2" : "=v"(r) : "v"(lo), "v"(hi)); return r; }

template <class Epi, class Sched, bool ALIGN_EPI = false, bool SP2 = false>
__device__ __forceinline__ void gemm_phase(PG8_LAS unsigned char* lds, const Gemm g, const Sched& S, const Epi& E) {
    const int tid = threadIdx.x, wid = __builtin_amdgcn_readfirstlane(tid >> 6), lane = tid & 63, wr = wid >> 2, wc = wid & 3, fr = lane & 15, fq = lane >> 4;
    const int K = g.K, nt = K / BK;
    unsigned voffA[2], voffB[2];
#pragma unroll
    for (int i = 0; i < 2; ++i) { int R, C; stage_rc(tid * 16 + i * 8192, R, C); const int Rb = Epi::PERM ? ((R & ~31) + perm32(R & 31)) : R;
        voffA[i] = (unsigned)(R * K + C) * 2u; voffB[i] = (unsigned)(Rb * K + C) * 2u; }
    const size_t kstep = (size_t)(BK * 2);
    const size_t hstep = (size_t)HALF * K * 2;
    const size_t tstep = 2 * hstep;
    const unsigned ldsw = (unsigned)wid * 1024u;
    const int aoff = lds_byte(wr * 64 + fr, fq * 8), boff = lds_byte(wc * 32 + fr, fq * 8);
#define PG8_SA(b, h) (((b) * 2 + (h)) * HTB)
#define PG8_SB(b, h) ((4 + (b) * 2 + (h)) * HTB)
#define PG8_STAGE(bufoff, gbase, voff) do { _Pragma("unroll") for (int _i = 0; _i < 2; ++_i) \
        __builtin_amdgcn_global_load_lds((const unsigned*)((const char*)(gbase) + (voff)[_i]), (PG8_LAS unsigned*)(lds + (bufoff) + ldsw + _i * 8192), 16, 0, 0); } while (0)
#define PG8_LDA(dst, b, h) do { _Pragma("unroll") for (int m = 0; m < 4; ++m) _Pragma("unroll") for (int k = 0; k < 2; ++k) dst[m][k] = *(const PG8_LAS bf16x8*)(lds + PG8_SA(b, h) + aoff + m * 2048 + k * 1024); } while (0)
#define PG8_LDB(dst, b, h) do { _Pragma("unroll") for (int n = 0; n < 2; ++n) _Pragma("unroll") for (int k = 0; k < 2; ++k) dst[n][k] = *(const PG8_LAS bf16x8*)(lds + PG8_SB(b, h) + boff + n * 2048 + k * 1024); } while (0)
#define PG8_MMA(ai, bj, At, Bt) do { __builtin_amdgcn_s_setprio(1); _Pragma("unroll") for (int m = 0; m < 4; ++m) _Pragma("unroll") for (int n = 0; n < 2; ++n) _Pragma("unroll") for (int k = 0; k < 2; ++k) \
        acc[ai][bj][m][n] = __builtin_amdgcn_mfma_f32_16x16x32_bf16(Bt[n][k], At[m][k], acc[ai][bj][m][n], 0, 0, 0); __builtin_amdgcn_s_setprio(0); } while (0)
#define PG8_WAIT_V(n) asm volatile("s_waitcnt vmcnt(" #n ")" ::: "memory")
#define PG8_WAIT_L(n) asm volatile("s_waitcnt lgkmcnt(" #n ")" ::: "memory")
#define PG8_BAR __builtin_amdgcn_s_barrier()
#define PG8_SCHED __builtin_amdgcn_sched_barrier(0)
    Unit cur, nxt; int ui = 0;
    if (!S.next(0, cur)) return;
    f32x4 acc[2][2][4][2];
#pragma unroll
    for (int a = 0; a < 2; ++a)
#pragma unroll
        for (int b = 0; b < 2; ++b)
#pragma unroll
            for (int m = 0; m < 4; ++m)
#pragma unroll
                for (int n = 0; n < 2; ++n) acc[a][b][m][n] = (f32x4){0.f, 0.f, 0.f, 0.f};
    bf16x8 At[4][2], B0[2][2], B1[2][2];
    const char* cA = (const char*)g.A + (size_t)cur.pm * tstep; const char* cB = (const char*)g.Bt + (size_t)cur.pn * tstep;
    S.a_ready(cur);
    if constexpr (SP2) {
        PG8_STAGE(PG8_SB(0, 0), cB, voffB); PG8_STAGE(PG8_SB(0, 1), cB + hstep, voffB); PG8_STAGE(PG8_SA(0, 0), cA, voffA); PG8_STAGE(PG8_SA(0, 1), cA + hstep, voffA);
        if (wr == 1) PG8_BAR;
        PG8_WAIT_V(2); PG8_BAR;
        PG8_STAGE(PG8_SB(1, 0), cB + kstep, voffB); PG8_STAGE(PG8_SA(1, 0), cA + kstep, voffA); PG8_STAGE(PG8_SB(1, 1), cB + hstep + kstep, voffB);
        PG8_WAIT_V(6); PG8_BAR;
    } else {
        PG8_STAGE(PG8_SB(0, 0), cB, voffB); PG8_STAGE(PG8_SA(0, 0), cA, voffA); PG8_STAGE(PG8_SB(0, 1), cB + hstep, voffB); PG8_STAGE(PG8_SA(0, 1), cA + hstep, voffA);
        if (wr == 1) PG8_BAR;
        PG8_WAIT_V(4); PG8_BAR;
        PG8_STAGE(PG8_SB(1, 0), cB + kstep, voffB); PG8_STAGE(PG8_SA(1, 0), cA + kstep, voffA); PG8_STAGE(PG8_SB(1, 1), cB + hstep + kstep, voffB);
        PG8_WAIT_V(6); PG8_BAR;
    }
    for (;;) {
        const bool has_next = S.next(ui + 1, nxt);
        const char* nA = has_next ? (const char*)g.A + (size_t)nxt.pm * tstep : cA; const char* nB = has_next ? (const char*)g.Bt + (size_t)nxt.pn * tstep : cB;
        for (int t = 0; t < nt; t += 2) {
            const bool last = (t == nt - 2);
            const char* a1 = cA + (size_t)(t + 1) * kstep;
            const char* a2 = last ? nA : cA + (size_t)(t + 2) * kstep; const char* b2 = last ? nB : cB + (size_t)(t + 2) * kstep;
            const char* a3 = a2 + kstep; const char* b3 = b2 + kstep;
            if (last && has_next) S.a_ready(nxt);
            if constexpr (SP2) {
            PG8_LDB(B0, 0, 0); PG8_LDB(B1, 0, 1); PG8_SCHED; PG8_LDA(At, 0, 0); PG8_STAGE(PG8_SA(1, 1), a1 + hstep, voffA);
            PG8_WAIT_V(8); PG8_WAIT_L(0); PG8_BAR; PG8_MMA(0, 0, At, B0); PG8_MMA(0, 1, At, B1); PG8_BAR; PG8_SCHED;
            PG8_LDA(At, 0, 1); PG8_STAGE(PG8_SB(0, 0), b2, voffB); PG8_STAGE(PG8_SB(0, 1), b2 + hstep, voffB); PG8_STAGE(PG8_SA(0, 0), a2, voffA);
            PG8_WAIT_V(8); PG8_WAIT_L(0); PG8_BAR; PG8_MMA(1, 0, At, B0); PG8_MMA(1, 1, At, B1); PG8_BAR; PG8_SCHED;
            PG8_LDB(B0, 1, 0); PG8_LDB(B1, 1, 1); PG8_SCHED; PG8_LDA(At, 1, 0); PG8_STAGE(PG8_SA(0, 1), a2 + hstep, voffA);
            PG8_WAIT_V(8); PG8_WAIT_L(0); PG8_BAR; PG8_MMA(0, 0, At, B0); PG8_MMA(0, 1, At, B1); PG8_BAR; PG8_SCHED;
            PG8_LDA(At, 1, 1); PG8_STAGE(PG8_SB(1, 0), b3, voffB); PG8_STAGE(PG8_SB(1, 1), b3 + hstep, voffB); PG8_STAGE(PG8_SA(1, 0), a3, voffA);
            PG8_WAIT_V(8); PG8_WAIT_L(0); PG8_BAR; PG8_MMA(1, 0, At, B0); PG8_MMA(1, 1, At, B1); PG8_BAR; PG8_SCHED;
            } else {
            PG8_LDB(B0, 0, 0); PG8_SCHED; PG8_LDA(At, 0, 0); PG8_STAGE(PG8_SA(1, 1), a1 + hstep, voffA);
            PG8_WAIT_L(8); PG8_BAR; PG8_WAIT_L(0); PG8_MMA(0, 0, At, B0); PG8_BAR; PG8_SCHED;
            PG8_LDB(B1, 0, 1); PG8_STAGE(PG8_SB(0, 0), b2, voffB);
            PG8_BAR; PG8_WAIT_L(0); PG8_MMA(0, 1, At, B1); PG8_BAR;
            PG8_LDA(At, 0, 1); PG8_STAGE(PG8_SA(0, 0), a2, voffA);
            PG8_BAR; PG8_WAIT_L(0); PG8_MMA(1, 0, At, B0); PG8_BAR; PG8_SCHED;
            PG8_STAGE(PG8_SB(0, 1), b2 + hstep, voffB);
            PG8_WAIT_V(6); PG8_BAR; PG8_MMA(1, 1, At, B1); PG8_BAR;
            PG8_LDB(B0, 1, 0); PG8_SCHED; PG8_LDA(At, 1, 0); PG8_STAGE(PG8_SA(0, 1), a2 + hstep, voffA);
            PG8_WAIT_L(8); PG8_BAR; PG8_WAIT_L(0); PG8_MMA(0, 0, At, B0); PG8_BAR; PG8_SCHED;
            PG8_LDB(B1, 1, 1); PG8_STAGE(PG8_SB(1, 0), b3, voffB);
            PG8_BAR; PG8_WAIT_L(0); PG8_MMA(0, 1, At, B1); PG8_BAR;
            PG8_LDA(At, 1, 1); PG8_STAGE(PG8_SA(1, 0), a3, voffA);
            PG8_BAR; PG8_WAIT_L(0); PG8_MMA(1, 0, At, B0); PG8_BAR; PG8_SCHED;
            PG8_STAGE(PG8_SB(1, 1), b3 + hstep, voffB);
            PG8_WAIT_V(6); PG8_BAR; PG8_MMA(1, 1, At, B1); PG8_BAR;
            }
        }
        if constexpr (ALIGN_EPI) { if (wr == 0) PG8_BAR; }
        if constexpr (!Epi::AFTER_DRAIN) { E(acc, cur, wr, wc, fr, fq); S.done(cur); }
        if (!has_next) break;
#pragma unroll
        for (int a = 0; a < 2; ++a)
#pragma unroll
            for (int b = 0; b < 2; ++b)
#pragma unroll
                for (int m = 0; m < 4; ++m)
#pragma unroll
                    for (int n = 0; n < 2; ++n) acc[a][b][m][n] = (f32x4){0.f, 0.f, 0.f, 0.f};
        cur = nxt; cA = nA; cB = nB; ++ui;
        if constexpr (ALIGN_EPI) { if (wr == 1) PG8_BAR; }
    }
    PG8_WAIT_V(0);
    if constexpr (!ALIGN_EPI) { if (wr == 0) PG8_BAR; }
    PG8_BAR;
    if constexpr (Epi::AFTER_DRAIN) { E.fused(acc, cur, wr, wc, fr, fq, lds, wid, lane); S.done(cur); }
#undef PG8_SA
#undef PG8_SB
#undef PG8_STAGE
#undef PG8_LDA
#undef PG8_LDB
#undef PG8_MMA
#undef PG8_WAIT_V
#undef PG8_WAIT_L
#undef PG8_BAR
#undef PG8_SCHED
}
}

#define LAS __attribute__((address_space(3)))
typedef unsigned short bf16;
typedef short bf16x8 __attribute__((ext_vector_type(8)));
typedef float f32x4 __attribute__((ext_vector_type(4)));
typedef float f32x16 __attribute__((ext_vector_type(16)));
typedef unsigned u32x4 __attribute__((ext_vector_type(4)));
typedef unsigned u32x2 __attribute__((ext_vector_type(2)));
typedef __bf16 bf16x2_t __attribute__((ext_vector_type(2)));
typedef float f32x2_t __attribute__((ext_vector_type(2)));
#define MFMA32(a, b, c) __builtin_amdgcn_mfma_f32_32x32x16_bf16((a), (b), (c), 0, 0, 0)
#define MFMA16(a, b, c) __builtin_amdgcn_mfma_f32_16x16x32_bf16((a), (b), (c), 0, 0, 0)
#define DI __device__ __forceinline__
#define LDS_BARRIER() do { asm volatile("s_waitcnt lgkmcnt(0)" ::: "memory"); __builtin_amdgcn_s_barrier(); asm volatile("" ::: "memory"); } while (0)

constexpr int DM = 1024, MROWS = 33792, MP = 32768;
constexpr float EPS = 1e-6f;
constexpr float LOG2E = 1.4426950408889634f;
constexpr float QSCALE = 0.125f * LOG2E;
constexpr size_t O_KWP = 34603008, O_VWP = 34865152, O_CONVP = 35127296, O_SSMP = 35201024, O_KWS = 36249600, O_VWS = 37298176, O_CONVS = 38346752, O_SSMS = 38641664;
constexpr size_t MiB = 1u << 20;
constexpr size_t WS_W1T = 1 * MiB, WS_WO1T = 6 * MiB, WS_W2T = 8 * MiB, WS_WO2T = 17 * MiB, WS_BA = 19 * MiB, WS_SS1 = 22 * MiB, WS_SS2 = 22 * MiB + 512 * 1024,
                 WS_HALO = 23 * MiB, WS_SCAL = 33 * MiB, WS_XN = 40 * MiB  , WS_BIG = 110 * MiB  , WS_OG = 374 * MiB, WS_KT = 440 * MiB, WS_END = 508 * MiB;
constexpr int LDS_BYTES = 143360;

DI unsigned pk2(float lo, float hi) { f32x2_t v = {lo, hi}; bf16x2_t b = __builtin_convertvector(v, bf16x2_t); return __builtin_bit_cast(unsigned, b); }
DI float bflo(unsigned u) { return __builtin_bit_cast(float, u << 16); }
DI float bfhi(unsigned u) { return __builtin_bit_cast(float, u & 0xffff0000u); }
DI float bf2f(bf16 u) { return __builtin_bit_cast(float, (unsigned)u << 16); }
DI bf16 f2bf(float f) { return (bf16)(pk2(f, 0.f) & 0xffffu); }
DI int crow(int i, int h) { return (i & 3) + 8 * (i >> 2) + 4 * h; }
DI float fexp2(float x) { return __builtin_amdgcn_exp2f(x); }
DI float silu(float x) { return x * __builtin_amdgcn_rcpf(1.f + __builtin_amdgcn_exp2f(-1.4426950408889634f * x)); }
DI float frsq(float x) { return __builtin_amdgcn_rsqf(x); }
DI float wave_sum(float v) {
#pragma unroll
    for (int o = 1; o < 64; o <<= 1) v += __shfl_xor(v, o);
    return v;
}
DI u32x4 pack8f(const float* p) { u32x4 r; r.x = pk2(p[0], p[1]); r.y = pk2(p[2], p[3]); r.z = pk2(p[4], p[5]); r.w = pk2(p[6], p[7]); return r; }
DI u32x4 ld8f_bf(const float* p) { const f32x4 a = *(const f32x4*)p, b = *(const f32x4*)(p + 4); u32x4 r; r.x = pk2(a.x, a.y); r.y = pk2(a.z, a.w); r.z = pk2(b.x, b.y); r.w = pk2(b.z, b.w); return r; }

#define XB_TMO      128
#define XB_XCNT(j)  (256  + 64 * (j))
#define XB_XSUB(j)  (1280 + 64 * (j))
#define XB_XGEN(j)  (2304 + 64 * (j))
#define XB_TOP      3328
#define XB_TOPGEN   3392
#define XCD_BAR_WORDS 3456
#define XB_SPIN_CAP (1u << 18)

__device__ __forceinline__ unsigned xb_ld(unsigned* p)              { return __hip_atomic_load(p, __ATOMIC_RELAXED, __HIP_MEMORY_SCOPE_AGENT); }
__device__ __forceinline__ unsigned xb_add(unsigned* p, unsigned v) { return __hip_atomic_fetch_add(p, v, __ATOMIC_RELAXED, __HIP_MEMORY_SCOPE_AGENT); }
__device__ __forceinline__ unsigned xb_xcc_id() { return (unsigned)__builtin_amdgcn_s_getreg((3 << 11) | 20) & 0xFu; }
#define XB_SPIN(cond, bar) do { unsigned _sp = 0; while (cond) { __builtin_amdgcn_s_sleep(1); \
    if ((++_sp & 255u) == 0u) { if (xb_ld(&(bar)[XB_TMO])) break; if (_sp > XB_SPIN_CAP) { atomicAdd(&(bar)[XB_TMO], 1u); break; } } } } while (0)

struct XcdBarrier {
    unsigned* bar; unsigned x;
    volatile LAS unsigned* st;
};

__device__ __forceinline__ XcdBarrier xcd_barrier_post(unsigned* bar, volatile LAS unsigned* st) {
    XcdBarrier b; b.bar = bar; b.x = xb_xcc_id(); b.st = st;
    if (threadIdx.x == 0) (void)xb_add(&bar[XB_XCNT(b.x)], 1u);
    return b;
}
__device__ __forceinline__ void xcd_barrier_complete(unsigned* bar, unsigned x, unsigned& nloc, unsigned& nx) {
    const unsigned G = gridDim.x * gridDim.y * gridDim.z;
    unsigned sum, cnt, mine, sp = 0u;
    for (;;) {
        sum = 0u; cnt = 0u; mine = 0u;
#pragma unroll
        for (unsigned j = 0; j < 16; ++j) { const unsigned c = xb_ld(&bar[XB_XCNT(j)]); sum += c; cnt += (c > 0u) ? 1u : 0u; mine = (j == x) ? c : mine; }
        if (sum == G) break;
        __builtin_amdgcn_s_sleep(1);
        if ((++sp & 255u) == 0u) { if (xb_ld(&bar[XB_TMO])) break; if (sp > XB_SPIN_CAP) { atomicAdd(&bar[XB_TMO], 1u); break; } }
    }
    nloc = mine > 0u ? mine : 1u; nx = cnt > 0u ? cnt : 1u;
}

__device__ __forceinline__ void xcd_barrier(const XcdBarrier& b) {
    asm volatile("s_waitcnt vmcnt(0)" ::: "memory");
    __syncthreads();
    if (threadIdx.x == 0) {
        unsigned* bar = b.bar;
        __builtin_amdgcn_s_waitcnt(0);
        unsigned nloc = b.st[0], nx = b.st[1];
        if (nloc == 0u) { xcd_barrier_complete(bar, b.x, nloc, nx); b.st[0] = nloc; b.st[1] = nx; }
        const unsigned old = xb_add(&bar[XB_XSUB(b.x)], 1u);
        const unsigned gen = old / nloc;
        if (old + 1u == (gen + 1u) * nloc) {
            __builtin_amdgcn_fence(__ATOMIC_RELEASE, "agent");
            asm volatile("s_waitcnt vmcnt(0)" ::: "memory");
            const unsigned og = xb_add(&bar[XB_TOP], 1u);
            const unsigned tg = og / nx;
            if (og + 1u == (tg + 1u) * nx) xb_add(&bar[XB_TOPGEN], 1u);
            else XB_SPIN(xb_ld(&bar[XB_TOPGEN]) == tg, bar);
            __builtin_amdgcn_fence(__ATOMIC_ACQUIRE, "agent");
            xb_add(&bar[XB_XGEN(b.x)], 1u);
            asm volatile("s_waitcnt vmcnt(0)" ::: "memory");
        } else {
            XB_SPIN(xb_ld(&bar[XB_XGEN(b.x)]) == gen, bar);
            __builtin_amdgcn_fence(__ATOMIC_ACQUIRE, "agent");
            asm volatile("s_waitcnt vmcnt(0)" ::: "memory");
        }
    }
    __syncthreads();
}

struct EpiQKVG {
    static constexpr bool PERM = true, AFTER_DRAIN = false;
    bf16* O; float* dout;
    DI void operator()(const pg8::f32x4 (&acc)[2][2][4][2], const pg8::Unit& u, int wr, int wc, int fr, int fq) const {
        const float sc = (u.pn < 4) ? QSCALE : 1.f;
        const bool kv = (u.pn == 4 || u.pn == 5);
#pragma unroll
        for (int ai = 0; ai < 2; ++ai)
#pragma unroll
            for (int m = 0; m < 4; ++m) {
                const int row = u.pm * 256 + ai * 128 + wr * 64 + m * 16 + fr;
                float* wdst = nullptr;
                if (kv) {
                    if (row < MP) { const int t = row & 4095; if (t >= 3968) wdst = dout + (u.pn == 4 ? O_KWP : O_VWP) + ((size_t)((row >> 12) * 128 + (t - 3968))) * 256; }
                    else { const int s = row - MP; wdst = dout + (u.pn == 4 ? O_KWS : O_VWS) + ((size_t)((s >> 5) * 128 + 96 + (s & 31))) * 256; }
                }
#pragma unroll
                for (int bj = 0; bj < 2; ++bj) {
                    const int cin = bj * 128 + wc * 32 + 8 * fq;
                    const f32x4 v0 = acc[ai][bj][m][0] * sc, v1 = acc[ai][bj][m][1] * sc;
                    u32x4 w; w.x = pk2(v0[0], v0[1]); w.y = pk2(v0[2], v0[3]); w.z = pk2(v1[0], v1[1]); w.w = pk2(v1[2], v1[3]);
                    *(u32x4*)(O + (size_t)row * 2560 + u.pn * 256 + cin) = w;
                    if (wdst) { *(f32x4*)(wdst + cin) = v0; *(f32x4*)(wdst + cin + 4) = v1; }
                }
            }
    }
};

struct EpiRes {
    static constexpr bool PERM = true, AFTER_DRAIN = false;
    const float* xp; const float* xs; float* y; bf16* XN; const float* g; float* ss;
    DI void operator()(const pg8::f32x4 (&acc)[2][2][4][2], const pg8::Unit& u, int wr, int wc, int fr, int fq) const {
#pragma unroll
        for (int ai = 0; ai < 2; ++ai)
#pragma unroll
            for (int m = 0; m < 4; ++m) {
                const int row = u.pm * 256 + ai * 128 + wr * 64 + m * 16 + fr;
                const float* xr = (row < MP || xs == nullptr) ? xp + (size_t)row * DM : xs + (size_t)(row - MP) * DM;
                float s = 0.f;
#pragma unroll
                for (int bj = 0; bj < 2; ++bj) {
                    const int col = u.pn * 256 + bj * 128 + wc * 32 + 8 * fq;
                    const f32x4 a0 = *(const f32x4*)(xr + col), a1 = *(const f32x4*)(xr + col + 4);
                    const f32x4 v0 = acc[ai][bj][m][0] + a0, v1 = acc[ai][bj][m][1] + a1;
                    *(f32x4*)(y + (size_t)row * DM + col) = v0; *(f32x4*)(y + (size_t)row * DM + col + 4) = v1;
                    s += (v0[0] * v0[0] + v0[1] * v0[1]) + (v0[2] * v0[2] + v0[3] * v0[3]) + (v1[0] * v1[0] + v1[1] * v1[1]) + (v1[2] * v1[2] + v1[3] * v1[3]);
                    if (XN) {
                        const f32x4 g0 = *(const f32x4*)(g + col), g1 = *(const f32x4*)(g + col + 4);
                        u32x4 w; w.x = pk2(v0[0] * g0[0], v0[1] * g0[1]); w.y = pk2(v0[2] * g0[2], v0[3] * g0[3]); w.z = pk2(v1[0] * g1[0], v1[1] * g1[1]); w.w = pk2(v1[2] * g1[2], v1[3] * g1[3]);
                        *(u32x4*)(XN + (size_t)row * DM + col) = w;
                    }
                }
                s += __shfl_xor(s, 16); s += __shfl_xor(s, 32);
                if (fq == 0) atomicAdd(ss + row, s);
            }
    }
};

struct EpiDN {
    static constexpr bool PERM = true, AFTER_DRAIN = false;
    bf16* O; bf16* halo; float* ba; const float* ss; float* dout;
    DI void operator()(const pg8::f32x4 (&acc)[2][2][4][2], const pg8::Unit& u, int wr, int wc, int fr, int fq) const {
#pragma unroll
        for (int ai = 0; ai < 2; ++ai)
#pragma unroll
            for (int m = 0; m < 4; ++m) {
                const int row = u.pm * 256 + ai * 128 + wr * 64 + m * 16 + fr;
                const float sc = rsqrtf(ss[row] * (1.f / DM) + EPS);
                if (u.pn < 16) {
                    bf16* hdst = nullptr; float* cdst = nullptr;
                    if (u.pn < 12) {
                        if (row < MP) { const int t = row & 63; if (t >= 61) hdst = halo + ((size_t)(row >> 6) * 3 + (t - 61)) * 3072;
                                        const int t4 = row & 4095; if (t4 >= 4093) cdst = dout + O_CONVP + ((size_t)(row >> 12) * 3 + (t4 - 4093)) * 3072; }
                        else { const int s = row - MP, t = s & 31; if (t >= 29) cdst = dout + O_CONVS + ((size_t)(s >> 5) * 3 + (t - 29)) * 3072; }
                    }
#pragma unroll
                    for (int bj = 0; bj < 2; ++bj) {
                        const int col = u.pn * 256 + bj * 128 + wc * 32 + 8 * fq;
                        const f32x4 v0 = acc[ai][bj][m][0] * sc, v1 = acc[ai][bj][m][1] * sc;
                        u32x4 w; w.x = pk2(v0[0], v0[1]); w.y = pk2(v0[2], v0[3]); w.z = pk2(v1[0], v1[1]); w.w = pk2(v1[2], v1[3]);
                        *(u32x4*)(O + (size_t)row * 4096 + col) = w;
                        if (hdst) *(u32x4*)(hdst + col) = w;
                        if (cdst) { *(f32x4*)(cdst + col) = v0; *(f32x4*)(cdst + col + 4) = v1; }
                    }
                } else if (wc == 0 && fq < 2) {
                    const f32x4 v0 = acc[ai][0][m][0] * sc, v1 = acc[ai][0][m][1] * sc;
                    *(f32x4*)(ba + (size_t)row * 16 + 8 * fq) = v0; *(f32x4*)(ba + (size_t)row * 16 + 8 * fq + 4) = v1;
                }
            }
    }
};

DI void p0_transpose_item(const float* W, int K, int ld, int nblk, bf16* WT, LAS float* scr, int item, int lane) {
    const int kb = item / nblk, nb = item % nblk, k0 = 64 * kb, n0 = 32 * nb;
#pragma unroll 8
    for (int i = 0; i < 32; ++i) { const int kk = 2 * i + (lane >> 5); scr[kk * 33 + (lane & 31)] = W[(size_t)(k0 + kk) * ld + n0 + (lane & 31)]; }
    asm volatile("s_waitcnt lgkmcnt(0)" ::: "memory");
    const int c = lane & 7;
#pragma unroll
    for (int j = 0; j < 4; ++j) { const int n = (lane >> 3) + 8 * j; const LAS float* s = scr + (8 * c) * 33 + n;
        u32x4 o; o.x = pk2(s[0 * 33], s[1 * 33]); o.y = pk2(s[2 * 33], s[3 * 33]); o.z = pk2(s[4 * 33], s[5 * 33]); o.w = pk2(s[6 * 33], s[7 * 33]);
        *(u32x4*)(WT + (size_t)(n0 + n) * K + k0 + 8 * c) = o; }
    asm volatile("s_waitcnt lgkmcnt(0)" ::: "memory");
}

struct Args { const float* in[17]; float* out; unsigned char* ws; };

DI void p0_prologue(const Args& a, LAS unsigned char* lds, int tid, int lane, int w) {
    LAS float* scr = (LAS float*)(lds + w * 16384);
    const int gw = blockIdx.x * 8 + w, NGW = gridDim.x * 8;
    const float* W1 = a.in[8]; const float* Wo1 = a.in[10]; const float* W2 = a.in[11]; const float* Wo2 = a.in[16];
    bf16* W1T = (bf16*)(a.ws + WS_W1T); bf16* WO1T = (bf16*)(a.ws + WS_WO1T); bf16* W2T = (bf16*)(a.ws + WS_W2T); bf16* WO2T = (bf16*)(a.ws + WS_WO2T);
    constexpr int I1 = 16 * 80, I2 = 16 * 32, I3 = 16 * 128, I4 = 16 * 32;
    for (int it = gw; it < I1 + I2 + I3 + I4; it += NGW) {
        int r = it;
        if (r < I1) { p0_transpose_item(W1, 1024, 2560, 80, W1T, scr, r, lane); continue; } r -= I1;
        if (r < I2) { p0_transpose_item(Wo1, 1024, 1024, 32, WO1T, scr, r, lane); continue; } r -= I2;
        if (r < I3) { p0_transpose_item(W2, 1024, 4112, 128, W2T, scr, r, lane); continue; } r -= I3;
        p0_transpose_item(Wo2, 1024, 1024, 32, WO2T, scr, r, lane);
    }
    const int gt = blockIdx.x * 512 + tid, NGT = gridDim.x * 512;
    for (int i = gt; i < 16 * 1024; i += NGT) { const int n = i >> 10, k = i & 1023; W2T[(size_t)(4096 + n) * 1024 + k] = f2bf(W2[(size_t)k * 4112 + 4096 + n]); }
    for (int i = gt; i < 240 * 1024 / 8; i += NGT) *(u32x4*)(W2T + (size_t)4112 * 1024 + (size_t)i * 8) = (u32x4){0u, 0u, 0u, 0u};
    float* ss1 = (float*)(a.ws + WS_SS1); float* ss2 = (float*)(a.ws + WS_SS2);
    for (int i = gt; i < MROWS; i += NGT) { ss1[i] = 0.f; ss2[i] = 0.f; }
    const float* ck = a.in[2]; const float* cv = a.in[3];
    for (int i = gt; i < 32 * 96 * 64; i += NGT) { const int sb = i / (96 * 64), rem = i % (96 * 64);
        *(f32x4*)(a.out + O_KWS + (size_t)sb * 32768 + (size_t)rem * 4) = *(const f32x4*)(ck + (size_t)sb * 32768 + 32 * 256 + (size_t)rem * 4);
        *(f32x4*)(a.out + O_VWS + (size_t)sb * 32768 + (size_t)rem * 4) = *(const f32x4*)(cv + (size_t)sb * 32768 + 32 * 256 + (size_t)rem * 4); }
    const float* g0 = a.in[6]; bf16* XN = (bf16*)(a.ws + WS_XN);
    f32x4 gv[4];
#pragma unroll
    for (int j = 0; j < 4; ++j) gv[j] = *(const f32x4*)(g0 + 4 * lane + 256 * j);
    for (int m = gw; m < MROWS; m += NGW) {
        const float* xr = (m < MP) ? a.in[0] + (size_t)m * DM : a.in[1] + (size_t)(m - MP) * DM;
        f32x4 v[4]; float s = 0.f;
#pragma unroll
        for (int j = 0; j < 4; ++j) { v[j] = *(const f32x4*)(xr + 4 * lane + 256 * j); s += (v[j].x * v[j].x + v[j].y * v[j].y) + (v[j].z * v[j].z + v[j].w * v[j].w); }
        const float rs = rsqrtf(wave_sum(s) * (1.f / DM) + EPS);
#pragma unroll
        for (int j = 0; j < 4; ++j) { u32x2 o; o.x = pk2(v[j].x * rs * gv[j].x, v[j].y * rs * gv[j].y); o.y = pk2(v[j].z * rs * gv[j].z, v[j].w * rs * gv[j].w);
            *(u32x2*)(XN + (size_t)m * DM + 4 * lane + 256 * j) = o; }
    }
}

DI void attn_phase(LAS unsigned char* lds, const bf16* QKVG, const float* cache_k, const float* cache_v, const float* sinks, bf16* OG, int tid, int lane, int w) {
    LAS bf16* Ks = (LAS bf16*)lds;
    LAS bf16* VT = (LAS bf16*)(lds + 192 * 72 * 2);
    for (int u = blockIdx.x; u < 2176; u += gridDim.x) {
        asm volatile("" : "+v"(lane), "+v"(tid));
        const int r = lane & 31, hh = lane >> 5;
        int kvh, jmin, jmax, qrow0, sb = 0; bool sample;
        if (u < 2048) { kvh = u & 3; const int bn = u >> 2, b = bn >> 6, n = bn & 63; qrow0 = b * 4096 + 64 * n; jmin = n < 2 ? 64 * (2 - n) : 0; jmax = 192; sample = false; }
        else { const int su = u - 2048; kvh = su & 3; sb = su >> 2; qrow0 = MP + 32 * sb; jmin = 0; jmax = 160; sample = true; }
        __syncthreads();
#pragma unroll
        for (int i = 0; i < 3; ++i) {
            const int id = tid + 512 * i, j = id >> 3, c8 = id & 7;
            u32x4 kv = (u32x4){0u, 0u, 0u, 0u}, vv = (u32x4){0u, 0u, 0u, 0u};
            if (!sample) {
                if (j >= jmin) { const size_t row = (size_t)(qrow0 - 128 + j); kv = *(const u32x4*)(QKVG + row * 2560 + 1024 + kvh * 64 + c8 * 8); vv = *(const u32x4*)(QKVG + row * 2560 + 1280 + kvh * 64 + c8 * 8); }
            } else {
                if (j < 128) { const size_t off = ((size_t)(sb * 128 + j) * 4 + kvh) * 64 + c8 * 8; kv = ld8f_bf(cache_k + off); vv = ld8f_bf(cache_v + off); }
                else if (j < 160) { const size_t row = (size_t)(qrow0 + j - 128); kv = *(const u32x4*)(QKVG + row * 2560 + 1024 + kvh * 64 + c8 * 8); vv = *(const u32x4*)(QKVG + row * 2560 + 1280 + kvh * 64 + c8 * 8); }
            }
            *(LAS u32x4*)(Ks + j * 72 + c8 * 8) = kv;
            const int pos = (j & ~31) | (((j >> 4) & 1) << 4) | (((j >> 2) & 1) << 3) | (((j >> 3) & 1) << 2) | (j & 3);
#pragma unroll
            for (int e = 0; e < 4; ++e) { VT[(c8 * 8 + 2 * e) * 200 + pos] = (bf16)(vv[e] & 0xffffu); VT[(c8 * 8 + 2 * e + 1) * 200 + pos] = (bf16)(vv[e] >> 16); }
        }
        __syncthreads();
        const int g = w >> 1, th = w & 1;
        if (!(sample && th == 1)) {
            const int head = kvh * 4 + g;
            const size_t qrow = (size_t)(qrow0 + 32 * th + r);
            bf16x8 qf[4];
#pragma unroll
            for (int s = 0; s < 4; ++s) qf[s] = *(const bf16x8*)(QKVG + qrow * 2560 + head * 64 + 16 * s + 8 * hh);
            f32x16 sc[6];
#pragma unroll
            for (int kt = 0; kt < 6; ++kt) {
#pragma unroll
                for (int i = 0; i < 16; ++i) sc[kt][i] = 0.f;
#pragma unroll
                for (int s = 0; s < 4; ++s) { const bf16x8 kf = *(const LAS bf16x8*)(Ks + (32 * kt + r) * 72 + 16 * s + 8 * hh); sc[kt] = MFMA32(kf, qf[s], sc[kt]); }
                __builtin_amdgcn_sched_barrier(0);
            }
            const float slope2 = fexp2(-0.5f * (float)(head + 1)) * LOG2E;
            const float sink2 = sinks[head] * LOG2E;
            const int t = 32 * th + r;
            float mx = sink2;
#pragma unroll
            for (int kt = 0; kt < 6; ++kt)
#pragma unroll
                for (int i = 0; i < 16; ++i) { const int j = 32 * kt + crow(i, hh); const float dist = fabsf((float)(128 + t - j));
                    float l = sc[kt][i] - slope2 * dist; l = (j >= jmin && j < jmax) ? l : -INFINITY; sc[kt][i] = l; mx = fmaxf(mx, l); }
            mx = fmaxf(mx, __shfl_xor(mx, 32));
            float sum = 0.f;
#pragma unroll
            for (int kt = 0; kt < 6; ++kt)
#pragma unroll
                for (int i = 0; i < 16; ++i) { const float p = fexp2(sc[kt][i] - mx); sc[kt][i] = p; sum += p; }
            sum += __shfl_xor(sum, 32);
            const float inv = 1.f / (sum + fexp2(sink2 - mx));
            f32x16 o[2];
#pragma unroll
            for (int i = 0; i < 16; ++i) { o[0][i] = 0.f; o[1][i] = 0.f; }
#pragma unroll
            for (int kt = 0; kt < 6; ++kt)
#pragma unroll
                for (int s = 0; s < 2; ++s) {
                    u32x4 pp; pp.x = pk2(sc[kt][8 * s], sc[kt][8 * s + 1]); pp.y = pk2(sc[kt][8 * s + 2], sc[kt][8 * s + 3]); pp.z = pk2(sc[kt][8 * s + 4], sc[kt][8 * s + 5]); pp.w = pk2(sc[kt][8 * s + 6], sc[kt][8 * s + 7]);
                    const bf16x8 pf = __builtin_bit_cast(bf16x8, pp);
#pragma unroll
                    for (int mt = 0; mt < 2; ++mt) { const bf16x8 vf = *(const LAS bf16x8*)(VT + (32 * mt + r) * 200 + 32 * kt + 16 * s + 8 * hh); o[mt] = MFMA32(vf, pf, o[mt]); }
                    __builtin_amdgcn_sched_barrier(0);
                }
#pragma unroll
            for (int mt = 0; mt < 2; ++mt)
#pragma unroll
                for (int i4 = 0; i4 < 4; ++i4) {
                    const int d0 = 32 * mt + 8 * i4 + 4 * hh;
                    const u32x2 gz = *(const u32x2*)(QKVG + qrow * 2560 + 1536 + head * 64 + d0);
                    const float o0 = o[mt][4 * i4] * inv * silu(bflo(gz.x)), o1 = o[mt][4 * i4 + 1] * inv * silu(bfhi(gz.x));
                    const float o2 = o[mt][4 * i4 + 2] * inv * silu(bflo(gz.y)), o3 = o[mt][4 * i4 + 3] * inv * silu(bfhi(gz.y));
                    u32x2 ov; ov.x = pk2(o0, o1); ov.y = pk2(o2, o3);
                    *(u32x2*)(OG + qrow * 1024 + head * 64 + d0) = ov;
                }
        }
    }
    __syncthreads();
}

DI u32x4 zero4() { return (u32x4){0u, 0u, 0u, 0u}; }
DI float bfe(const u32x4& v, int e) { const unsigned u = v[e >> 1]; return (e & 1) ? bfhi(u) : bflo(u); }

DI void dn_pre_phase(const Args& a, int lane, int w) {
    bf16* DNP = (bf16*)(a.ws + WS_BIG); const bf16* HALO = (const bf16*)(a.ws + WS_HALO); float* BA = (float*)(a.ws + WS_BA);
    const float* state_conv = a.in[4]; const float* conv_w = a.in[12]; const float* a_log = a.in[13]; const float* dt_bias = a.in[14];
    const int gw = blockIdx.x * 8 + w, NGW = gridDim.x * 8;
    for (int it = gw; it < 528 * 25; it += NGW) {
        asm volatile("" : "+v"(lane));
        const int ch = it / 25, sub = it % 25;
        if (sub == 24) {
            const size_t row = (size_t)64 * ch + lane; const int width = ch < 512 ? 64 : 32;
            float bv[8], gv[8];
#pragma unroll
            for (int hh = 0; hh < 8; ++hh) { bv[hh] = BA[row * 16 + hh]; gv[hh] = BA[row * 16 + 8 + hh]; }
#pragma unroll
            for (int hh = 0; hh < 8; ++hh) {
                const float beta = 1.f / (1.f + __expf(-bv[hh]));
                const float x = gv[hh] + dt_bias[hh]; const float sp = x > 20.f ? x : log1pf(expf(x));
                float gg = -expf(a_log[hh]) * sp;
#pragma unroll
                for (int d = 1; d < 64; d <<= 1) { const float t = __shfl_up(gg, d, 64); if ((lane & (width - 1)) >= d && d < width) gg += t; }
                BA[row * 16 + hh] = beta; BA[row * 16 + 8 + hh] = gg;
            }
            continue;
        }
        const int h = sub / 3, sec = sub % 3;
        const int g = lane >> 4, cl = lane & 15;
        const int col = sec * 1024 + h * 128 + 8 * cl;
        const size_t R0 = (size_t)64 * ch + 16 * g;
        u32x4 xin[19];
#pragma unroll
        for (int i = 0; i < 16; ++i) xin[3 + i] = *(const u32x4*)(DNP + (R0 + i) * 4096 + col);
        if (ch < 512) {
            if (g > 0) {
#pragma unroll
                for (int i = 0; i < 3; ++i) xin[i] = *(const u32x4*)(DNP + (R0 - 3 + i) * 4096 + col);
            } else if ((ch & 63) == 0) { xin[0] = zero4(); xin[1] = zero4(); xin[2] = zero4(); }
            else {
#pragma unroll
                for (int i = 0; i < 3; ++i) xin[i] = *(const u32x4*)(HALO + ((size_t)(ch - 1) * 3 + i) * 3072 + col);
            }
        } else {
            if (g & 1) {
#pragma unroll
                for (int i = 0; i < 3; ++i) xin[i] = *(const u32x4*)(DNP + (R0 - 3 + i) * 4096 + col);
            } else { const int sb = 2 * (ch - 512) + (g >> 1);
#pragma unroll
                for (int i = 0; i < 3; ++i) xin[i] = ld8f_bf(state_conv + ((size_t)sb * 3 + i) * 3072 + col);
            }
        }
        float wv[4][8];
#pragma unroll
        for (int j = 0; j < 4; ++j) { const f32x4 w0 = *(const f32x4*)(conv_w + (size_t)j * 3072 + col), w1 = *(const f32x4*)(conv_w + (size_t)j * 3072 + col + 4);
            wv[j][0] = w0.x; wv[j][1] = w0.y; wv[j][2] = w0.z; wv[j][3] = w0.w; wv[j][4] = w1.x; wv[j][5] = w1.y; wv[j][6] = w1.z; wv[j][7] = w1.w; }
        asm volatile("s_waitcnt vmcnt(0)" ::: "memory");
        const int clp = cl & 3, pos0 = 32 * (cl >> 2) + 16 * (clp & 1) + 4 * (clp >> 1);
        unsigned vp[4][4];
#pragma unroll
        for (int i = 0; i < 16; ++i) {
            float y[8]; float ssq = 0.f;
#pragma unroll
            for (int e = 0; e < 8; ++e) { float t = wv[0][e] * bfe(xin[i], e) + wv[1][e] * bfe(xin[i + 1], e) + wv[2][e] * bfe(xin[i + 2], e) + wv[3][e] * bfe(xin[i + 3], e);
                t = silu(t); y[e] = t; ssq += t * t; }
            if (sec < 2) {
                ssq += __shfl_xor(ssq, 1); ssq += __shfl_xor(ssq, 2); ssq += __shfl_xor(ssq, 4); ssq += __shfl_xor(ssq, 8);
                const float scl = frsq(ssq + EPS) * (sec == 0 ? 0.08838834764831845f : 1.f);
                u32x2 lo, hi; lo.x = pk2(y[0] * scl, y[1] * scl); lo.y = pk2(y[2] * scl, y[3] * scl); hi.x = pk2(y[4] * scl, y[5] * scl); hi.y = pk2(y[6] * scl, y[7] * scl);
                bf16* dst = DNP + (R0 + i) * 4096 + sec * 1024 + h * 128 + pos0;
                *(u32x2*)dst = lo; *(u32x2*)(dst + 8) = hi;
            } else {
                const u32x4 pk = pack8f(y);
                vp[i & 3][0] = pk.x; vp[i & 3][1] = pk.y; vp[i & 3][2] = pk.z; vp[i & 3][3] = pk.w;
                if ((i & 3) == 3) {
                    bf16* dst = DNP + ((size_t)64 * ch + 4 * (4 * g + (i >> 2)) + (cl >> 2)) * 4096 + 2048 + h * 128 + (cl & 3) * 32;
#pragma unroll
                    for (int j = 0; j < 4; ++j) { u32x4 o;
                        o.x = (vp[0][j] & 0xffffu) | (vp[1][j] << 16); o.y = (vp[2][j] & 0xffffu) | (vp[3][j] << 16);
                        o.z = (vp[0][j] >> 16) | (vp[1][j] & 0xffff0000u); o.w = (vp[2][j] >> 16) | (vp[3][j] & 0xffff0000u);
                        *(u32x4*)(dst + 8 * j) = o; }
                }
            }
        }
    }
}


template <int I, int J4> DI void fs_cols(float& acc, float (&T)[64], const LAS float* Ms) {
    if constexpr (4 * J4 < I) {
        const f32x4 m = *(const LAS f32x4*)(Ms + I * 64 + 4 * J4);
        if constexpr (4 * J4 + 0 < I) acc -= m[0] * T[4 * J4 + 0];
        if constexpr (4 * J4 + 1 < I) acc -= m[1] * T[4 * J4 + 1];
        if constexpr (4 * J4 + 2 < I) acc -= m[2] * T[4 * J4 + 2];
        if constexpr (4 * J4 + 3 < I) acc -= m[3] * T[4 * J4 + 3];
        fs_cols<I, J4 + 1>(acc, T, Ms);
    }
}
template <int I> DI void fs_all(float (&T)[64], const LAS float* Ms, int lane) {
    if constexpr (I < 64) {
        float acc = (lane == I) ? 1.f : 0.f;
        fs_cols<I, 0>(acc, T, Ms);
        T[I] = acc;
        fs_all<I + 1>(T, Ms, lane);
    }
}
template <int I> DI void tb_store(float (&T)[64], LAS bf16* TbI, int lane, float betal) {
    if constexpr (I < 64) { TbI[I * 64 + lane] = f2bf(T[I] * betal); tb_store<I + 1>(T, TbI, lane, betal); }
}
DI void dn_prep_phase(const Args& a, LAS unsigned char* lds, int lane, int w) {
    const bf16* DNP = (const bf16*)(a.ws + WS_BIG); const float* BA = (const float*)(a.ws + WS_BA);
    unsigned char* TBI = a.ws + WS_XN; unsigned char* KTG = a.ws + WS_KT; float* SCAL = (float*)(a.ws + WS_SCAL);
    LAS float* Ms = (LAS float*)(lds + w * 17408);
    LAS bf16* TbI = (LAS bf16*)Ms; LAS bf16* InI = TbI + 4096; LAS bf16* Kl = (LAS bf16*)Ms;
    const int gw = blockIdx.x * 8 + w, NGW = gridDim.x * 8;
    for (int uid = gw; uid < 4352; uid += NGW) {
        asm volatile("" : "+v"(lane));
        const int r = lane & 31, hh = lane >> 5;
        int h, nv; size_t R0;
        if (uid < 4096) { h = uid & 7; R0 = (size_t)64 * (uid >> 3); nv = 64; } else { const int su = uid - 4096; h = su & 7; R0 = (size_t)MP + 32 * (su >> 3); nv = 32; }
        const int lr = lane < nv ? lane : nv - 1;
        const float gcl = BA[(R0 + lr) * 16 + 8 + h];
        const float betal = lane < nv ? BA[(R0 + lane) * 16 + h] : 0.f;
        const bf16* kbase = DNP + R0 * 4096 + 1024 + h * 128; const bf16* qbase = DNP + R0 * 4096 + h * 128;
        bf16x8 kf[2][8];
#pragma unroll
        for (int mt = 0; mt < 2; ++mt)
#pragma unroll
            for (int s = 0; s < 8; ++s) kf[mt][s] = (32 * mt + r < nv) ? *(const bf16x8*)(kbase + (size_t)(32 * mt + r) * 4096 + 16 * s + 8 * hh) : (bf16x8){0, 0, 0, 0, 0, 0, 0, 0};
        f32x16 in00, in10, in11;
#pragma unroll
        for (int tl = 0; tl < 3; ++tl) {
            const int mt = tl > 0 ? 1 : 0, nt = tl > 1 ? 1 : 0;
            f32x16 kk, qk;
#pragma unroll
            for (int i = 0; i < 16; ++i) { kk[i] = 0.f; qk[i] = 0.f; }
#pragma unroll
            for (int s = 0; s < 8; ++s) {
                const bf16x8 qf = (32 * mt + r < nv) ? *(const bf16x8*)(qbase + (size_t)(32 * mt + r) * 4096 + 16 * s + 8 * hh) : (bf16x8){0, 0, 0, 0, 0, 0, 0, 0};
                kk = MFMA32(kf[mt][s], kf[nt][s], kk); qk = MFMA32(qf, kf[nt][s], qk);
            }
            const int j = 32 * nt + r; const float gcj = __shfl(gcl, j);
#pragma unroll
            for (int i = 0; i < 16; ++i) {
                const int ii = 32 * mt + crow(i, hh);
                const float gci = __shfl(gcl, ii), bi = __shfl(betal, ii);
                const float dec = __expf(fminf(gci - gcj, 0.f));
                Ms[ii * 64 + j] = (ii > j) ? kk[i] * bi * dec : 0.f;
                const float iv = (ii >= j) ? qk[i] * dec : 0.f;
                if (tl == 0) in00[i] = iv; else if (tl == 1) in10[i] = iv; else in11[i] = iv;
            }
        }
        float T[64];
        fs_all<0>(T, Ms, lane);
        tb_store<0>(T, TbI, lane, betal);
#pragma unroll
        for (int i = 0; i < 16; ++i) {
            InI[crow(i, hh) * 64 + r] = f2bf(in00[i]); InI[crow(i, hh) * 64 + 32 + r] = 0;
            InI[(32 + crow(i, hh)) * 64 + r] = f2bf(in10[i]); InI[(32 + crow(i, hh)) * 64 + 32 + r] = f2bf(in11[i]);
        }
        const int row = lane & 15, quad = lane >> 4;
#pragma unroll
        for (int f = 0; f < 8; ++f) {
            const int i = 16 * (f >> 1) + row, c0 = 32 * (f & 1) + 4 * quad;
            const u32x2 tlo = *(const LAS u32x2*)(TbI + i * 64 + c0), thi = *(const LAS u32x2*)(TbI + i * 64 + c0 + 16);
            *(u32x4*)(TBI + (size_t)uid * 16384 + (size_t)(f * 64 + lane) * 16) = (u32x4){tlo.x, tlo.y, thi.x, thi.y};
            const u32x2 ilo = *(const LAS u32x2*)(InI + i * 64 + c0), ihi = *(const LAS u32x2*)(InI + i * 64 + c0 + 16);
            *(u32x4*)(TBI + (size_t)uid * 16384 + 8192 + (size_t)(f * 64 + lane) * 16) = (u32x4){ilo.x, ilo.y, ihi.x, ihi.y};
        }
#pragma unroll
        for (int i = 0; i < 16; ++i) { const int id = lane + 64 * i, rr = id >> 4, c16 = id & 15;
            const u32x4 v = (rr < nv) ? *(const u32x4*)(kbase + (size_t)rr * 4096 + 8 * c16) : zero4();
            *(LAS u32x4*)(Kl + rr * 136 + 8 * c16) = v; }
#pragma unroll
        for (int f = 0; f < 16; ++f) {
            const int dk = 16 * (f >> 1) + row, dkp = dk & 31, pos = (dk & ~31) + 8 * ((dkp >> 2) & 3) + 4 * (dkp >> 4) + (dkp & 3);
            u32x4 o;
#pragma unroll
            for (int j2 = 0; j2 < 4; ++j2) { const int tok = 32 * (f & 1) + 16 * (j2 >> 1) + 4 * quad + 2 * (j2 & 1);
                o[j2] = (unsigned)Kl[tok * 136 + pos] | ((unsigned)Kl[(tok + 1) * 136 + pos] << 16); }
            *(u32x4*)(KTG + (size_t)uid * 16384 + (size_t)(f * 64 + lane) * 16) = o;
        }
        const float gl = __shfl(gcl, 63);
        SCAL[(size_t)uid * 256 + lane] = __expf(gcl); SCAL[(size_t)uid * 256 + 64 + lane] = __expf(gl - gcl);
        if (lane == 0) SCAL[(size_t)uid * 256 + 128] = __expf(gl);
    }
}

constexpr int SC_K = 0, SC_Q = 17408, SC_V = 34816, SC_TB = 52224, SC_IN = 60416, SC_KT = 68608, SC_SC = 84992, SC_OB = 86016, SC_OBSZ = 17408;
#define RAW_BARRIER() do { asm volatile("s_waitcnt lgkmcnt(0)" ::: "memory"); __builtin_amdgcn_s_barrier(); asm volatile("" ::: "memory"); } while (0)
DI void dn_scan_phase(const Args& a, LAS unsigned char* lds, int tid, int lane, int w) {
    const bf16* DNP = (const bf16*)(a.ws + WS_BIG); const unsigned char* TBI = a.ws + WS_XN; const unsigned char* KTG = a.ws + WS_KT; const float* SCAL = (const float*)(a.ws + WS_SCAL);
    bf16* OG = (bf16*)(a.ws + WS_OG); const float* state_ssm = a.in[5]; const float* ng = a.in[15];
    for (int job = blockIdx.x; job < 320; job += gridDim.x) {
        int h, nsteps, nv; size_t Rbase; int uid0, ustep; float* sout; const float* sin = nullptr;
        if (job < 64) { const int b = job >> 3; h = job & 7; nsteps = 64; nv = 64; Rbase = (size_t)b * 4096; uid0 = b * 512 + h; ustep = 8; sout = a.out + O_SSMP + (size_t)(b * 8 + h) * 16384; }
        else { const int s = job - 64, sb = s >> 3; h = s & 7; nsteps = 1; nv = 32; Rbase = (size_t)MP + 32 * sb; uid0 = 4096 + s; ustep = 0; sout = a.out + O_SSMS + (size_t)(sb * 8 + h) * 16384; sin = state_ssm + (size_t)(sb * 8 + h) * 16384; }
        if (w < 4) {
            f32x4 S[2][8];
            { const int col = lane & 15, quad = lane >> 4;
#pragma unroll
              for (int nt = 0; nt < 2; ++nt)
#pragma unroll
                for (int t = 0; t < 8; ++t)
#pragma unroll
                    for (int i = 0; i < 4; ++i) S[nt][t][i] = sin ? sin[(size_t)(16 * t + 4 * quad + i) * 128 + 32 * w + 16 * nt + col] : 0.f; }
            for (int n = 0; n < nsteps; ++n) {
                asm volatile("" : "+v"(lane));
                const int col = lane & 15, quad = lane >> 4;
                RAW_BARRIER();
                RAW_BARRIER();
                bf16x8 sB[2][4];
#pragma unroll
                for (int nt = 0; nt < 2; ++nt)
#pragma unroll
                    for (int ks = 0; ks < 4; ++ks) { u32x4 p; p.x = pk2(S[nt][2 * ks][0], S[nt][2 * ks][1]); p.y = pk2(S[nt][2 * ks][2], S[nt][2 * ks][3]); p.z = pk2(S[nt][2 * ks + 1][0], S[nt][2 * ks + 1][1]); p.w = pk2(S[nt][2 * ks + 1][2], S[nt][2 * ks + 1][3]); sB[nt][ks] = __builtin_bit_cast(bf16x8, p); }
                f32x4 kS[2][4], qS[2][4];
#pragma unroll
                for (int mt = 0; mt < 4; ++mt) {
#pragma unroll
                    for (int nt = 0; nt < 2; ++nt) { kS[nt][mt] = (f32x4){0.f, 0.f, 0.f, 0.f}; qS[nt][mt] = (f32x4){0.f, 0.f, 0.f, 0.f}; }
#pragma unroll
                    for (int ks = 0; ks < 4; ++ks) { const int off = (16 * mt + col) * 272 + 64 * ks + 16 * quad;
                        const bf16x8 ka = *(const LAS bf16x8*)(lds + SC_K + off), qa = *(const LAS bf16x8*)(lds + SC_Q + off);
#pragma unroll
                        for (int nt = 0; nt < 2; ++nt) { kS[nt][mt] = MFMA16(ka, sB[nt][ks], kS[nt][mt]); qS[nt][mt] = MFMA16(qa, sB[nt][ks], qS[nt][mt]); } }
                }
#define EVL(mt) (*(const LAS f32x4*)(lds + SC_SC + (16 * (mt) + 4 * quad) * 4))
#define DVL(mt) (*(const LAS f32x4*)(lds + SC_SC + (64 + 16 * (mt) + 4 * quad) * 4))
                const float gam = *(const LAS float*)(lds + SC_SC + 128 * 4);
                bf16x8 vB[2][2], vdB[2][2];
#pragma unroll
                for (int nt = 0; nt < 2; ++nt) {
                    f32x4 rr4[4];
#pragma unroll
                    for (int mt = 0; mt < 4; ++mt) { const u32x2 vv = *(const LAS u32x2*)(lds + SC_V + (4 * (4 * mt + quad) + w) * 272 + (16 * nt + col) * 8); const f32x4 ev = EVL(mt);
                        rr4[mt][0] = bflo(vv.x) - ev[0] * kS[nt][mt][0]; rr4[mt][1] = bfhi(vv.x) - ev[1] * kS[nt][mt][1];
                        rr4[mt][2] = bflo(vv.y) - ev[2] * kS[nt][mt][2]; rr4[mt][3] = bfhi(vv.y) - ev[3] * kS[nt][mt][3]; }
                    bf16x8 rB[2];
#pragma unroll
                    for (int k2 = 0; k2 < 2; ++k2) { u32x4 p; p.x = pk2(rr4[2 * k2][0], rr4[2 * k2][1]); p.y = pk2(rr4[2 * k2][2], rr4[2 * k2][3]); p.z = pk2(rr4[2 * k2 + 1][0], rr4[2 * k2 + 1][1]); p.w = pk2(rr4[2 * k2 + 1][2], rr4[2 * k2 + 1][3]); rB[k2] = __builtin_bit_cast(bf16x8, p); }
                    f32x4 vn[4];
#pragma unroll
                    for (int mt = 0; mt < 4; ++mt) { vn[mt] = (f32x4){0.f, 0.f, 0.f, 0.f};
#pragma unroll
                        for (int k2 = 0; k2 < 2; ++k2) { if (k2 == 1 && mt < 2) continue; const bf16x8 ta = *(const LAS bf16x8*)(lds + SC_TB + ((mt * 2 + k2) * 64 + lane) * 16); vn[mt] = MFMA16(ta, rB[k2], vn[mt]); } }
#pragma unroll
                    for (int k2 = 0; k2 < 2; ++k2) { u32x4 p, q; f32x4 dv[4]; dv[2 * k2] = DVL(2 * k2); dv[2 * k2 + 1] = DVL(2 * k2 + 1);
                        p.x = pk2(vn[2 * k2][0], vn[2 * k2][1]); p.y = pk2(vn[2 * k2][2], vn[2 * k2][3]); p.z = pk2(vn[2 * k2 + 1][0], vn[2 * k2 + 1][1]); p.w = pk2(vn[2 * k2 + 1][2], vn[2 * k2 + 1][3]);
                        q.x = pk2(vn[2 * k2][0] * dv[2 * k2][0], vn[2 * k2][1] * dv[2 * k2][1]); q.y = pk2(vn[2 * k2][2] * dv[2 * k2][2], vn[2 * k2][3] * dv[2 * k2][3]);
                        q.z = pk2(vn[2 * k2 + 1][0] * dv[2 * k2 + 1][0], vn[2 * k2 + 1][1] * dv[2 * k2 + 1][1]); q.w = pk2(vn[2 * k2 + 1][2] * dv[2 * k2 + 1][2], vn[2 * k2 + 1][3] * dv[2 * k2 + 1][3]);
                        vB[nt][k2] = __builtin_bit_cast(bf16x8, p); vdB[nt][k2] = __builtin_bit_cast(bf16x8, q); }
                }
                LAS bf16* OB = (LAS bf16*)(lds + SC_OB + (n & 1) * SC_OBSZ);
#pragma unroll
                for (int mt = 0; mt < 4; ++mt) {
                    f32x4 o[2];
#pragma unroll
                    for (int nt = 0; nt < 2; ++nt) o[nt] = EVL(mt) * qS[nt][mt];
#pragma unroll
                    for (int k2 = 0; k2 < 2; ++k2) { if (k2 == 1 && mt < 2) continue; const bf16x8 ia = *(const LAS bf16x8*)(lds + SC_IN + ((mt * 2 + k2) * 64 + lane) * 16);
#pragma unroll
                        for (int nt = 0; nt < 2; ++nt) o[nt] = MFMA16(ia, vB[nt][k2], o[nt]); }
#pragma unroll
                    for (int nt = 0; nt < 2; ++nt)
#pragma unroll
                        for (int i = 0; i < 4; ++i) OB[(16 * mt + 4 * quad + i) * 136 + 32 * w + 16 * nt + col] = f2bf(o[nt][i]);
                }
#pragma unroll
                for (int t = 0; t < 8; ++t) {
#pragma unroll
                    for (int nt = 0; nt < 2; ++nt) S[nt][t] = S[nt][t] * gam;
#pragma unroll
                    for (int k2 = 0; k2 < 2; ++k2) { const bf16x8 kt = *(const LAS bf16x8*)(lds + SC_KT + ((t * 2 + k2) * 64 + lane) * 16);
#pragma unroll
                        for (int nt = 0; nt < 2; ++nt) S[nt][t] = MFMA16(kt, vdB[nt][k2], S[nt][t]); } }
            }
            RAW_BARRIER();
            { const int col = lane & 15, quad = lane >> 4;
#pragma unroll
              for (int nt = 0; nt < 2; ++nt)
#pragma unroll
                for (int t = 0; t < 8; ++t)
#pragma unroll
                    for (int i = 0; i < 4; ++i) sout[(size_t)(16 * t + 4 * quad + i) * 128 + 32 * w + 16 * nt + col] = S[nt][t][i]; }
        } else {
            int ht = tid - 256;
            u32x4 pf[20]; float pfs = 0.f; u32x4 zr[4];
#define SCAN_PREFETCH(n) do { const size_t R0_ = Rbase + (size_t)64 * (n); const int uid_ = uid0 + ustep * (n); \
                _Pragma("unroll") for (int i_ = 0; i_ < 4; ++i_) { const int id_ = ht + 256 * i_, rr_ = id_ >> 4, c16_ = id_ & 15; const bool ok_ = rr_ < nv; \
                    const bf16* src_ = DNP + (R0_ + rr_) * 4096 + h * 128 + 8 * c16_; \
                    pf[i_] = ok_ ? *(const u32x4*)(src_ + 1024) : zero4(); pf[4 + i_] = ok_ ? *(const u32x4*)(src_) : zero4(); pf[8 + i_] = ok_ ? *(const u32x4*)(src_ + 2048) : zero4(); \
                    pf[12 + i_] = *(const u32x4*)(KTG + (size_t)uid_ * 16384 + (size_t)id_ * 16); } \
                _Pragma("unroll") for (int i_ = 0; i_ < 2; ++i_) { pf[16 + i_] = *(const u32x4*)(TBI + (size_t)uid_ * 16384 + (size_t)(ht + 256 * i_) * 16); pf[18 + i_] = *(const u32x4*)(TBI + (size_t)uid_ * 16384 + 8192 + (size_t)(ht + 256 * i_) * 16); } \
                if (ht < 132) pfs = SCAL[(size_t)uid_ * 256 + ht]; } while (0)
#define SCAN_ZLOAD(n) do { const bf16* zs_ = DNP + (Rbase + (size_t)64 * (n) + (ht >> 2)) * 4096 + 3072 + h * 128 + 32 * (ht & 3); const bool okz_ = (ht >> 2) < nv; \
                  _Pragma("unroll") for (int j_ = 0; j_ < 4; ++j_) zr[j_] = okz_ ? *(const u32x4*)(zs_ + 8 * j_) : zero4(); } while (0)
#define SCAN_EPILOGUE(n) do { const LAS bf16* OB_ = (const LAS bf16*)(lds + SC_OB + ((n) & 1) * SC_OBSZ) + (ht >> 2) * 136 + 32 * (ht & 3); \
                u32x4 ov_[4]; float ss_ = 0.f; \
                _Pragma("unroll") for (int j_ = 0; j_ < 4; ++j_) { ov_[j_] = *(const LAS u32x4*)(OB_ + 8 * j_); \
                    _Pragma("unroll") for (int e_ = 0; e_ < 4; ++e_) { const float x0_ = bflo(ov_[j_][e_]), x1_ = bfhi(ov_[j_][e_]); ss_ += x0_ * x0_ + x1_ * x1_; } } \
                ss_ += __shfl_xor(ss_, 1); ss_ += __shfl_xor(ss_, 2); \
                const float rs_ = frsq(ss_ * (1.f / 128.f) + EPS); \
                if ((ht >> 2) < nv) { bf16* od_ = OG + (Rbase + (size_t)64 * (n) + (ht >> 2)) * 1024 + h * 128 + 32 * (ht & 3); \
                    _Pragma("unroll") for (int j_ = 0; j_ < 4; ++j_) { u32x4 o_; \
                        _Pragma("unroll") for (int e_ = 0; e_ < 4; ++e_) { const float g0_ = ngv[j_ * 8 + 2 * e_], g1_ = ngv[j_ * 8 + 2 * e_ + 1]; \
                            o_[e_] = pk2(bflo(ov_[j_][e_]) * rs_ * g0_ * silu(bflo(zr[j_][e_])), bfhi(ov_[j_][e_]) * rs_ * g1_ * silu(bfhi(zr[j_][e_]))); } \
                        *(u32x4*)(od_ + 8 * j_) = o_; } } } while (0)
            float ngv[32];
#pragma unroll
            for (int j = 0; j < 8; ++j) { const f32x4 g4 = *(const f32x4*)(ng + 32 * (ht & 3) + 4 * j); ngv[4 * j] = g4.x; ngv[4 * j + 1] = g4.y; ngv[4 * j + 2] = g4.z; ngv[4 * j + 3] = g4.w; }
            SCAN_PREFETCH(0);
            for (int nn = 0; nn < nsteps; ++nn) {
                asm volatile("" : "+v"(ht));
                RAW_BARRIER();
#pragma unroll
                for (int i = 0; i < 4; ++i) { const int id = ht + 256 * i, rr = id >> 4, c16 = id & 15; const int off = rr * 272 + c16 * 16;
                    *(LAS u32x4*)(lds + SC_K + off) = pf[i]; *(LAS u32x4*)(lds + SC_Q + off) = pf[4 + i]; *(LAS u32x4*)(lds + SC_V + off) = pf[8 + i];
                    *(LAS u32x4*)(lds + SC_KT + id * 16) = pf[12 + i]; }
#pragma unroll
                for (int i = 0; i < 2; ++i) { *(LAS u32x4*)(lds + SC_TB + (ht + 256 * i) * 16) = pf[16 + i]; *(LAS u32x4*)(lds + SC_IN + (ht + 256 * i) * 16) = pf[18 + i]; }
                if (ht < 132) *(LAS float*)(lds + SC_SC + ht * 4) = pfs;
                RAW_BARRIER();
                if (nn + 1 < nsteps) SCAN_PREFETCH(nn + 1);
                if (nn >= 1) SCAN_EPILOGUE(nn - 1);
                SCAN_ZLOAD(nn);
            }
            RAW_BARRIER();
            SCAN_EPILOGUE(nsteps - 1);
#undef SCAN_PREFETCH
#undef SCAN_ZLOAD
#undef SCAN_EPILOGUE
        }
        __syncthreads();
    }
}

DI void final_norm_phase(const Args& a, int lane, int w) {
    const float* gf = a.in[7]; const float* ss2 = (const float*)(a.ws + WS_SS2);
    const int gw = blockIdx.x * 8 + w, NGW = gridDim.x * 8;
    f32x4 gv[4];
#pragma unroll
    for (int j = 0; j < 4; ++j) gv[j] = *(const f32x4*)(gf + 4 * lane + 256 * j);
    for (int m = gw; m < MROWS; m += NGW) {
        float* yr = a.out + (size_t)m * DM; const float rs = rsqrtf(ss2[m] * (1.f / DM) + EPS);
#pragma unroll
        for (int j = 0; j < 4; ++j) { f32x4 v = *(const f32x4*)(yr + 4 * lane + 256 * j); v = v * rs * gv[j]; *(f32x4*)(yr + 4 * lane + 256 * j) = v; }
    }
}

#ifndef N_PHASES
#define N_PHASES 10
#endif
__global__ void __launch_bounds__(512, 2) mega_fwd(Args a, int ph_lo, int ph_hi, int coop) {
    extern __shared__ __attribute__((aligned(16))) unsigned char lds_raw[];
    LAS unsigned char* lds = (LAS unsigned char*)lds_raw;
    const int tid = threadIdx.x, lane = tid & 63, w = __builtin_amdgcn_readfirstlane(tid >> 6);
    cg::grid_group grid = cg::this_grid();
    unsigned* barw = (unsigned*)a.ws;
    volatile LAS unsigned* bst = (volatile LAS unsigned*)(lds + LDS_BYTES - 64);
    if (tid < 16) bst[tid] = 0u;
    if (coop && blockIdx.x == 0) for (int i = tid; i < XCD_BAR_WORDS; i += 512) barw[i] = 0u;
    __syncthreads();
    XcdBarrier xbar; xbar.bar = barw; xbar.x = 0; xbar.st = bst;
    bf16* XN = (bf16*)(a.ws + WS_XN); bf16* BIG = (bf16*)(a.ws + WS_BIG); bf16* OG = (bf16*)(a.ws + WS_OG);
    float* ss1 = (float*)(a.ws + WS_SS1); float* ss2 = (float*)(a.ws + WS_SS2);
#ifndef PH_MASK
#define PH_MASK 0x3ff
#endif
#define IN(k) (((PH_MASK >> (k)) & 1) && ph_lo <= (k) && (k) < ph_hi)
#define SEAM(k) do { if (coop && IN(k) && IN((k) + 1)) { if ((k) == 0) { grid.sync(); xbar = xcd_barrier_post(barw, bst); } else xcd_barrier(xbar); } } while (0)
#ifndef REP_MASK
#define REP_MASK 0
#endif
#define REP(k) for (int rep_ = 0; rep_ < 1 + ((REP_MASK >> (k)) & 1); ++rep_)
    if (IN(0)) REP(0) { p0_prologue(a, lds, tid, lane, w); }
    SEAM(0);
#ifdef EXTRA_SYNCS
    if (coop) for (int es_ = 0; es_ < EXTRA_SYNCS; ++es_) grid.sync();
#endif
    if (IN(1)) REP(1) { pg8::Gemm g{XN, (const bf16*)(a.ws + WS_W1T), MROWS, 2560, 1024}; pg8::StaticOrder S; S.init(MROWS, 2560, gridDim.x, blockIdx.x);
        EpiQKVG E{BIG, a.out}; pg8::gemm_phase<EpiQKVG, pg8::StaticOrder, true, true>(lds, g, S, E); }
    SEAM(1);
    if (IN(2)) REP(2) { attn_phase(lds, BIG, a.in[2], a.in[3], a.in[9], OG, tid, lane, w); }
    SEAM(2);
    if (IN(3)) { pg8::Gemm g{OG, (const bf16*)(a.ws + WS_WO1T), MROWS, 1024, 1024}; pg8::StaticOrder S; S.init(MROWS, 1024, gridDim.x, blockIdx.x);
        EpiRes E{a.in[0], a.in[1], a.out, XN, a.in[6] + 1024, ss1}; pg8::gemm_phase<EpiRes, pg8::StaticOrder, true, true>(lds, g, S, E); }
    SEAM(3);
    if (IN(4)) REP(4) { pg8::Gemm g{XN, (const bf16*)(a.ws + WS_W2T), MROWS, 4352, 1024}; pg8::StaticOrder S; S.init(MROWS, 4352, gridDim.x, blockIdx.x);
        EpiDN E{BIG, (bf16*)(a.ws + WS_HALO), (float*)(a.ws + WS_BA), ss1, a.out}; pg8::gemm_phase<EpiDN, pg8::StaticOrder, true, true>(lds, g, S, E); }
    SEAM(4);
    if (IN(5)) { dn_pre_phase(a, lane, w); }
    SEAM(5);
    if (IN(6)) REP(6) { dn_prep_phase(a, lds, lane, w); }
    SEAM(6);
    if (IN(7)) REP(7) { dn_scan_phase(a, lds, tid, lane, w); }
    SEAM(7);
    if (IN(8)) { pg8::Gemm g{OG, (const bf16*)(a.ws + WS_WO2T), MROWS, 1024, 1024}; pg8::StaticOrder S; S.init(MROWS, 1024, gridDim.x, blockIdx.x);
        EpiRes E{a.out, nullptr, a.out, nullptr, nullptr, ss2}; pg8::gemm_phase<EpiRes, pg8::StaticOrder, true, true>(lds, g, S, E); }
    SEAM(8);
    if (IN(9)) { final_norm_phase(a, lane, w); }
#undef IN
#undef SEAM
}

#ifndef MULTI_LAUNCH
#define MULTI_LAUNCH 0
#endif
extern "C" void kernel_launch(void* const* d_in, const int* in_sizes, int n_in, void* d_out, int out_size, void* d_ws, size_t ws_size, hipStream_t stream) {
    static int grid = 0;
    if (grid == 0) {
        int dev = 0, cus = 0, per_cu = 0;
        if (n_in != 17 || ws_size < WS_END) { fprintf(stderr, "kernel_launch: unexpected n_in %d / ws_size %zu\n", n_in, ws_size); grid = -1; return; }
        if (hipGetDevice(&dev) != hipSuccess || hipDeviceGetAttribute(&cus, hipDeviceAttributeMultiprocessorCount, dev) != hipSuccess) { grid = -1; return; }
        if (hipFuncSetAttribute((const void*)mega_fwd, hipFuncAttributeMaxDynamicSharedMemorySize, LDS_BYTES) != hipSuccess) { fprintf(stderr, "kernel_launch: hipFuncSetAttribute failed\n"); grid = -1; return; }
        if (hipOccupancyMaxActiveBlocksPerMultiprocessor(&per_cu, (const void*)mega_fwd, 512, LDS_BYTES) != hipSuccess || per_cu < 1) { fprintf(stderr, "kernel_launch: occupancy query gave %d\n", per_cu); per_cu = 1; }
        (void)hipGetLastError();
        grid = cus * (per_cu > 1 ? 1 : per_cu);
        if (grid < 64) grid = 64;
    }
    if (grid < 0) return;
    Args a{};
    for (int i = 0; i < 17; ++i) a.in[i] = (const float*)d_in[i];
    a.out = (float*)d_out; a.ws = (unsigned char*)d_ws;
#if MULTI_LAUNCH
    for (int p = 0; p < N_PHASES; ++p) { int lo = p, hi = p + 1, coop = 0; hipLaunchKernelGGL(mega_fwd, dim3(grid), dim3(512), LDS_BYTES, stream, a, lo, hi, coop); }
#else
    int lo = 0, hi = N_PHASES, coop = 1;
    void* args[] = {&a, &lo, &hi, &coop};
    hipError_t e = hipLaunchCooperativeKernel((const void*)mega_fwd, dim3(grid), dim3(512), args, LDS_BYTES, stream);
    if (e != hipSuccess) fprintf(stderr, "kernel_launch: cooperative launch failed: %s (grid %d)\n", hipGetErrorString(e), grid);
#endif
}
```

```cpp
#include <hip/hip_runtime.h>
#include <hip/hip_cooperative_groups.h>
#include <cstdio>
#include <cstdint>
namespace cg = cooperative_groups;
namespace pg8 {
#define PG8_LAS __attribute__((address_space(3)))
typedef unsigned short bf16_t;
typedef short bf16x8 __attribute__((ext_vector_type(8)));
typedef float f32x4 __attribute__((ext_vector_type(4)));
typedef unsigned u32x4 __attribute__((ext_vector_type(4)));
constexpr int BM = 256, BK = 64, HALF = 128, HTB = HALF * BK * 2  , STAGE_BYTES = 8 * HTB, NXCD = 8, WGM = 8;

__host__ __device__ __forceinline__ int lds_byte(int r, int c) { const int st = (r >> 4) * 2 + (c >> 5), rr = r & 15, cc = c & 31, ob = rr * 64 + cc * 2; return st * 1024 + (ob ^ (((ob >> 9) & 1) << 5)); }
__host__ __device__ __forceinline__ void stage_rc(int b, int& R, int& C) { const int st = b / 1024, sb = b % 1024, swz = sb ^ (((sb >> 9) & 1) << 5); R = (st >> 1) * 16 + swz / 64; C = (st & 1) * 32 + (swz % 64) / 2; }
__host__ __device__ __forceinline__ int perm32(int rho) { const int n = rho >> 4, i = rho & 15; return 8 * (i >> 2) + 4 * n + (i & 3); }

struct Unit { int pm, pn; };
struct Gemm { const bf16_t* A; const bf16_t* Bt; int M, N, K; };

struct StaticOrder {
    int nM, nN, nwg, G, c;
    __host__ __device__ void init(int M, int N, int G_, int c_) { nM = M / BM; nN = N / BM; nwg = nM * nN; G = G_; c = c_; }
    __host__ __device__ bool next(int i, Unit& u) const {
        const long L = (long)i * G + c; if (L >= nwg) return false;
        int wgid = (int)L; { const int q = nwg / NXCD, r = nwg % NXCD, xcd = wgid % NXCD, off = wgid / NXCD; wgid = (xcd < r ? xcd * (q + 1) : r * (q + 1) + (xcd - r) * q) + off; }
        const int nig = WGM * nN, gid = wgid / nig, fm = gid * WGM, gsz = (nM - fm) < WGM ? (nM - fm) : WGM;
        u.pm = fm + ((wgid % nig) % gsz); u.pn = (wgid % nig) / gsz; return true;
    }
    __device__ __forceinline__ void a_ready(const Unit&) const {}
    __device__ __forceinline__ void done(const Unit&) const {}
};

__device__ __forceinline__ unsigned cvt_pk_bf16(float lo, float hi) { unsigned r; asm volatile("v_cvt_pk_bf16_f32 %0, %1, %2" : "=v"(r) : "v"(lo), "v"(hi)); return r; }

template <class Epi, class Sched, bool ALIGN_EPI = false, bool SP2 = false>
__device__ __forceinline__ void gemm_phase(PG8_LAS unsigned char* lds, const Gemm g, const Sched& S, const Epi& E) {
    const int tid = threadIdx.x, wid = __builtin_amdgcn_readfirstlane(tid >> 6), lane = tid & 63, wr = wid >> 2, wc = wid & 3, fr = lane & 15, fq = lane >> 4;
    const int K = g.K, nt = K / BK;
    unsigned voffA[2], voffB[2];
#pragma unroll
    for (int i = 0; i < 2; ++i) { int R, C; stage_rc(tid * 16 + i * 8192, R, C); const int Rb = Epi::PERM ? ((R & ~31) + perm32(R & 31)) : R;
        voffA[i] = (unsigned)(R * K + C) * 2u; voffB[i] = (unsigned)(Rb * K + C) * 2u; }
    const size_t kstep = (size_t)(BK * 2);
    const size_t hstep = (size_t)HALF * K * 2;
    const size_t tstep = 2 * hstep;
    const unsigned ldsw = (unsigned)wid * 1024u;
    const int aoff = lds_byte(wr * 64 + fr, fq * 8), boff = lds_byte(wc * 32 + fr, fq * 8);
#define PG8_SA(b, h) (((b) * 2 + (h)) * HTB)
#define PG8_SB(b, h) ((4 + (b) * 2 + (h)) * HTB)
#define PG8_STAGE(bufoff, gbase, voff) do { _Pragma("unroll") for (int _i = 0; _i < 2; ++_i) \
        __builtin_amdgcn_global_load_lds((const unsigned*)((const char*)(gbase) + (voff)[_i]), (PG8_LAS unsigned*)(lds + (bufoff) + ldsw + _i * 8192), 16, 0, 0); } while (0)
#define PG8_LDA(dst, b, h) do { _Pragma("unroll") for (int m = 0; m < 4; ++m) _Pragma("unroll") for (int k = 0; k < 2; ++k) dst[m][k] = *(const PG8_LAS bf16x8*)(lds + PG8_SA(b, h) + aoff + m * 2048 + k * 1024); } while (0)
#define PG8_LDB(dst, b, h) do { _Pragma("unroll") for (int n = 0; n < 2; ++n) _Pragma("unroll") for (int k = 0; k < 2; ++k) dst[n][k] = *(const PG8_LAS bf16x8*)(lds + PG8_SB(b, h) + boff + n * 2048 + k * 1024); } while (0)
#define PG8_MMA(ai, bj, At, Bt) do { __builtin_amdgcn_s_setprio(1); _Pragma("unroll") for (int m = 0; m < 4; ++m) _Pragma("unroll") for (int n = 0; n < 2; ++n) _Pragma("unroll") for (int k = 0; k < 2; ++k) \
        acc[ai][bj][m][n] = __builtin_amdgcn_mfma_f32_16x16x32_bf16(Bt[n][k], At[m][k], acc[ai][bj][m][n], 0, 0, 0); __builtin_amdgcn_s_setprio(0); } while (0)
#define PG8_WAIT_V(n) asm volatile("s_waitcnt vmcnt(" #n ")" ::: "memory")
#define PG8_WAIT_L(n) asm volatile("s_waitcnt lgkmcnt(" #n ")" ::: "memory")
#define PG8_BAR __builtin_amdgcn_s_barrier()
#define PG8_SCHED __builtin_amdgcn_sched_barrier(0)
    Unit cur, nxt; int ui = 0;
    if (!S.next(0, cur)) return;
    f32x4 acc[2][2][4][2];
#pragma unroll
    for (int a = 0; a < 2; ++a)
#pragma unroll
        for (int b = 0; b < 2; ++b)
#pragma unroll
            for (int m = 0; m < 4; ++m)
#pragma unroll
                for (int n = 0; n < 2; ++n) acc[a][b][m][n] = (f32x4){0.f, 0.f, 0.f, 0.f};
    bf16x8 At[4][2], B0[2][2], B1[2][2];
    const char* cA = (const char*)g.A + (size_t)cur.pm * tstep; const char* cB = (const char*)g.Bt + (size_t)cur.pn * tstep;
    S.a_ready(cur);
    if constexpr (SP2) {
        PG8_STAGE(PG8_SB(0, 0), cB, voffB); PG8_STAGE(PG8_SB(0, 1), cB + hstep, voffB); PG8_STAGE(PG8_SA(0, 0), cA, voffA); PG8_STAGE(PG8_SA(0, 1), cA + hstep, voffA);
        if (wr == 1) PG8_BAR;
        PG8_WAIT_V(2); PG8_BAR;
        PG8_STAGE(PG8_SB(1, 0), cB + kstep, voffB); PG8_STAGE(PG8_SA(1, 0), cA + kstep, voffA); PG8_STAGE(PG8_SB(1, 1), cB + hstep + kstep, voffB);
        PG8_WAIT_V(6); PG8_BAR;
    } else {
        PG8_STAGE(PG8_SB(0, 0), cB, voffB); PG8_STAGE(PG8_SA(0, 0), cA, voffA); PG8_STAGE(PG8_SB(0, 1), cB + hstep, voffB); PG8_STAGE(PG8_SA(0, 1), cA + hstep, voffA);
        if (wr == 1) PG8_BAR;
        PG8_WAIT_V(4); PG8_BAR;
        PG8_STAGE(PG8_SB(1, 0), cB + kstep, voffB); PG8_STAGE(PG8_SA(1, 0), cA + kstep, voffA); PG8_STAGE(PG8_SB(1, 1), cB + hstep + kstep, voffB);
        PG8_WAIT_V(6); PG8_BAR;
    }
    for (;;) {
        const bool has_next = S.next(ui + 1, nxt);
        const char* nA = has_next ? (const char*)g.A + (size_t)nxt.pm * tstep : cA; const char* nB = has_next ? (const char*)g.Bt + (size_t)nxt.pn * tstep : cB;
        for (int t = 0; t < nt; t += 2) {
            const bool last = (t == nt - 2);
            const char* a1 = cA + (size_t)(t + 1) * kstep;
            const char* a2 = last ? nA : cA + (size_t)(t + 2) * kstep; const char* b2 = last ? nB : cB + (size_t)(t + 2) * kstep;
            const char* a3 = a2 + kstep; const char* b3 = b2 + kstep;
            if (last && has_next) S.a_ready(nxt);
            if constexpr (SP2) {
            PG8_LDB(B0, 0, 0); PG8_LDB(B1, 0, 1); PG8_SCHED; PG8_LDA(At, 0, 0); PG8_STAGE(PG8_SA(1, 1), a1 + hstep, voffA);
            PG8_WAIT_V(8); PG8_WAIT_L(0); PG8_BAR; PG8_MMA(0, 0, At, B0); PG8_MMA(0, 1, At, B1); PG8_BAR; PG8_SCHED;
            PG8_LDA(At, 0, 1); PG8_STAGE(PG8_SB(0, 0), b2, voffB); PG8_STAGE(PG8_SB(0, 1), b2 + hstep, voffB); PG8_STAGE(PG8_SA(0, 0), a2, voffA);
            PG8_WAIT_V(8); PG8_WAIT_L(0); PG8_BAR; PG8_MMA(1, 0, At, B0); PG8_MMA(1, 1, At, B1); PG8_BAR; PG8_SCHED;
            PG8_LDB(B0, 1, 0); PG8_LDB(B1, 1, 1); PG8_SCHED; PG8_LDA(At, 1, 0); PG8_STAGE(PG8_SA(0, 1), a2 + hstep, voffA);
            PG8_WAIT_V(8); PG8_WAIT_L(0); PG8_BAR; PG8_MMA(0, 0, At, B0); PG8_MMA(0, 1, At, B1); PG8_BAR; PG8_SCHED;
            PG8_LDA(At, 1, 1); PG8_STAGE(PG8_SB(1, 0), b3, voffB); PG8_STAGE(PG8_SB(1, 1), b3 + hstep, voffB); PG8_STAGE(PG8_SA(1, 0), a3, voffA);
            PG8_WAIT_V(8); PG8_WAIT_L(0); PG8_BAR; PG8_MMA(1, 0, At, B0); PG8_MMA(1, 1, At, B1); PG8_BAR; PG8_SCHED;
            } else {
            PG8_LDB(B0, 0, 0); PG8_SCHED; PG8_LDA(At, 0, 0); PG8_STAGE(PG8_SA(1, 1), a1 + hstep, voffA);
            PG8_WAIT_L(8); PG8_BAR; PG8_WAIT_L(0); PG8_MMA(0, 0, At, B0); PG8_BAR; PG8_SCHED;
            PG8_LDB(B1, 0, 1); PG8_STAGE(PG8_SB(0, 0), b2, voffB);
            PG8_BAR; PG8_WAIT_L(0); PG8_MMA(0, 1, At, B1); PG8_BAR;
            PG8_LDA(At, 0, 1); PG8_STAGE(PG8_SA(0, 0), a2, voffA);
            PG8_BAR; PG8_WAIT_L(0); PG8_MMA(1, 0, At, B0); PG8_BAR; PG8_SCHED;
            PG8_STAGE(PG8_SB(0, 1), b2 + hstep, voffB);
            PG8_WAIT_V(6); PG8_BAR; PG8_MMA(1, 1, At, B1); PG8_BAR;
            PG8_LDB(B0, 1, 0); PG8_SCHED; PG8_LDA(At, 1, 0); PG8_STAGE(PG8_SA(0, 1), a2 + hstep, voffA);
            PG8_WAIT_L(8); PG8_BAR; PG8_WAIT_L(0); PG8_MMA(0, 0, At, B0); PG8_BAR; PG8_SCHED;
            PG8_LDB(B1, 1, 1); PG8_STAGE(PG8_SB(1, 0), b3, voffB);
            PG8_BAR; PG8_WAIT_L(0); PG8_MMA(0, 1, At, B1); PG8_BAR;
            PG8_LDA(At, 1, 1); PG8_STAGE(PG8_SA(1, 0), a3, voffA);
            PG8_BAR; PG8_WAIT_L(0); PG8_MMA(1, 0, At, B0); PG8_BAR; PG8_SCHED;
            PG8_STAGE(PG8_SB(1, 1), b3 + hstep, voffB);
            PG8_WAIT_V(6); PG8_BAR; PG8_MMA(1, 1, At, B1); PG8_BAR;
            }
        }
        if constexpr (ALIGN_EPI) { if (wr == 0) PG8_BAR; }
        if constexpr (!Epi::AFTER_DRAIN) { E(acc, cur, wr, wc, fr, fq); S.done(cur); }
        if (!has_next) break;
#pragma unroll
        for (int a = 0; a < 2; ++a)
#pragma unroll
            for (int b = 0; b < 2; ++b)
#pragma unroll
                for (int m = 0; m < 4; ++m)
#pragma unroll
                    for (int n = 0; n < 2; ++n) acc[a][b][m][n] = (f32x4){0.f, 0.f, 0.f, 0.f};
        cur = nxt; cA = nA; cB = nB; ++ui;
        if constexpr (ALIGN_EPI) { if (wr == 1) PG8_BAR; }
    }
    PG8_WAIT_V(0);
    if constexpr (!ALIGN_EPI) { if (wr == 0) PG8_BAR; }
    PG8_BAR;
    if constexpr (Epi::AFTER_DRAIN) { E.fused(acc, cur, wr, wc, fr, fq, lds, wid, lane); S.done(cur); }
#undef PG8_SA
#undef PG8_SB
#undef PG8_STAGE
#undef PG8_LDA
#undef PG8_LDB
#undef PG8_MMA
#undef PG8_WAIT_V
#undef PG8_WAIT_L
#undef PG8_BAR
#undef PG8_SCHED
}
}


#define LAS __attribute__((address_space(3)))
typedef unsigned short bf16;
typedef short bf16x8 __attribute__((ext_vector_type(8)));
typedef float f32x4 __attribute__((ext_vector_type(4)));
typedef float f32x16 __attribute__((ext_vector_type(16)));
typedef unsigned u32x4 __attribute__((ext_vector_type(4)));
typedef unsigned u32x2 __attribute__((ext_vector_type(2)));
typedef __bf16 bf16x2_t __attribute__((ext_vector_type(2)));
typedef float f32x2_t __attribute__((ext_vector_type(2)));
#define MFMA32(a, b, c) __builtin_amdgcn_mfma_f32_32x32x16_bf16((a), (b), (c), 0, 0, 0)
#define MFMA16(a, b, c) __builtin_amdgcn_mfma_f32_16x16x32_bf16((a), (b), (c), 0, 0, 0)
#define DI __device__ __forceinline__
#define LDS_BARRIER() do { asm volatile("s_waitcnt lgkmcnt(0)" ::: "memory"); __builtin_amdgcn_s_barrier(); asm volatile("" ::: "memory"); } while (0)

constexpr int DM = 1024, MROWS = 33792, MP = 32768;
constexpr float EPS = 1e-6f;
constexpr float LOG2E = 1.4426950408889634f;
constexpr float QSCALE = 0.125f * LOG2E;
constexpr size_t O_KWP = 34603008, O_VWP = 34865152, O_CONVP = 35127296, O_SSMP = 35201024, O_KWS = 36249600, O_VWS = 37298176, O_CONVS = 38346752, O_SSMS = 38641664;
constexpr size_t MiB = 1u << 20;
constexpr size_t WS_W1T = 1 * MiB, WS_WO1T = 6 * MiB, WS_W2T = 8 * MiB, WS_WO2T = 17 * MiB, WS_BA = 19 * MiB, WS_SS1 = 22 * MiB, WS_SS2 = 22 * MiB + 512 * 1024,
                 WS_HALO = 23 * MiB, WS_SCAL = 33 * MiB, WS_XN = 40 * MiB  , WS_BIG = 110 * MiB  , WS_OG = 374 * MiB, WS_KT = 440 * MiB, WS_END = 508 * MiB;
constexpr int LDS_BYTES = 143360;

DI unsigned pk2(float lo, float hi) { f32x2_t v = {lo, hi}; bf16x2_t b = __builtin_convertvector(v, bf16x2_t); return __builtin_bit_cast(unsigned, b); }
DI float bflo(unsigned u) { return __builtin_bit_cast(float, u << 16); }
DI float bfhi(unsigned u) { return __builtin_bit_cast(float, u & 0xffff0000u); }
DI float bf2f(bf16 u) { return __builtin_bit_cast(float, (unsigned)u << 16); }
DI bf16 f2bf(float f) { return (bf16)(pk2(f, 0.f) & 0xffffu); }
DI int crow(int i, int h) { return (i & 3) + 8 * (i >> 2) + 4 * h; }
DI float fexp2(float x) { return __builtin_amdgcn_exp2f(x); }
DI float silu(float x) { return x * __builtin_amdgcn_rcpf(1.f + __builtin_amdgcn_exp2f(-1.4426950408889634f * x)); }
DI float frsq(float x) { return __builtin_amdgcn_rsqf(x); }
DI float wave_sum(float v) {
#pragma unroll
    for (int o = 1; o < 64; o <<= 1) v += __shfl_xor(v, o);
    return v;
}
DI u32x4 pack8f(const float* p) { u32x4 r; r.x = pk2(p[0], p[1]); r.y = pk2(p[2], p[3]); r.z = pk2(p[4], p[5]); r.w = pk2(p[6], p[7]); return r; }
DI u32x4 ld8f_bf(const float* p) { const f32x4 a = *(const f32x4*)p, b = *(const f32x4*)(p + 4); u32x4 r; r.x = pk2(a.x, a.y); r.y = pk2(a.z, a.w); r.z = pk2(b.x, b.y); r.w = pk2(b.z, b.w); return r; }

#define XB_TMO      128
#define XB_XCNT(j)  (256  + 64 * (j))
#define XB_XSUB(j)  (1280 + 64 * (j))
#define XB_XGEN(j)  (2304 + 64 * (j))
#define XB_TOP      3328
#define XB_TOPGEN   3392
#define XCD_BAR_WORDS 3456
#define XB_SPIN_CAP (1u << 18)

__device__ __forceinline__ unsigned xb_ld(unsigned* p)              { return __hip_atomic_load(p, __ATOMIC_RELAXED, __HIP_MEMORY_SCOPE_AGENT); }
__device__ __forceinline__ unsigned xb_add(unsigned* p, unsigned v) { return __hip_atomic_fetch_add(p, v, __ATOMIC_RELAXED, __HIP_MEMORY_SCOPE_AGENT); }
__device__ __forceinline__ unsigned xb_xcc_id() { return (unsigned)__builtin_amdgcn_s_getreg((3 << 11) | 20) & 0xFu; }
#define XB_SPIN(cond, bar) do { unsigned _sp = 0; while (cond) { __builtin_amdgcn_s_sleep(1); \
    if ((++_sp & 255u) == 0u) { if (xb_ld(&(bar)[XB_TMO])) break; if (_sp > XB_SPIN_CAP) { atomicAdd(&(bar)[XB_TMO], 1u); break; } } } } while (0)

struct XcdBarrier {
    unsigned* bar; unsigned x;
    volatile LAS unsigned* st;
};

__device__ __forceinline__ XcdBarrier xcd_barrier_post(unsigned* bar, volatile LAS unsigned* st) {
    XcdBarrier b; b.bar = bar; b.x = xb_xcc_id(); b.st = st;
    if (threadIdx.x == 0) (void)xb_add(&bar[XB_XCNT(b.x)], 1u);
    return b;
}
__device__ __forceinline__ void xcd_barrier_complete(unsigned* bar, unsigned x, unsigned& nloc, unsigned& nx) {
    const unsigned G = gridDim.x * gridDim.y * gridDim.z;
    unsigned sum, cnt, mine, sp = 0u;
    for (;;) {
        sum = 0u; cnt = 0u; mine = 0u;
#pragma unroll
        for (unsigned j = 0; j < 16; ++j) { const unsigned c = xb_ld(&bar[XB_XCNT(j)]); sum += c; cnt += (c > 0u) ? 1u : 0u; mine = (j == x) ? c : mine; }
        if (sum == G) break;
        __builtin_amdgcn_s_sleep(1);
        if ((++sp & 255u) == 0u) { if (xb_ld(&bar[XB_TMO])) break; if (sp > XB_SPIN_CAP) { atomicAdd(&bar[XB_TMO], 1u); break; } }
    }
    nloc = mine > 0u ? mine : 1u; nx = cnt > 0u ? cnt : 1u;
}

__device__ __forceinline__ void xcd_barrier(const XcdBarrier& b) {
    asm volatile("s_waitcnt vmcnt(0)" ::: "memory");
    __syncthreads();
    if (threadIdx.x == 0) {
        unsigned* bar = b.bar;
        __builtin_amdgcn_s_waitcnt(0);
        unsigned nloc = b.st[0], nx = b.st[1];
        if (nloc == 0u) { xcd_barrier_complete(bar, b.x, nloc, nx); b.st[0] = nloc; b.st[1] = nx; }
        const unsigned old = xb_add(&bar[XB_XSUB(b.x)], 1u);
        const unsigned gen = old / nloc;
        if (old + 1u == (gen + 1u) * nloc) {
            __builtin_amdgcn_fence(__ATOMIC_RELEASE, "agent");
            asm volatile("s_waitcnt vmcnt(0)" ::: "memory");
            const unsigned og = xb_add(&bar[XB_TOP], 1u);
            const unsigned tg = og / nx;
            if (og + 1u == (tg + 1u) * nx) xb_add(&bar[XB_TOPGEN], 1u);
            else XB_SPIN(xb_ld(&bar[XB_TOPGEN]) == tg, bar);
            __builtin_amdgcn_fence(__ATOMIC_ACQUIRE, "agent");
            xb_add(&bar[XB_XGEN(b.x)], 1u);
            asm volatile("s_waitcnt vmcnt(0)" ::: "memory");
        } else {
            XB_SPIN(xb_ld(&bar[XB_XGEN(b.x)]) == gen, bar);
            __builtin_amdgcn_fence(__ATOMIC_ACQUIRE, "agent");
            asm volatile("s_waitcnt vmcnt(0)" ::: "memory");
        }
    }
    __syncthreads();
#undef ATT_LOAD
#undef ATT_DECODE
}

struct EpiQKVG {
    static constexpr bool PERM = true, AFTER_DRAIN = false;
    bf16* O; float* dout;
    DI void operator()(const pg8::f32x4 (&acc)[2][2][4][2], const pg8::Unit& u, int wr, int wc, int fr, int fq) const {
        const float sc = (u.pn < 4) ? QSCALE : 1.f;
        const bool kv = (u.pn == 4 || u.pn == 5);
#pragma unroll
        for (int ai = 0; ai < 2; ++ai)
#pragma unroll
            for (int m = 0; m < 4; ++m) {
                const int row = u.pm * 256 + ai * 128 + wr * 64 + m * 16 + fr;
                float* wdst = nullptr;
                if (kv) {
                    if (row < MP) { const int t = row & 4095; if (t >= 3968) wdst = dout + (u.pn == 4 ? O_KWP : O_VWP) + ((size_t)((row >> 12) * 128 + (t - 3968))) * 256; }
                    else { const int s = row - MP; wdst = dout + (u.pn == 4 ? O_KWS : O_VWS) + ((size_t)((s >> 5) * 128 + 96 + (s & 31))) * 256; }
                }
#pragma unroll
                for (int bj = 0; bj < 2; ++bj) {
                    const int cin = bj * 128 + wc * 32 + 8 * fq;
                    const f32x4 v0 = acc[ai][bj][m][0] * sc, v1 = acc[ai][bj][m][1] * sc;
                    u32x4 w; w.x = pk2(v0[0], v0[1]); w.y = pk2(v0[2], v0[3]); w.z = pk2(v1[0], v1[1]); w.w = pk2(v1[2], v1[3]);
                    *(u32x4*)(O + (size_t)row * 2560 + u.pn * 256 + cin) = w;
                    if (wdst) { *(f32x4*)(wdst + cin) = v0; *(f32x4*)(wdst + cin + 4) = v1; }
                }
            }
    }
};

struct EpiRes {
    static constexpr bool PERM = true, AFTER_DRAIN = false;
    const float* xp; const float* xs; float* y; bf16* XN; const float* g; float* ss; const bf16* xb; bf16* yb;
    DI void operator()(const pg8::f32x4 (&acc)[2][2][4][2], const pg8::Unit& u, int wr, int wc, int fr, int fq) const {
#pragma unroll
        for (int ai = 0; ai < 2; ++ai)
#pragma unroll
            for (int m = 0; m < 4; ++m) {
                const int row = u.pm * 256 + ai * 128 + wr * 64 + m * 16 + fr;
                const float* xr = (row < MP || xs == nullptr) ? xp + (size_t)row * DM : xs + (size_t)(row - MP) * DM;
                float s = 0.f;
#pragma unroll
                for (int bj = 0; bj < 2; ++bj) {
                    const int col = u.pn * 256 + bj * 128 + wc * 32 + 8 * fq;
                    f32x4 a0, a1;
                    if (xb) { const u32x4 xv = *(const u32x4*)(xb + (size_t)row * DM + col); a0 = (f32x4){bflo(xv.x), bfhi(xv.x), bflo(xv.y), bfhi(xv.y)}; a1 = (f32x4){bflo(xv.z), bfhi(xv.z), bflo(xv.w), bfhi(xv.w)}; }
                    else { a0 = *(const f32x4*)(xr + col); a1 = *(const f32x4*)(xr + col + 4); }
                    const f32x4 v0 = acc[ai][bj][m][0] + a0, v1 = acc[ai][bj][m][1] + a1;
                    if (y) { *(f32x4*)(y + (size_t)row * DM + col) = v0; *(f32x4*)(y + (size_t)row * DM + col + 4) = v1; }
                    if (yb) { u32x4 w; w.x = pk2(v0[0], v0[1]); w.y = pk2(v0[2], v0[3]); w.z = pk2(v1[0], v1[1]); w.w = pk2(v1[2], v1[3]); *(u32x4*)(yb + (size_t)row * DM + col) = w; }
                    s += (v0[0] * v0[0] + v0[1] * v0[1]) + (v0[2] * v0[2] + v0[3] * v0[3]) + (v1[0] * v1[0] + v1[1] * v1[1]) + (v1[2] * v1[2] + v1[3] * v1[3]);
                    if (XN) {
                        const f32x4 g0 = *(const f32x4*)(g + col), g1 = *(const f32x4*)(g + col + 4);
                        u32x4 w; w.x = pk2(v0[0] * g0[0], v0[1] * g0[1]); w.y = pk2(v0[2] * g0[2], v0[3] * g0[3]); w.z = pk2(v1[0] * g1[0], v1[1] * g1[1]); w.w = pk2(v1[2] * g1[2], v1[3] * g1[3]);
                        *(u32x4*)(XN + (size_t)row * DM + col) = w;
                    }
                }
                s += __shfl_xor(s, 16); s += __shfl_xor(s, 32);
                if (fq == 0) atomicAdd(ss + row, s);
            }
    }
};

struct EpiDN {
    static constexpr bool PERM = true, AFTER_DRAIN = false;
    bf16* O; bf16* halo; float* ba; const float* ss; float* dout; const float* ng;
    DI void operator()(const pg8::f32x4 (&acc)[2][2][4][2], const pg8::Unit& u, int wr, int wc, int fr, int fq) const {
#pragma unroll
        for (int ai = 0; ai < 2; ++ai)
#pragma unroll
            for (int m = 0; m < 4; ++m) {
                const int row = u.pm * 256 + ai * 128 + wr * 64 + m * 16 + fr;
                const float sc = rsqrtf(ss[row] * (1.f / DM) + EPS);
                if (u.pn < 16) {
                    bf16* hdst = nullptr; float* cdst = nullptr;
                    if (u.pn < 12) {
                        if (row < MP) { const int t = row & 63; if (t >= 61) hdst = halo + ((size_t)(row >> 6) * 3 + (t - 61)) * 3072;
                                        const int t4 = row & 4095; if (t4 >= 4093) cdst = dout + O_CONVP + ((size_t)(row >> 12) * 3 + (t4 - 4093)) * 3072; }
                        else { const int s = row - MP, t = s & 31; if (t >= 29) cdst = dout + O_CONVS + ((size_t)(s >> 5) * 3 + (t - 29)) * 3072; }
                    }
#pragma unroll
                    for (int bj = 0; bj < 2; ++bj) {
                        const int col = u.pn * 256 + bj * 128 + wc * 32 + 8 * fq;
                        f32x4 v0 = acc[ai][bj][m][0] * sc, v1 = acc[ai][bj][m][1] * sc;
                        if (u.pn >= 12) {
                            const f32x4 g0 = *(const f32x4*)(ng + (col & 127)), g1 = *(const f32x4*)(ng + (col & 127) + 4);
#pragma unroll
                            for (int e = 0; e < 4; ++e) { v0[e] = silu(v0[e]) * g0[e]; v1[e] = silu(v1[e]) * g1[e]; }
                        }
                        u32x4 w; w.x = pk2(v0[0], v0[1]); w.y = pk2(v0[2], v0[3]); w.z = pk2(v1[0], v1[1]); w.w = pk2(v1[2], v1[3]);
                        *(u32x4*)(O + (size_t)row * 4096 + col) = w;
                        if (hdst) *(u32x4*)(hdst + col) = w;
                        if (cdst) { *(f32x4*)(cdst + col) = v0; *(f32x4*)(cdst + col + 4) = v1; }
                    }
                } else if (wc == 0 && fq < 2) {
                    const f32x4 v0 = acc[ai][0][m][0] * sc, v1 = acc[ai][0][m][1] * sc;
                    *(f32x4*)(ba + (size_t)row * 16 + 8 * fq) = v0; *(f32x4*)(ba + (size_t)row * 16 + 8 * fq + 4) = v1;
                }
            }
    }
};

DI void p0_transpose_item(const float* W, int K, int ld, int nblk, bf16* WT, LAS float* scr, int item, int lane) {
    const int kb = item / nblk, nb = item % nblk, k0 = 64 * kb, n0 = 32 * nb;
#pragma unroll 8
    for (int i = 0; i < 32; ++i) { const int kk = 2 * i + (lane >> 5); scr[kk * 33 + (lane & 31)] = W[(size_t)(k0 + kk) * ld + n0 + (lane & 31)]; }
    asm volatile("s_waitcnt lgkmcnt(0)" ::: "memory");
    const int c = lane & 7;
#pragma unroll
    for (int j = 0; j < 4; ++j) { const int n = (lane >> 3) + 8 * j; const LAS float* s = scr + (8 * c) * 33 + n;
        u32x4 o; o.x = pk2(s[0 * 33], s[1 * 33]); o.y = pk2(s[2 * 33], s[3 * 33]); o.z = pk2(s[4 * 33], s[5 * 33]); o.w = pk2(s[6 * 33], s[7 * 33]);
        *(u32x4*)(WT + (size_t)(n0 + n) * K + k0 + 8 * c) = o; }
    asm volatile("s_waitcnt lgkmcnt(0)" ::: "memory");
}

struct Args { const float* in[17]; float* out; unsigned char* ws; };

DI void p0_prologue(const Args& a, LAS unsigned char* lds, int tid, int lane, int w) {
    LAS float* scr = (LAS float*)(lds + w * 16384);
    const int gw = blockIdx.x * 8 + w, NGW = gridDim.x * 8;
    const float* W1 = a.in[8]; const float* Wo1 = a.in[10]; const float* W2 = a.in[11]; const float* Wo2 = a.in[16];
    bf16* W1T = (bf16*)(a.ws + WS_W1T); bf16* WO1T = (bf16*)(a.ws + WS_WO1T); bf16* W2T = (bf16*)(a.ws + WS_W2T); bf16* WO2T = (bf16*)(a.ws + WS_WO2T);
    constexpr int I1 = 16 * 80, I2 = 16 * 32, I3 = 16 * 128, I4 = 16 * 32;
    for (int it = gw; it < I1 + I2 + I3 + I4; it += NGW) {
        int r = it;
        if (r < I1) { p0_transpose_item(W1, 1024, 2560, 80, W1T, scr, r, lane); continue; } r -= I1;
        if (r < I2) { p0_transpose_item(Wo1, 1024, 1024, 32, WO1T, scr, r, lane); continue; } r -= I2;
        if (r < I3) { p0_transpose_item(W2, 1024, 4112, 128, W2T, scr, r, lane); continue; } r -= I3;
        p0_transpose_item(Wo2, 1024, 1024, 32, WO2T, scr, r, lane);
    }
    const int gt = blockIdx.x * 512 + tid, NGT = gridDim.x * 512;
    for (int i = gt; i < 16 * 1024; i += NGT) { const int n = i >> 10, k = i & 1023; W2T[(size_t)(4096 + n) * 1024 + k] = f2bf(W2[(size_t)k * 4112 + 4096 + n]); }
    for (int i = gt; i < 240 * 1024 / 8; i += NGT) *(u32x4*)(W2T + (size_t)4112 * 1024 + (size_t)i * 8) = (u32x4){0u, 0u, 0u, 0u};
    float* ss1 = (float*)(a.ws + WS_SS1); float* ss2 = (float*)(a.ws + WS_SS2);
    for (int i = gt; i < MROWS; i += NGT) { ss1[i] = 0.f; ss2[i] = 0.f; }
    const float* ck = a.in[2]; const float* cv = a.in[3];
    for (int i = gt; i < 32 * 96 * 64; i += NGT) { const int sb = i / (96 * 64), rem = i % (96 * 64);
        *(f32x4*)(a.out + O_KWS + (size_t)sb * 32768 + (size_t)rem * 4) = *(const f32x4*)(ck + (size_t)sb * 32768 + 32 * 256 + (size_t)rem * 4);
        *(f32x4*)(a.out + O_VWS + (size_t)sb * 32768 + (size_t)rem * 4) = *(const f32x4*)(cv + (size_t)sb * 32768 + 32 * 256 + (size_t)rem * 4); }
    const float* g0 = a.in[6]; bf16* XN = (bf16*)(a.ws + WS_XN);
    f32x4 gv[4];
#pragma unroll
    for (int j = 0; j < 4; ++j) gv[j] = *(const f32x4*)(g0 + 4 * lane + 256 * j);
    for (int m0 = gw; m0 < MROWS; m0 += 2 * NGW) {
        f32x4 v[2][4];
#pragma unroll
        for (int r = 0; r < 2; ++r) { const int m = m0 + r * NGW, mc = m < MROWS ? m : m0;
            const float* xr = (mc < MP) ? a.in[0] + (size_t)mc * DM : a.in[1] + (size_t)(mc - MP) * DM;
#pragma unroll
            for (int j = 0; j < 4; ++j) v[r][j] = *(const f32x4*)(xr + 4 * lane + 256 * j); }
#pragma unroll
        for (int r = 0; r < 2; ++r) { const int m = m0 + r * NGW; float s = 0.f;
#pragma unroll
            for (int j = 0; j < 4; ++j) s += (v[r][j].x * v[r][j].x + v[r][j].y * v[r][j].y) + (v[r][j].z * v[r][j].z + v[r][j].w * v[r][j].w);
            const float rs = frsq(wave_sum(s) * (1.f / DM) + EPS);
            if (m < MROWS) {
#pragma unroll
                for (int j = 0; j < 4; ++j) { u32x2 o; o.x = pk2(v[r][j].x * rs * gv[j].x, v[r][j].y * rs * gv[j].y); o.y = pk2(v[r][j].z * rs * gv[j].z, v[r][j].w * rs * gv[j].w);
                    *(u32x2*)(XN + (size_t)m * DM + 4 * lane + 256 * j) = o; } } }
    }
}

DI void attn_phase(LAS unsigned char* lds, const bf16* QKVG, const float* cache_k, const float* cache_v, const float* sinks, bf16* OG, int tid, int lane, int w) {
    LAS bf16* Ks = (LAS bf16*)lds;
    LAS bf16* VT = (LAS bf16*)(lds + 192 * 72 * 2);
    for (int u = blockIdx.x; u < 2176; u += gridDim.x) {
        asm volatile("" : "+v"(lane), "+v"(tid));
        const int r = lane & 31, hh = lane >> 5;
        int kvh, jmin, jmax, qrow0, sb = 0; bool sample;
        if (u < 2048) { kvh = u & 3; const int bn = u >> 2, b = bn >> 6, n = bn & 63; qrow0 = b * 4096 + 64 * n; jmin = n < 2 ? 64 * (2 - n) : 0; jmax = 192; sample = false; }
        else { const int su = u - 2048; kvh = su & 3; sb = su >> 2; qrow0 = MP + 32 * sb; jmin = 0; jmax = 160; sample = true; }
        __syncthreads();
#pragma unroll
        for (int i = 0; i < 3; ++i) {
            const int id = tid + 512 * i, j = id >> 3, c8 = id & 7;
            u32x4 kv = (u32x4){0u, 0u, 0u, 0u}, vv = (u32x4){0u, 0u, 0u, 0u};
            if (!sample) {
                if (j >= jmin) { const size_t row = (size_t)(qrow0 - 128 + j); kv = *(const u32x4*)(QKVG + row * 2560 + 1024 + kvh * 64 + c8 * 8); vv = *(const u32x4*)(QKVG + row * 2560 + 1280 + kvh * 64 + c8 * 8); }
            } else {
                if (j < 128) { const size_t off = ((size_t)(sb * 128 + j) * 4 + kvh) * 64 + c8 * 8; kv = ld8f_bf(cache_k + off); vv = ld8f_bf(cache_v + off); }
                else if (j < 160) { const size_t row = (size_t)(qrow0 + j - 128); kv = *(const u32x4*)(QKVG + row * 2560 + 1024 + kvh * 64 + c8 * 8); vv = *(const u32x4*)(QKVG + row * 2560 + 1280 + kvh * 64 + c8 * 8); }
            }
            *(LAS u32x4*)(Ks + j * 72 + c8 * 8) = kv;
            const int pos = (j & ~31) | (((j >> 4) & 1) << 4) | (((j >> 2) & 1) << 3) | (((j >> 3) & 1) << 2) | (j & 3);
#pragma unroll
            for (int e = 0; e < 4; ++e) { VT[(c8 * 8 + 2 * e) * 200 + pos] = (bf16)(vv[e] & 0xffffu); VT[(c8 * 8 + 2 * e + 1) * 200 + pos] = (bf16)(vv[e] >> 16); }
        }
        __syncthreads();
        const int g = w >> 1, th = w & 1;
        if (!(sample && th == 1)) {
            const int head = kvh * 4 + g;
            const size_t qrow = (size_t)(qrow0 + 32 * th + r);
            bf16x8 qf[4];
#pragma unroll
            for (int s = 0; s < 4; ++s) qf[s] = *(const bf16x8*)(QKVG + qrow * 2560 + head * 64 + 16 * s + 8 * hh);
            f32x16 sc[6];
#pragma unroll
            for (int kt = 0; kt < 6; ++kt) {
#pragma unroll
                for (int i = 0; i < 16; ++i) sc[kt][i] = 0.f;
#pragma unroll
                for (int s = 0; s < 4; ++s) { const bf16x8 kf = *(const LAS bf16x8*)(Ks + (32 * kt + r) * 72 + 16 * s + 8 * hh); sc[kt] = MFMA32(kf, qf[s], sc[kt]); }
                __builtin_amdgcn_sched_barrier(0);
            }
            const float slope2 = fexp2(-0.5f * (float)(head + 1)) * LOG2E;
            const float sink2 = sinks[head] * LOG2E;
            const int t = 32 * th + r;
            float mx = sink2;
            const int tb = 128 + t - 4 * hh;
#pragma unroll
            for (int kt = 0; kt < 6; ++kt) {
                if (32 * kt >= jmin && 32 * kt + 32 <= jmax) {
#pragma unroll
                    for (int i = 0; i < 16; ++i) { const float dist = fabsf((float)(tb - (32 * kt + (i & 3) + 8 * (i >> 2))));
                        const float l = sc[kt][i] - slope2 * dist; sc[kt][i] = l; mx = fmaxf(mx, l); }
                } else {
#pragma unroll
                    for (int i = 0; i < 16; ++i) sc[kt][i] = -INFINITY;
                }
            }
            mx = fmaxf(mx, __shfl_xor(mx, 32));
            float sum = 0.f;
#pragma unroll
            for (int kt = 0; kt < 6; ++kt)
#pragma unroll
                for (int i = 0; i < 16; ++i) { const float p = fexp2(sc[kt][i] - mx); sc[kt][i] = p; sum += p; }
            sum += __shfl_xor(sum, 32);
            const float inv = 1.f / (sum + fexp2(sink2 - mx));
            f32x16 o[2];
#pragma unroll
            for (int i = 0; i < 16; ++i) { o[0][i] = 0.f; o[1][i] = 0.f; }
#pragma unroll
            for (int kt = 0; kt < 6; ++kt)
#pragma unroll
                for (int s = 0; s < 2; ++s) {
                    u32x4 pp; pp.x = pk2(sc[kt][8 * s], sc[kt][8 * s + 1]); pp.y = pk2(sc[kt][8 * s + 2], sc[kt][8 * s + 3]); pp.z = pk2(sc[kt][8 * s + 4], sc[kt][8 * s + 5]); pp.w = pk2(sc[kt][8 * s + 6], sc[kt][8 * s + 7]);
                    const bf16x8 pf = __builtin_bit_cast(bf16x8, pp);
#pragma unroll
                    for (int mt = 0; mt < 2; ++mt) { const bf16x8 vf = *(const LAS bf16x8*)(VT + (32 * mt + r) * 200 + 32 * kt + 16 * s + 8 * hh); o[mt] = MFMA32(vf, pf, o[mt]); }
                    __builtin_amdgcn_sched_barrier(0);
                }
#pragma unroll
            for (int mt = 0; mt < 2; ++mt)
#pragma unroll
                for (int i4 = 0; i4 < 4; ++i4) {
                    const int d0 = 32 * mt + 8 * i4 + 4 * hh;
                    const u32x2 gz = *(const u32x2*)(QKVG + qrow * 2560 + 1536 + head * 64 + d0);
                    const float o0 = o[mt][4 * i4] * inv * silu(bflo(gz.x)), o1 = o[mt][4 * i4 + 1] * inv * silu(bfhi(gz.x));
                    const float o2 = o[mt][4 * i4 + 2] * inv * silu(bflo(gz.y)), o3 = o[mt][4 * i4 + 3] * inv * silu(bfhi(gz.y));
                    u32x2 ov; ov.x = pk2(o0, o1); ov.y = pk2(o2, o3);
                    *(u32x2*)(OG + qrow * 1024 + head * 64 + d0) = ov;
                }
        }
    }
    __syncthreads();
}


DI u32x4 zero4() { return (u32x4){0u, 0u, 0u, 0u}; }
DI float bfe(const u32x4& v, int e) { const unsigned u = v[e >> 1]; return (e & 1) ? bfhi(u) : bflo(u); }

DI void dn_pre_phase(const Args& a, int lane, int w) {
    bf16* DNP = (bf16*)(a.ws + WS_BIG); const bf16* HALO = (const bf16*)(a.ws + WS_HALO); float* BA = (float*)(a.ws + WS_BA);
    const float* state_conv = a.in[4]; const float* conv_w = a.in[12]; const float* a_log = a.in[13]; const float* dt_bias = a.in[14];
    const int gw = blockIdx.x * 8 + w, NGW = gridDim.x * 8;
    for (int it = gw; it < 528 * 25; it += NGW) {
        asm volatile("" : "+v"(lane));
        const int ch = it / 25, sub = it % 25;
        if (sub == 24) {
            const size_t row = (size_t)64 * ch + lane; const int width = ch < 512 ? 64 : 32;
            float bv[8], gv[8];
#pragma unroll
            for (int hh = 0; hh < 8; ++hh) { bv[hh] = BA[row * 16 + hh]; gv[hh] = BA[row * 16 + 8 + hh]; }
#pragma unroll
            for (int hh = 0; hh < 8; ++hh) {
                const float beta = 1.f / (1.f + __expf(-bv[hh]));
                const float x = gv[hh] + dt_bias[hh]; const float sp = x > 20.f ? x : log1pf(expf(x));
                float gg = -expf(a_log[hh]) * sp;
#pragma unroll
                for (int d = 1; d < 64; d <<= 1) { const float t = __shfl_up(gg, d, 64); if ((lane & (width - 1)) >= d && d < width) gg += t; }
                BA[row * 16 + hh] = beta; BA[row * 16 + 8 + hh] = gg;
            }
            continue;
        }
        const int h = sub / 3, sec = sub % 3;
        const int g = lane >> 4, cl = lane & 15;
        const int col = sec * 1024 + h * 128 + 8 * cl;
        const size_t R0 = (size_t)64 * ch + 16 * g;
        u32x4 xin[19];
#pragma unroll
        for (int i = 0; i < 16; ++i) xin[3 + i] = *(const u32x4*)(DNP + (R0 + i) * 4096 + col);
        if (ch < 512) {
            if (g > 0) {
#pragma unroll
                for (int i = 0; i < 3; ++i) xin[i] = *(const u32x4*)(DNP + (R0 - 3 + i) * 4096 + col);
            } else if ((ch & 63) == 0) { xin[0] = zero4(); xin[1] = zero4(); xin[2] = zero4(); }
            else {
#pragma unroll
                for (int i = 0; i < 3; ++i) xin[i] = *(const u32x4*)(HALO + ((size_t)(ch - 1) * 3 + i) * 3072 + col);
            }
        } else {
            if (g & 1) {
#pragma unroll
                for (int i = 0; i < 3; ++i) xin[i] = *(const u32x4*)(DNP + (R0 - 3 + i) * 4096 + col);
            } else { const int sb = 2 * (ch - 512) + (g >> 1);
#pragma unroll
                for (int i = 0; i < 3; ++i) xin[i] = ld8f_bf(state_conv + ((size_t)sb * 3 + i) * 3072 + col);
            }
        }
        float wv[4][8];
#pragma unroll
        for (int j = 0; j < 4; ++j) { const f32x4 w0 = *(const f32x4*)(conv_w + (size_t)j * 3072 + col), w1 = *(const f32x4*)(conv_w + (size_t)j * 3072 + col + 4);
            wv[j][0] = w0.x; wv[j][1] = w0.y; wv[j][2] = w0.z; wv[j][3] = w0.w; wv[j][4] = w1.x; wv[j][5] = w1.y; wv[j][6] = w1.z; wv[j][7] = w1.w; }
        asm volatile("s_waitcnt vmcnt(0)" ::: "memory");
        const int clp = cl & 3, pos0 = 32 * (cl >> 2) + 16 * (clp & 1) + 4 * (clp >> 1);
        unsigned vp[4][4];
#pragma unroll
        for (int i = 0; i < 16; ++i) {
            float y[8]; float ssq = 0.f;
#pragma unroll
            for (int e = 0; e < 8; ++e) { float t = wv[0][e] * bfe(xin[i], e) + wv[1][e] * bfe(xin[i + 1], e) + wv[2][e] * bfe(xin[i + 2], e) + wv[3][e] * bfe(xin[i + 3], e);
                t = silu(t); y[e] = t; ssq += t * t; }
            if (sec < 2) {
                ssq += __shfl_xor(ssq, 1); ssq += __shfl_xor(ssq, 2); ssq += __shfl_xor(ssq, 4); ssq += __shfl_xor(ssq, 8);
                const float scl = frsq(ssq + EPS) * (sec == 0 ? 0.08838834764831845f : 1.f);
                u32x2 lo, hi; lo.x = pk2(y[0] * scl, y[1] * scl); lo.y = pk2(y[2] * scl, y[3] * scl); hi.x = pk2(y[4] * scl, y[5] * scl); hi.y = pk2(y[6] * scl, y[7] * scl);
                bf16* dst = DNP + (R0 + i) * 4096 + sec * 1024 + h * 128 + pos0;
                *(u32x2*)dst = lo; *(u32x2*)(dst + 8) = hi;
            } else {
                const u32x4 pk = pack8f(y);
                vp[i & 3][0] = pk.x; vp[i & 3][1] = pk.y; vp[i & 3][2] = pk.z; vp[i & 3][3] = pk.w;
                if ((i & 3) == 3) {
                    bf16* dst = DNP + ((size_t)64 * ch + 4 * (4 * g + (i >> 2)) + (cl >> 2)) * 4096 + 2048 + h * 128 + (cl & 3) * 32;
#pragma unroll
                    for (int j = 0; j < 4; ++j) { u32x4 o;
                        o.x = (vp[0][j] & 0xffffu) | (vp[1][j] << 16); o.y = (vp[2][j] & 0xffffu) | (vp[3][j] << 16);
                        o.z = (vp[0][j] >> 16) | (vp[1][j] & 0xffff0000u); o.w = (vp[2][j] >> 16) | (vp[3][j] & 0xffff0000u);
                        *(u32x4*)(dst + 8 * j) = o; }
                }
            }
        }
    }
}


template <int I> DI void fs_load_lo(f32x4 (&mb)[4], const LAS float* Ms) {
#pragma unroll
    for (int j4 = 0; j4 < 4; ++j4) if (4 * j4 < I) mb[j4] = *(const LAS f32x4*)(Ms + I * 64 + 4 * j4);
}
template <int I> DI void fs_load_hi(f32x4 (&mb)[12], const LAS float* Ms) {
#pragma unroll
    for (int j4 = 4; j4 < 16; ++j4) if (4 * j4 < I) mb[j4 - 4] = *(const LAS f32x4*)(Ms + I * 64 + 4 * j4);
}
template <int I> DI void fs_comp(float (&T)[64], const f32x4 (&lo)[4], const f32x4 (&hi)[12], int lane) {
    float a0 = (lane == I) ? 1.f : 0.f, a1 = 0.f, a2 = 0.f, a3 = 0.f;
#pragma unroll
    for (int j4 = 0; j4 < 4; ++j4) {
        if (4 * j4 + 0 < I) a0 -= lo[j4][0] * T[4 * j4 + 0];
        if (4 * j4 + 1 < I) a1 -= lo[j4][1] * T[4 * j4 + 1];
        if (4 * j4 + 2 < I) a2 -= lo[j4][2] * T[4 * j4 + 2];
        if (4 * j4 + 3 < I) a3 -= lo[j4][3] * T[4 * j4 + 3];
    }
#pragma unroll
    for (int j4 = 4; j4 < 16; ++j4) {
        if (4 * j4 + 0 < I) a0 -= hi[j4 - 4][0] * T[4 * j4 + 0];
        if (4 * j4 + 1 < I) a1 -= hi[j4 - 4][1] * T[4 * j4 + 1];
        if (4 * j4 + 2 < I) a2 -= hi[j4 - 4][2] * T[4 * j4 + 2];
        if (4 * j4 + 3 < I) a3 -= hi[j4 - 4][3] * T[4 * j4 + 3];
    }
    T[I] = (a0 + a1) + (a2 + a3);
}
template <int I> DI void fs_pipe(float (&T)[64], const LAS float* Ms, int lane, f32x4 (&cur)[4], f32x4 (&nxt)[4], f32x4 (&hi)[12]) {
    if constexpr (I < 64) {
        fs_load_hi<I>(hi, Ms);
        if constexpr (I + 1 < 64) fs_load_lo<I + 1>(nxt, Ms);
        fs_comp<I>(T, cur, hi, lane);
        fs_pipe<I + 1>(T, Ms, lane, nxt, cur, hi);
    }
}
template <int I> DI void tb_store(float (&T)[64], LAS bf16* TbI, int lane, float betal) {
    if constexpr (I < 64) { TbI[I * 64 + lane] = f2bf(T[I] * betal); tb_store<I + 1>(T, TbI, lane, betal); }
}
DI void dn_prep_phase(const Args& a, LAS unsigned char* lds, int lane, int w) {
    const bf16* DNP = (const bf16*)(a.ws + WS_BIG); const float* BA = (const float*)(a.ws + WS_BA);
    unsigned char* TBI = a.ws + WS_XN; unsigned char* KTG = a.ws + WS_KT; float* SCAL = (float*)(a.ws + WS_SCAL);
    LAS float* Ms = (LAS float*)(lds + w * 17408);
    LAS bf16* TbI = (LAS bf16*)Ms; LAS bf16* InI = TbI + 4096; LAS bf16* Kl = (LAS bf16*)Ms;
    const int gw = blockIdx.x * 8 + w, NGW = gridDim.x * 8;
    for (int slot = 0; slot < 3; ++slot) {
        int uid = gw + 2048 * slot; if (slot == 2) { if (w != 0 || (int)blockIdx.x >= 256) break; uid = 4096 + (int)blockIdx.x; } else if (uid >= 4096) continue;
        asm volatile("" : "+v"(lane));
        const int r = lane & 31, hh = lane >> 5;
        int h, nv; size_t R0;
        if (uid < 4096) { h = uid & 7; R0 = (size_t)64 * (uid >> 3); nv = 64; } else { const int su = uid - 4096; h = su & 7; R0 = (size_t)MP + 32 * (su >> 3); nv = 32; }
        const int lr = lane < nv ? lane : nv - 1;
        const float gcl = BA[(R0 + lr) * 16 + 8 + h];
        const float betal_ = BA[(R0 + lr) * 16 + h]; const float betal = lane < nv ? betal_ : 0.f;
        const bf16* kbase = DNP + R0 * 4096 + 1024 + h * 128; const bf16* qbase = DNP + R0 * 4096 + h * 128;
        const int row = lane & 15, quad = lane >> 4;
        {
            bf16x8 kf[2][8];
#pragma unroll
            for (int mt = 0; mt < 2; ++mt)
#pragma unroll
                for (int s = 0; s < 8; ++s) { const bool ok = 32 * mt + r < nv; const bf16x8 t = *(const bf16x8*)(kbase + (size_t)(ok ? 32 * mt + r : 0) * 4096 + 16 * s + 8 * hh); kf[mt][s] = ok ? t : (bf16x8){0, 0, 0, 0, 0, 0, 0, 0}; }
#pragma unroll
            for (int tl = 0; tl < 3; ++tl) {
                const int mt = tl > 0 ? 1 : 0, nt = tl > 1 ? 1 : 0;
                f32x16 kk;
#pragma unroll
                for (int i = 0; i < 16; ++i) kk[i] = 0.f;
#pragma unroll
                for (int s = 0; s < 8; ++s) kk = MFMA32(kf[mt][s], kf[nt][s], kk);
                const int j = 32 * nt + r; const float gcj = __shfl(gcl, j);
#pragma unroll
                for (int i = 0; i < 16; ++i) {
                    const int ii = 32 * mt + crow(i, hh);
                    const float gci = __shfl(gcl, ii), bi = __shfl(betal, ii);
                    Ms[ii * 64 + j] = (ii > j) ? kk[i] * bi * __expf(fminf(gci - gcj, 0.f)) : 0.f;
                }
            }
        }
        {
            float T[64]; f32x4 mbA[4], mbB[4], mbH[12];
            fs_pipe<0>(T, Ms, lane, mbA, mbB, mbH);
            tb_store<0>(T, TbI, lane, betal);
        }
#pragma unroll
        for (int f = 0; f < 8; ++f) {
            const int i = 16 * (f >> 1) + row, c0 = 32 * (f & 1) + 4 * quad;
            const u32x2 tlo = *(const LAS u32x2*)(TbI + i * 64 + c0), thi = *(const LAS u32x2*)(TbI + i * 64 + c0 + 16);
            *(u32x4*)(TBI + (size_t)uid * 16384 + (size_t)(f * 64 + lane) * 16) = (u32x4){tlo.x, tlo.y, thi.x, thi.y};
        }
        {
#pragma unroll
            for (int tl = 0; tl < 3; ++tl) {
                const int mt = tl > 0 ? 1 : 0, nt = tl > 1 ? 1 : 0;
                f32x16 qk;
#pragma unroll
                for (int i = 0; i < 16; ++i) qk[i] = 0.f;
#pragma unroll
                for (int s = 0; s < 8; ++s) {
                    const bool okq = 32 * mt + r < nv, okk = 32 * nt + r < nv;
                    const bf16x8 qt = *(const bf16x8*)(qbase + (size_t)(okq ? 32 * mt + r : 0) * 4096 + 16 * s + 8 * hh), kt_ = *(const bf16x8*)(kbase + (size_t)(okk ? 32 * nt + r : 0) * 4096 + 16 * s + 8 * hh);
                    const bf16x8 qf = okq ? qt : (bf16x8){0, 0, 0, 0, 0, 0, 0, 0}, kf = okk ? kt_ : (bf16x8){0, 0, 0, 0, 0, 0, 0, 0};
                    qk = MFMA32(qf, kf, qk);
                }
                const int j = 32 * nt + r; const float gcj = __shfl(gcl, j);
#pragma unroll
                for (int i = 0; i < 16; ++i) {
                    const int ii = 32 * mt + crow(i, hh);
                    const float gci = __shfl(gcl, ii);
                    InI[ii * 64 + j] = f2bf((ii >= j) ? qk[i] * __expf(fminf(gci - gcj, 0.f)) : 0.f);
                    if (tl == 0) InI[ii * 64 + 32 + r] = 0;
                }
            }
#pragma unroll
            for (int f = 0; f < 8; ++f) {
                const int i = 16 * (f >> 1) + row, c0 = 32 * (f & 1) + 4 * quad;
                const u32x2 ilo = *(const LAS u32x2*)(InI + i * 64 + c0), ihi = *(const LAS u32x2*)(InI + i * 64 + c0 + 16);
                *(u32x4*)(TBI + (size_t)uid * 16384 + 8192 + (size_t)(f * 64 + lane) * 16) = (u32x4){ilo.x, ilo.y, ihi.x, ihi.y};
            }
        }
#pragma unroll
        for (int i = 0; i < 16; ++i) { const int id = lane + 64 * i, rr = id >> 4, c16 = id & 15;
            const u32x4 vt_ = *(const u32x4*)(kbase + (size_t)(rr < nv ? rr : 0) * 4096 + 8 * c16); const u32x4 v = (rr < nv) ? vt_ : zero4();
            *(LAS u32x4*)(Kl + rr * 136 + 8 * c16) = v; }
#pragma unroll
        for (int f = 0; f < 16; ++f) {
            const int dk = 16 * (f >> 1) + row, dkp = dk & 31, pos = (dk & ~31) + 8 * ((dkp >> 2) & 3) + 4 * (dkp >> 4) + (dkp & 3);
            u32x4 o;
#pragma unroll
            for (int j2 = 0; j2 < 4; ++j2) { const int tok = 32 * (f & 1) + 16 * (j2 >> 1) + 4 * quad + 2 * (j2 & 1);
                o[j2] = (unsigned)Kl[tok * 136 + pos] | ((unsigned)Kl[(tok + 1) * 136 + pos] << 16); }
            *(u32x4*)(KTG + (size_t)uid * 16384 + (size_t)(f * 64 + lane) * 16) = o;
        }
        const float gl = __shfl(gcl, 63);
        SCAL[(size_t)uid * 256 + lane] = __expf(gcl); SCAL[(size_t)uid * 256 + 64 + lane] = __expf(gl - gcl);
        if (lane == 0) SCAL[(size_t)uid * 256 + 128] = __expf(gl);
    }
}

constexpr int SC_K = 0, SC_Q = 17408, SC_V = 34816, SC_TB = 52224, SC_IN = 60416, SC_KT = 68608, SC_SC = 84992, SC_OB = 86016, SC_OBSZ = 17408, SC_NG = 120832;
#define RAW_BARRIER() do { asm volatile("s_waitcnt lgkmcnt(0)" ::: "memory"); __builtin_amdgcn_s_barrier(); asm volatile("" ::: "memory"); } while (0)
struct QuarterOrder {
    int q, c, G;
    DI bool next(int i, pg8::Unit& u) const {
        const int L = i * G + c;
        if (L < 128) { u.pm = 16 * (L >> 4) + 4 * q + ((L >> 2) & 3); u.pn = L & 3; return true; }
        if (q == 3 && L < 144) { u.pm = 128 + ((L - 128) >> 2); u.pn = L & 3; return true; }
        return false;
    }
    DI void a_ready(const pg8::Unit&) const {}
    DI void done(const pg8::Unit&) const {}
};
struct SampleOrder {
    int c;
    DI bool next(int i, pg8::Unit& u) const { if (i > 0 || c < 0 || c >= 16) return false; u.pm = 128 + (c >> 2); u.pn = c & 3; return true; }
    DI void a_ready(const pg8::Unit&) const {}
    DI void done(const pg8::Unit&) const {}
};
DI void dn_scan_phase(const Args& a, LAS unsigned char* lds, int tid, int lane, int w, const XcdBarrier& xbar, int job_lo, int job_hi, bool midbar, int job_step) {
    const bf16* DNP = (const bf16*)(a.ws + WS_BIG); const unsigned char* TBI = a.ws + WS_XN; const unsigned char* KTG = a.ws + WS_KT; const float* SCAL = (const float*)(a.ws + WS_SCAL);
    bf16* OG = (bf16*)(a.ws + WS_OG); const float* state_ssm = a.in[5]; const float* ng = a.in[15];
    for (int job = job_lo; job < job_hi; job += job_step) {
        int h, nsteps, nv; size_t Rbase; int uid0, ustep; float* sout; const float* sin = nullptr;
        if (job < 64) { const int b = job >> 3; h = job & 7; nsteps = 64; nv = 64; Rbase = (size_t)b * 4096; uid0 = b * 512 + h; ustep = 8; sout = a.out + O_SSMP + (size_t)(b * 8 + h) * 16384; }
        else { const int s = job - 64, sb = s >> 3; h = s & 7; nsteps = 1; nv = 32; Rbase = (size_t)MP + 32 * sb; uid0 = 4096 + s; ustep = 0; sout = a.out + O_SSMS + (size_t)(sb * 8 + h) * 16384; sin = state_ssm + (size_t)(sb * 8 + h) * 16384; }
        if (w < 4) {
            f32x4 S[2][8];
            { const int col = lane & 15, quad = lane >> 4;
#pragma unroll
              for (int nt = 0; nt < 2; ++nt)
#pragma unroll
                for (int t = 0; t < 8; ++t)
#pragma unroll
                    for (int i = 0; i < 4; ++i) S[nt][t][i] = 0.f;
              if (sin) {
#pragma unroll
                for (int nt = 0; nt < 2; ++nt)
#pragma unroll
                  for (int t = 0; t < 8; ++t)
#pragma unroll
                    for (int i = 0; i < 4; ++i) S[nt][t][i] = sin[(size_t)(16 * t + 4 * quad + i) * 128 + 32 * w + 16 * nt + col];
              } }
#if defined(PROBE_IDLE) || defined(PROBE_REGION)
            unsigned long long idle_acc = 0;
#endif
#ifdef PROBE_WHOLE
            const unsigned long long tw0_ = __builtin_amdgcn_s_memrealtime();
#endif
            u32x4 ktp[4];
#define CP_KT_PREFETCH(n_) do { const unsigned char* src_ = KTG + (size_t)(uid0 + ustep * (n_)) * 16384 + (size_t)tid * 16; \
                _Pragma("unroll") for (int i_ = 0; i_ < 4; ++i_) ktp[i_] = *(const u32x4*)(src_ + 4096 * i_); } while (0)
            CP_KT_PREFETCH(0);
            for (int n = 0; n < nsteps; ++n) {
                if (midbar && n == 17) xcd_barrier(xbar);
                asm volatile("" : "+v"(lane), "+v"(tid));
                const int col = lane & 15, quad = lane >> 4;
#if defined(PROBE_IDLE) && !defined(PROBE_REGION)
                const unsigned long long t0_ = __builtin_amdgcn_s_memrealtime();
#endif
                RAW_BARRIER();
#pragma unroll
                for (int i = 0; i < 4; ++i) *(LAS u32x4*)(lds + SC_KT + (tid + 256 * i) * 16) = ktp[i];
                RAW_BARRIER();
                CP_KT_PREFETCH((n + 1 < nsteps) ? n + 1 : n);
#if defined(PROBE_IDLE) && !defined(PROBE_REGION)
                idle_acc += __builtin_amdgcn_s_memrealtime() - t0_;
#endif
#ifdef PROBE_REGION
                unsigned long long tr_ = 0;
#define RMARK(k) do { if ((k) == PROBE_REGION) { asm volatile("s_nop 0" ::: "memory"); tr_ = __builtin_amdgcn_s_memrealtime(); } if ((k) == PROBE_REGION + 1) { asm volatile("s_nop 0" ::: "memory"); idle_acc += __builtin_amdgcn_s_memrealtime() - tr_; } } while (0)
#else
#define RMARK(k) do { } while (0)
#endif
                RMARK(0);
#define BUILD_SB() do { _Pragma("unroll") for (int nt = 0; nt < 2; ++nt) _Pragma("unroll") for (int ks = 0; ks < 4; ++ks) { u32x4 p; p.x = pk2(S[nt][2 * ks][0], S[nt][2 * ks][1]); p.y = pk2(S[nt][2 * ks][2], S[nt][2 * ks][3]); \
                    p.z = pk2(S[nt][2 * ks + 1][0], S[nt][2 * ks + 1][1]); p.w = pk2(S[nt][2 * ks + 1][2], S[nt][2 * ks + 1][3]); sB[nt][ks] = __builtin_bit_cast(bf16x8, p); } } while (0)
#define SCHED_FENCE() __builtin_amdgcn_sched_barrier(0)
                f32x4 kS[2][4];
                bf16x8 ta[6];
                {
                    bf16x8 ka[4][4];
#pragma unroll
                    for (int mt = 0; mt < 4; ++mt)
#pragma unroll
                        for (int ks = 0; ks < 4; ++ks) ka[mt][ks] = *(const LAS bf16x8*)(lds + SC_K + (16 * mt + col) * 272 + 64 * ks + 16 * quad);
#pragma unroll
                    for (int f = 0; f < 6; ++f) { const int mt = f < 2 ? f : 2 + ((f - 2) >> 1), k2 = f < 2 ? 0 : ((f - 2) & 1); ta[f] = *(const LAS bf16x8*)(lds + SC_TB + ((mt * 2 + k2) * 64 + lane) * 16); }
                    bf16x8 sB[2][4];
                    BUILD_SB();
                    SCHED_FENCE();
#ifndef PROBE_KREP
#define PROBE_KREP 1
#endif
                    for (int krep = 0; krep < PROBE_KREP; ++krep) {
                    asm volatile("" ::: "memory");
#pragma unroll
                    for (int mt = 0; mt < 4; ++mt)
#pragma unroll
                        for (int nt = 0; nt < 2; ++nt) kS[nt][mt] = (f32x4){0.f, 0.f, 0.f, 0.f};
#pragma unroll
                    for (int ks = 0; ks < 4; ++ks)
#pragma unroll
                        for (int mt = 0; mt < 4; ++mt)
#pragma unroll
                            for (int nt = 0; nt < 2; ++nt) kS[nt][mt] = MFMA16(ka[mt][ks], sB[nt][ks], kS[nt][mt]);
                    SCHED_FENCE();
                    }
                }
                RMARK(1);
#define EVL(mt) (*(const LAS f32x4*)(lds + SC_SC + (16 * (mt) + 4 * quad) * 4))
#define DVL(mt) (*(const LAS f32x4*)(lds + SC_SC + (64 + 16 * (mt) + 4 * quad) * 4))
                const float gam = *(const LAS float*)(lds + SC_SC + 128 * 4);
                bf16x8 vB[2][2], vdB[2][2];
                {
                    bf16x8 rB[2][2];
#pragma unroll
                    for (int nt = 0; nt < 2; ++nt) {
                        f32x4 rr4[4];
#pragma unroll
                        for (int mt = 0; mt < 4; ++mt) { const u32x2 vv = *(const LAS u32x2*)(lds + SC_V + (4 * (4 * mt + quad) + w) * 272 + (16 * nt + col) * 8); const f32x4 ev = EVL(mt);
                            rr4[mt][0] = bflo(vv.x) - ev[0] * kS[nt][mt][0]; rr4[mt][1] = bfhi(vv.x) - ev[1] * kS[nt][mt][1];
                            rr4[mt][2] = bflo(vv.y) - ev[2] * kS[nt][mt][2]; rr4[mt][3] = bfhi(vv.y) - ev[3] * kS[nt][mt][3]; }
#pragma unroll
                        for (int k2 = 0; k2 < 2; ++k2) { u32x4 p; p.x = pk2(rr4[2 * k2][0], rr4[2 * k2][1]); p.y = pk2(rr4[2 * k2][2], rr4[2 * k2][3]); p.z = pk2(rr4[2 * k2 + 1][0], rr4[2 * k2 + 1][1]); p.w = pk2(rr4[2 * k2 + 1][2], rr4[2 * k2 + 1][3]); rB[nt][k2] = __builtin_bit_cast(bf16x8, p); }
                    }
                    f32x4 vn[2][4];
#pragma unroll
                    for (int mt = 0; mt < 4; ++mt)
#pragma unroll
                        for (int nt = 0; nt < 2; ++nt) vn[nt][mt] = (f32x4){0.f, 0.f, 0.f, 0.f};
#pragma unroll
                    for (int f = 0; f < 6; ++f) { const int mt = f < 2 ? f : 2 + ((f - 2) >> 1), k2 = f < 2 ? 0 : ((f - 2) & 1);
#pragma unroll
                        for (int nt = 0; nt < 2; ++nt) vn[nt][mt] = MFMA16(ta[f], rB[nt][k2], vn[nt][mt]); }
#pragma unroll
                    for (int nt = 0; nt < 2; ++nt)
#pragma unroll
                        for (int k2 = 0; k2 < 2; ++k2) { u32x4 p, q; const f32x4 d0 = DVL(2 * k2), d1 = DVL(2 * k2 + 1);
                            p.x = pk2(vn[nt][2 * k2][0], vn[nt][2 * k2][1]); p.y = pk2(vn[nt][2 * k2][2], vn[nt][2 * k2][3]); p.z = pk2(vn[nt][2 * k2 + 1][0], vn[nt][2 * k2 + 1][1]); p.w = pk2(vn[nt][2 * k2 + 1][2], vn[nt][2 * k2 + 1][3]);
                            q.x = pk2(vn[nt][2 * k2][0] * d0[0], vn[nt][2 * k2][1] * d0[1]); q.y = pk2(vn[nt][2 * k2][2] * d0[2], vn[nt][2 * k2][3] * d0[3]);
                            q.z = pk2(vn[nt][2 * k2 + 1][0] * d1[0], vn[nt][2 * k2 + 1][1] * d1[1]); q.w = pk2(vn[nt][2 * k2 + 1][2] * d1[2], vn[nt][2 * k2 + 1][3] * d1[3]);
                            vB[nt][k2] = __builtin_bit_cast(bf16x8, p); vdB[nt][k2] = __builtin_bit_cast(bf16x8, q); }
                }
                RMARK(2);
                LAS bf16* OB = (LAS bf16*)(lds + SC_OB + (n & 1) * SC_OBSZ);
                {
                    bf16x8 sB[2][4];
                    BUILD_SB();
#pragma unroll
                    for (int hf = 0; hf < 2; ++hf) {
                        bf16x8 qa[2][4], ia[3];
#pragma unroll
                        for (int m2 = 0; m2 < 2; ++m2)
#pragma unroll
                            for (int ks = 0; ks < 4; ++ks) qa[m2][ks] = *(const LAS bf16x8*)(lds + SC_Q + (16 * (2 * hf + m2) + col) * 272 + 64 * ks + 16 * quad);
                        if (hf == 0) { ia[0] = *(const LAS bf16x8*)(lds + SC_IN + ((0 * 2 + 0) * 64 + lane) * 16); ia[1] = *(const LAS bf16x8*)(lds + SC_IN + ((1 * 2 + 0) * 64 + lane) * 16); ia[2] = ia[1]; }
                        SCHED_FENCE();
                        f32x4 o[2][2];
#pragma unroll
                        for (int m2 = 0; m2 < 2; ++m2)
#pragma unroll
                            for (int nt = 0; nt < 2; ++nt) o[nt][m2] = (f32x4){0.f, 0.f, 0.f, 0.f};
#pragma unroll
                        for (int ks = 0; ks < 4; ++ks)
#pragma unroll
                            for (int m2 = 0; m2 < 2; ++m2)
#pragma unroll
                                for (int nt = 0; nt < 2; ++nt) o[nt][m2] = MFMA16(qa[m2][ks], sB[nt][ks], o[nt][m2]);
#pragma unroll
                        for (int m2 = 0; m2 < 2; ++m2) { const int mt = 2 * hf + m2; const f32x4 ev = EVL(mt);
#pragma unroll
                            for (int nt = 0; nt < 2; ++nt) o[nt][m2] = ev * o[nt][m2];
#pragma unroll
                            for (int k2 = 0; k2 < 2; ++k2) { if (k2 == 1 && mt < 2) continue;
                                const bf16x8 iaf = (hf == 0) ? ia[m2] : *(const LAS bf16x8*)(lds + SC_IN + ((mt * 2 + k2) * 64 + lane) * 16);
#pragma unroll
                                for (int nt = 0; nt < 2; ++nt) o[nt][m2] = MFMA16(iaf, vB[nt][k2], o[nt][m2]); }
#pragma unroll
                            for (int nt = 0; nt < 2; ++nt)
#pragma unroll
                                for (int i = 0; i < 4; ++i) OB[(16 * mt + 4 * quad + i) * 136 + 32 * w + 16 * nt + col] = f2bf(o[nt][m2][i]);
                        }
                        SCHED_FENCE();
                    }
                }
                RMARK(3);
                {
                    bf16x8 kt[8][2];
#pragma unroll
                    for (int t = 0; t < 8; ++t)
#pragma unroll
                        for (int k2 = 0; k2 < 2; ++k2) kt[t][k2] = *(const LAS bf16x8*)(lds + SC_KT + ((t * 2 + k2) * 64 + lane) * 16);
#pragma unroll
                    for (int t = 0; t < 8; ++t)
#pragma unroll
                        for (int nt = 0; nt < 2; ++nt) S[nt][t] = S[nt][t] * gam;
                    SCHED_FENCE();
#pragma unroll
                    for (int k2 = 0; k2 < 2; ++k2)
#pragma unroll
                        for (int t = 0; t < 8; ++t)
#pragma unroll
                            for (int nt = 0; nt < 2; ++nt) S[nt][t] = MFMA16(kt[t][k2], vdB[nt][k2], S[nt][t]);
                }
                RMARK(4);
            }
            RAW_BARRIER();
#if defined(PROBE_IDLE) || defined(PROBE_REGION)
#ifdef PROBE_WHOLE
            idle_acc = __builtin_amdgcn_s_memrealtime() - tw0_;
#endif
            if (blockIdx.x == 0 && job == 0) { const unsigned long long tend_ = __builtin_amdgcn_s_memrealtime() + PROBE_IDLE * idle_acc + PROBE_FIXED; while (__builtin_amdgcn_s_memrealtime() < tend_) __builtin_amdgcn_s_sleep(8); }
#endif
            { const int col = lane & 15, quad = lane >> 4;
#pragma unroll
              for (int nt = 0; nt < 2; ++nt)
#pragma unroll
                for (int t = 0; t < 8; ++t)
#pragma unroll
                    for (int i = 0; i < 4; ++i) sout[(size_t)(16 * t + 4 * quad + i) * 128 + 32 * w + 16 * nt + col] = S[nt][t][i]; }
        } else {
            const int nl = nsteps - 1;
#define CLAMPN(x) ((x) < nl ? (x) : nl)
            if (w < 6) {
                int st = tid - 256; asm volatile("" : "+v"(st));
                u32x4 pf[40]; float pfs0 = 0.f, pfs1 = 0.f; unsigned tch[6] = {0u, 0u, 0u, 0u, 0u, 0u}, tacc = 0u;
#define ST_TOUCH(n) do { const size_t R0_ = Rbase + (size_t)64 * (n); const int uid_ = uid0 + ustep * (n); \
                    _Pragma("unroll") for (int i_ = 0; i_ < 6; ++i_) { const int L_ = st + 128 * i_; const unsigned char* p_; \
                        if (L_ < 512) { const int sec_ = L_ >> 7, idx_ = L_ & 127; p_ = (const unsigned char*)(DNP + (R0_ + (idx_ >> 1)) * 4096 + sec_ * 1024 + h * 128 + (idx_ & 1) * 64); } \
                        else if (L_ < 640) p_ = TBI + (size_t)uid_ * 16384 + (size_t)(L_ - 512) * 128; \
                        else p_ = KTG + (size_t)uid_ * 16384 + (size_t)(L_ - 640) * 128; \
                        tch[i_] = *(const unsigned*)p_; } } while (0)
#define ST_PREFETCH(n) do { const size_t R0_ = Rbase + (size_t)64 * (n); const int uid_ = uid0 + ustep * (n); \
                    _Pragma("unroll") for (int i_ = 0; i_ < 8; ++i_) { const int id_ = st + 128 * i_, rr_ = id_ >> 4, c16_ = id_ & 15; const bool ok_ = rr_ < nv; \
                        const bf16* src_ = DNP + (R0_ + (ok_ ? rr_ : 0)) * 4096 + h * 128 + 8 * c16_; \
                        const u32x4 k_ = *(const u32x4*)(src_ + 1024); pf[i_] = ok_ ? k_ : zero4(); \
                        } \
                    _Pragma("unroll") for (int i_ = 0; i_ < 4; ++i_) { pf[32 + i_] = *(const u32x4*)(TBI + (size_t)uid_ * 16384 + (size_t)(st + 128 * i_) * 16); pf[36 + i_] = *(const u32x4*)(TBI + (size_t)uid_ * 16384 + 8192 + (size_t)(st + 128 * i_) * 16); } \
                    pfs0 = SCAL[(size_t)uid_ * 256 + st]; pfs1 = SCAL[(size_t)uid_ * 256 + 128 + st]; } while (0)
#define ST_WRITE() do { \
                    _Pragma("unroll") for (int i = 0; i < 8; ++i) { const int id = st + 128 * i, rr = id >> 4, c16 = id & 15; const int off = rr * 272 + c16 * 16; \
                        *(LAS u32x4*)(lds + SC_K + off) = pf[i]; } \
                    _Pragma("unroll") for (int i = 0; i < 4; ++i) { *(LAS u32x4*)(lds + SC_TB + (st + 128 * i) * 16) = pf[32 + i]; *(LAS u32x4*)(lds + SC_IN + (st + 128 * i) * 16) = pf[36 + i]; } \
                    *(LAS float*)(lds + SC_SC + st * 4) = pfs0; *(LAS float*)(lds + SC_SC + (128 + st) * 4) = pfs1; } while (0)
                ST_PREFETCH(0);
                for (int nn = 0; nn < nsteps; ++nn) {
                    if (midbar && nn == 17) xcd_barrier(xbar);
                    asm volatile("" : "+v"(st));
                    RAW_BARRIER();
                    ST_WRITE();
                    RAW_BARRIER();
                    tacc ^= (tch[0] ^ tch[1]) ^ (tch[2] ^ tch[3]) ^ (tch[4] ^ tch[5]);
                    ST_PREFETCH(CLAMPN(nn + 1));
                }
                RAW_BARRIER();
                tacc ^= (tch[0] ^ tch[1]) ^ (tch[2] ^ tch[3]) ^ (tch[4] ^ tch[5]) ^ pf[0][0] ^ pf[39][3];
                if (tacc == 0x9e3779b9u && nv == 77) ((unsigned*)a.ws)[8192 + st] = tacc;
#undef ST_TOUCH
#undef ST_PREFETCH
#undef ST_WRITE
            } else {
                int et = tid - 384; asm volatile("" : "+v"(et));
                u32x4 zr[8], qv[16];
#define EP_QV_PREFETCH(n) do { const size_t R0_ = Rbase + (size_t)64 * (n); \
                    _Pragma("unroll") for (int i_ = 0; i_ < 8; ++i_) { const int id_ = et + 128 * i_, rr_ = id_ >> 4, c16_ = id_ & 15; const bool ok_ = rr_ < nv; \
                        const bf16* src_ = DNP + (R0_ + (ok_ ? rr_ : 0)) * 4096 + h * 128 + 8 * c16_; \
                        const u32x4 q_ = *(const u32x4*)(src_), v_ = *(const u32x4*)(src_ + 2048); qv[i_] = ok_ ? q_ : zero4(); qv[8 + i_] = ok_ ? v_ : zero4(); } } while (0)
#define EP_QV_WRITE() do { \
                    _Pragma("unroll") for (int i = 0; i < 8; ++i) { const int id = et + 128 * i, rr = id >> 4, c16 = id & 15; const int off = rr * 272 + c16 * 16; \
                        *(LAS u32x4*)(lds + SC_Q + off) = qv[i]; *(LAS u32x4*)(lds + SC_V + off) = qv[8 + i]; } } while (0)
#define EP_ZLOAD(n) do { const bool okz_ = (et >> 1) < nv; const bf16* zs_ = DNP + (Rbase + (size_t)64 * (n) + (okz_ ? (et >> 1) : 0)) * 4096 + 3072 + h * 128 + 64 * (et & 1); \
                      _Pragma("unroll") for (int j_ = 0; j_ < 8; ++j_) zr[j_] = *(const u32x4*)(zs_ + 8 * j_); } while (0)
#define EP_RUN(n) do { const LAS bf16* OB_ = (const LAS bf16*)(lds + SC_OB + ((n) & 1) * SC_OBSZ) + (et >> 1) * 136 + 64 * (et & 1); \
                    u32x4 ov_[8]; float ss_ = 0.f; \
                    _Pragma("unroll") for (int j_ = 0; j_ < 8; ++j_) { ov_[j_] = *(const LAS u32x4*)(OB_ + 8 * j_); \
                        _Pragma("unroll") for (int e_ = 0; e_ < 4; ++e_) { const float x0_ = bflo(ov_[j_][e_]), x1_ = bfhi(ov_[j_][e_]); ss_ += x0_ * x0_ + x1_ * x1_; } } \
                    ss_ += __shfl_xor(ss_, 1); \
                    const float rs_ = frsq(ss_ * (1.f / 128.f) + EPS); \
                    bf16* od_ = ((et >> 1) < nv) ? OG + (Rbase + (size_t)64 * (n) + (et >> 1)) * 1024 + h * 128 + 64 * (et & 1) : (bf16*)(a.ws + 65536 + (size_t)tid * 128); \
                    _Pragma("unroll") for (int j_ = 0; j_ < 8; ++j_) { u32x4 o_; \
                        _Pragma("unroll") for (int e_ = 0; e_ < 4; ++e_) o_[e_] = pk2(bflo(ov_[j_][e_]) * rs_ * bflo(zr[j_][e_]), bfhi(ov_[j_][e_]) * rs_ * bfhi(zr[j_][e_])); \
                        *(u32x4*)(od_ + 8 * j_) = o_; } } while (0)
                EP_QV_PREFETCH(0);
                {
                    RAW_BARRIER(); EP_QV_WRITE(); RAW_BARRIER();
                    EP_QV_PREFETCH(CLAMPN(1));
                    EP_ZLOAD(0);
                }
                for (int nn = 1; nn < nsteps; ++nn) {
                    if (midbar && nn == 17) xcd_barrier(xbar);
                    asm volatile("" : "+v"(et));
                    RAW_BARRIER();
                    EP_QV_WRITE();
                    RAW_BARRIER();
                    EP_QV_PREFETCH(CLAMPN(nn + 1));
                    EP_RUN(nn - 1);
                    EP_ZLOAD(nn);
                }
                RAW_BARRIER();
                EP_RUN(nsteps - 1);
#undef EP_ZLOAD
#undef EP_QV_PREFETCH
#undef EP_QV_WRITE
#undef EP_RUN
            }
#undef CLAMPN
        }
        __syncthreads();
    }
}

DI void final_norm_phase(const Args& a, int lane, int w) {
    const bf16* XG = (const bf16*)(a.ws + WS_XN); const float* ss2 = (const float*)(a.ws + WS_SS2);
    const int gw = blockIdx.x * 8 + w, NGW = gridDim.x * 8;
    for (int m0 = gw; m0 < MROWS; m0 += 4 * NGW) {
        u32x4 v[4][2]; float rs[4];
#pragma unroll
        for (int r = 0; r < 4; ++r) { const int m = m0 + r * NGW; const int mc = m < MROWS ? m : m0;
            rs[r] = frsq(ss2[mc] * (1.f / DM) + EPS);
            v[r][0] = *(const u32x4*)(XG + (size_t)mc * DM + 8 * lane); v[r][1] = *(const u32x4*)(XG + (size_t)mc * DM + 512 + 8 * lane); }
#pragma unroll
        for (int r = 0; r < 4; ++r) { const int m = m0 + r * NGW; if (m < MROWS) { float* yr = a.out + (size_t)m * DM;
#pragma unroll
            for (int hlf = 0; hlf < 2; ++hlf) { const u32x4 x = v[r][hlf];
                *(f32x4*)(yr + 512 * hlf + 8 * lane) = (f32x4){bflo(x.x) * rs[r], bfhi(x.x) * rs[r], bflo(x.y) * rs[r], bfhi(x.y) * rs[r]};
                *(f32x4*)(yr + 512 * hlf + 8 * lane + 4) = (f32x4){bflo(x.z) * rs[r], bfhi(x.z) * rs[r], bflo(x.w) * rs[r], bfhi(x.w) * rs[r]}; } } }
    }
}

#ifndef N_PHASES
#define N_PHASES 10
#endif
__global__ void __launch_bounds__(512, 2) mega_fwd(Args a, int ph_lo, int ph_hi, int coop) {
    extern __shared__ __attribute__((aligned(16))) unsigned char lds_raw[];
    LAS unsigned char* lds = (LAS unsigned char*)lds_raw;
    const int tid = threadIdx.x, lane = tid & 63, w = __builtin_amdgcn_readfirstlane(tid >> 6);
    cg::grid_group grid = cg::this_grid();
    unsigned* barw = (unsigned*)a.ws;
    volatile LAS unsigned* bst = (volatile LAS unsigned*)(lds + LDS_BYTES - 64);
    if (tid < 16) bst[tid] = 0u;
    __syncthreads();
    XcdBarrier xbar = xcd_barrier_post(barw, bst);
    bf16* XN = (bf16*)(a.ws + WS_XN); bf16* BIG = (bf16*)(a.ws + WS_BIG); bf16* OG = (bf16*)(a.ws + WS_OG);
    float* ss1 = (float*)(a.ws + WS_SS1); float* ss2 = (float*)(a.ws + WS_SS2);
#ifndef PH_MASK
#define PH_MASK 0x3ff
#endif
#define IN(k) (((PH_MASK >> (k)) & 1) && ph_lo <= (k) && (k) < ph_hi)
#define SEAM(k) do { if (coop && IN(k) && IN((k) + 1)) { if (coop == 2) grid.sync(); else xcd_barrier(xbar); } } while (0)
#ifndef REP_MASK
#define REP_MASK 0
#endif
#define REP(k) for (int rep_ = 0; rep_ < 1 + ((REP_MASK >> (k)) & 1); ++rep_)
#ifdef PROBE_PHASE
    unsigned long long tph_ = 0;
#define PH_BEGIN(k) do { if ((k) == PROBE_PHASE) tph_ = __builtin_amdgcn_s_memrealtime(); } while (0)
#define PH_END(k) do { if ((k) == PROBE_PHASE && blockIdx.x == PROBE_WG) { __syncthreads(); const unsigned long long now_ = __builtin_amdgcn_s_memrealtime(); const unsigned long long tend_ = now_ + (now_ - tph_); while (__builtin_amdgcn_s_memrealtime() < tend_) __builtin_amdgcn_s_sleep(8); } } while (0)
#else
#define PH_BEGIN(k) do { } while (0)
#define PH_END(k) do { } while (0)
#endif
    PH_BEGIN(0);
    if (IN(0)) REP(0) { p0_prologue(a, lds, tid, lane, w); }
    PH_END(0);
    SEAM(0);
#ifdef EXTRA_SYNCS
    if (coop) for (int es_ = 0; es_ < EXTRA_SYNCS; ++es_) grid.sync();
#endif
    PH_BEGIN(1);
    if (IN(1)) REP(1) { pg8::Gemm g{XN, (const bf16*)(a.ws + WS_W1T), MROWS, 2560, 1024}; pg8::StaticOrder S; S.init(MROWS, 2560, gridDim.x, blockIdx.x);
        EpiQKVG E{BIG, a.out}; pg8::gemm_phase<EpiQKVG, pg8::StaticOrder, true, true>(lds, g, S, E); }
    PH_END(1);
    SEAM(1);
    PH_BEGIN(2);
    if (IN(2)) REP(2) { attn_phase(lds, BIG, a.in[2], a.in[3], a.in[9], OG, tid, lane, w); }
    PH_END(2);
    SEAM(2);
    PH_BEGIN(3);
    if (IN(3)) { pg8::Gemm g{OG, (const bf16*)(a.ws + WS_WO1T), MROWS, 1024, 1024}; pg8::StaticOrder S; S.init(MROWS, 1024, gridDim.x, blockIdx.x);
        EpiRes E{a.in[0], a.in[1], nullptr, XN, a.in[6] + 1024, ss1, nullptr, (bf16*)a.out};     pg8::gemm_phase<EpiRes, pg8::StaticOrder, true, true>(lds, g, S, E); }
    PH_END(3);
    SEAM(3);
    PH_BEGIN(4);
    if (IN(4)) REP(4) { pg8::Gemm g{XN, (const bf16*)(a.ws + WS_W2T), MROWS, 4352, 1024}; pg8::StaticOrder S; S.init(MROWS, 4352, gridDim.x, blockIdx.x);
        EpiDN E{BIG, (bf16*)(a.ws + WS_HALO), (float*)(a.ws + WS_BA), ss1, a.out, a.in[15]}; pg8::gemm_phase<EpiDN, pg8::StaticOrder, true, true>(lds, g, S, E); }
    PH_END(4);
    SEAM(4);
    PH_BEGIN(5);
    if (IN(5)) { dn_pre_phase(a, lane, w); }
    PH_END(5);
    SEAM(5);
    PH_BEGIN(6);
    if (IN(6)) REP(6) { dn_prep_phase(a, lds, lane, w); }
    PH_END(6);
    SEAM(6);
    PH_BEGIN(7);
    if (IN(7)) {
        if (blockIdx.x < 64) dn_scan_phase(a, lds, tid, lane, w, xbar, (int)blockIdx.x, 64, true, 256);
        else {
            dn_scan_phase(a, lds, tid, lane, w, xbar, (int)blockIdx.x, 320, false, 192);
            xcd_barrier(xbar);
            if (blockIdx.x >= 240) { pg8::Gemm g{OG, (const bf16*)(a.ws + WS_WO2T), MROWS, 1024, 1024}; SampleOrder S{(int)blockIdx.x - 240};
                EpiRes E{a.in[0], nullptr, nullptr, XN, a.in[7], ss2, (const bf16*)a.out, nullptr}; pg8::gemm_phase<EpiRes, SampleOrder, true, true>(lds, g, S, E); }
        }
    }
    PH_END(7);
    SEAM(7);
    PH_BEGIN(8);
    if (IN(8)) { pg8::Gemm g{OG, (const bf16*)(a.ws + WS_WO2T), MP, 1024, 1024}; pg8::StaticOrder S; S.init(MP, 1024, gridDim.x, blockIdx.x);
        EpiRes E{a.in[0], nullptr, nullptr, XN, a.in[7], ss2, (const bf16*)a.out, nullptr}; pg8::gemm_phase<EpiRes, pg8::StaticOrder, true, true>(lds, g, S, E); }
    PH_END(8);
    SEAM(8);
    PH_BEGIN(9);
    if (IN(9)) { final_norm_phase(a, lane, w); }
    PH_END(9);
#undef IN
#undef SEAM
}

#ifndef MULTI_LAUNCH
#define MULTI_LAUNCH 0
#endif
extern "C" void kernel_launch(void* const* d_in, const int* in_sizes, int n_in, void* d_out, int out_size, void* d_ws, size_t ws_size, hipStream_t stream) {
    static int grid = 0;
    if (grid == 0) {
        int dev = 0, cus = 0, per_cu = 0;
        if (n_in != 17 || ws_size < WS_END) { fprintf(stderr, "kernel_launch: unexpected n_in %d / ws_size %zu\n", n_in, ws_size); grid = -1; return; }
        if (hipGetDevice(&dev) != hipSuccess || hipDeviceGetAttribute(&cus, hipDeviceAttributeMultiprocessorCount, dev) != hipSuccess) { grid = -1; return; }
        if (hipFuncSetAttribute((const void*)mega_fwd, hipFuncAttributeMaxDynamicSharedMemorySize, LDS_BYTES) != hipSuccess) { fprintf(stderr, "kernel_launch: hipFuncSetAttribute failed\n"); grid = -1; return; }
        if (hipOccupancyMaxActiveBlocksPerMultiprocessor(&per_cu, (const void*)mega_fwd, 512, LDS_BYTES) != hipSuccess || per_cu < 1) { fprintf(stderr, "kernel_launch: occupancy query gave %d\n", per_cu); per_cu = 1; }
        (void)hipGetLastError();
        grid = cus * (per_cu > 1 ? 1 : per_cu);
        if (grid < 64) grid = 64;
    }
    if (grid < 0) return;
    Args a{};
    for (int i = 0; i < 17; ++i) a.in[i] = (const float*)d_in[i];
    a.out = (float*)d_out; a.ws = (unsigned char*)d_ws;
#if MULTI_LAUNCH
    for (int p = 0; p < N_PHASES; ++p) { int lo = p, hi = p + 1, coop = 0; hipLaunchKernelGGL(mega_fwd, dim3(grid), dim3(512), LDS_BYTES, stream, a, lo, hi, coop); }
#else
    if (hipMemsetAsync(d_ws, 0, 16384, stream) != hipSuccess) { fprintf(stderr, "kernel_launch: memset of the barrier words failed\n"); return; }
    int lo = 0, hi = N_PHASES, coop = 1;
    void* args[] = {&a, &lo, &hi, &coop};
    hipError_t e = hipLaunchCooperativeKernel((const void*)mega_fwd, dim3(grid), dim3(512), args, LDS_BYTES, stream);
    if (e != hipSuccess) fprintf(stderr, "kernel_launch: cooperative launch failed: %s (grid %d)\n", hipGetErrorString(e), grid);
#endif
}
```

```cpp
#include <hip/hip_runtime.h>
#include <hip/hip_cooperative_groups.h>
#include <cstdio>
#include <cstdint>
namespace cg = cooperative_groups;
namespace pg8 {
#define PG8_LAS __attribute__((address_space(3)))
typedef unsigned short bf16_t;
typedef short bf16x8 __attribute__((ext_vector_type(8)));
typedef float f32x4 __attribute__((ext_vector_type(4)));
typedef unsigned u32x4 __attribute__((ext_vector_type(4)));
constexpr int BM = 256, BK = 64, HALF = 128, HTB = HALF * BK * 2  , STAGE_BYTES = 8 * HTB, NXCD = 8, WGM = 8;

__host__ __device__ __forceinline__ int lds_byte(int r, int c) { const int st = (r >> 4) * 2 + (c >> 5), rr = r & 15, cc = c & 31, ob = rr * 64 + cc * 2; return st * 1024 + (ob ^ (((ob >> 9) & 1) << 5)); }
__host__ __device__ __forceinline__ void stage_rc(int b, int& R, int& C) { const int st = b / 1024, sb = b % 1024, swz = sb ^ (((sb >> 9) & 1) << 5); R = (st >> 1) * 16 + swz / 64; C = (st & 1) * 32 + (swz % 64) / 2; }
__host__ __device__ __forceinline__ int perm32(int rho) { const int n = rho >> 4, i = rho & 15; return 8 * (i >> 2) + 4 * n + (i & 3); }

struct Unit { int pm, pn; };
struct Gemm { const bf16_t* A; const bf16_t* Bt; int M, N, K; };

struct StaticOrder {
    int nM, nN, nwg, G, c;
    __host__ __device__ void init(int M, int N, int G_, int c_) { nM = M / BM; nN = N / BM; nwg = nM * nN; G = G_; c = c_; }
    __host__ __device__ bool next(int i, Unit& u) const {
        const long L = (long)i * G + c; if (L >= nwg) return false;
        int wgid = (int)L; { const int q = nwg / NXCD, r = nwg % NXCD, xcd = wgid % NXCD, off = wgid / NXCD; wgid = (xcd < r ? xcd * (q + 1) : r * (q + 1) + (xcd - r) * q) + off; }
        const int nig = WGM * nN, gid = wgid / nig, fm = gid * WGM, gsz = (nM - fm) < WGM ? (nM - fm) : WGM;
        u.pm = fm + ((wgid % nig) % gsz); u.pn = (wgid % nig) / gsz; return true;
    }
    __device__ __forceinline__ void a_ready(const Unit&) const {}
    __device__ __forceinline__ void done(const Unit&) const {}
};

__device__ __forceinline__ unsigned cvt_pk_bf16(float lo, float hi) { unsigned r; asm volatile("v_cvt_pk_bf16_f32 %0, %1, %2" : "=v"(r) : "v"(lo), "v"(hi)); return r; }

template <class Epi, class Sched, bool ALIGN_EPI = false, bool SP2 = false>
__device__ __forceinline__ void gemm_phase(PG8_LAS unsigned char* lds, const Gemm g, const Sched& S, const Epi& E) {
    const int tid = threadIdx.x, wid = __builtin_amdgcn_readfirstlane(tid >> 6), lane = tid & 63, wr = wid >> 2, wc = wid & 3, fr = lane & 15, fq = lane >> 4;
    const int K = g.K, nt = K / BK;
    unsigned voffA[2], voffB[2];
#pragma unroll
    for (int i = 0; i < 2; ++i) { int R, C; stage_rc(tid * 16 + i * 8192, R, C); const int Rb = Epi::PERM ? ((R & ~31) + perm32(R & 31)) : R;
        voffA[i] = (unsigned)(R * K + C) * 2u; voffB[i] = (unsigned)(Rb * K + C) * 2u; }
    const size_t kstep = (size_t)(BK * 2);
    const size_t hstep = (size_t)HALF * K * 2;
    const size_t tstep = 2 * hstep;
    const unsigned ldsw = (unsigned)wid * 1024u;
    const int aoff = lds_byte(wr * 64 + fr, fq * 8), boff = lds_byte(wc * 32 + fr, fq * 8);
#define PG8_SA(b, h) (((b) * 2 + (h)) * HTB)
#define PG8_SB(b, h) ((4 + (b) * 2 + (h)) * HTB)
#define PG8_STAGE(bufoff, gbase, voff) do { _Pragma("unroll") for (int _i = 0; _i < 2; ++_i) \
        __builtin_amdgcn_global_load_lds((const unsigned*)((const char*)(gbase) + (voff)[_i]), (PG8_LAS unsigned*)(lds + (bufoff) + ldsw + _i * 8192), 16, 0, 0); } while (0)
#define PG8_LDA(dst, b, h) do { _Pragma("unroll") for (int m = 0; m < 4; ++m) _Pragma("unroll") for (int k = 0; k < 2; ++k) dst[m][k] = *(const PG8_LAS bf16x8*)(lds + PG8_SA(b, h) + aoff + m * 2048 + k * 1024); } while (0)
#define PG8_LDB(dst, b, h) do { _Pragma("unroll") for (int n = 0; n < 2; ++n) _Pragma("unroll") for (int k = 0; k < 2; ++k) dst[n][k] = *(const PG8_LAS bf16x8*)(lds + PG8_SB(b, h) + boff + n * 2048 + k * 1024); } while (0)
#define PG8_MMA(ai, bj, At, Bt) do { __builtin_amdgcn_s_setprio(1); _Pragma("unroll") for (int m = 0; m < 4; ++m) _Pragma("unroll") for (int n = 0; n < 2; ++n) _Pragma("unroll") for (int k = 0; k < 2; ++k) \
        acc[ai][bj][m][n] = __builtin_amdgcn_mfma_f32_16x16x32_bf16(Bt[n][k], At[m][k], acc[ai][bj][m][n], 0, 0, 0); __builtin_amdgcn_s_setprio(0); } while (0)
#define PG8_WAIT_V(n) asm volatile("s_waitcnt vmcnt(" #n ")" ::: "memory")
#define PG8_WAIT_L(n) asm volatile("s_waitcnt lgkmcnt(" #n ")" ::: "memory")
#define PG8_BAR __builtin_amdgcn_s_barrier()
#define PG8_SCHED __builtin_amdgcn_sched_barrier(0)
    Unit cur, nxt; int ui = 0;
    if (!S.next(0, cur)) return;
    f32x4 acc[2][2][4][2];
#pragma unroll
    for (int a = 0; a < 2; ++a)
#pragma unroll
        for (int b = 0; b < 2; ++b)
#pragma unroll
            for (int m = 0; m < 4; ++m)
#pragma unroll
                for (int n = 0; n < 2; ++n) acc[a][b][m][n] = (f32x4){0.f, 0.f, 0.f, 0.f};
    bf16x8 At[4][2], B0[2][2], B1[2][2];
    const char* cA = (const char*)g.A + (size_t)cur.pm * tstep; const char* cB = (const char*)g.Bt + (size_t)cur.pn * tstep;
    S.a_ready(cur);
    if constexpr (SP2) {
        PG8_STAGE(PG8_SB(0, 0), cB, voffB); PG8_STAGE(PG8_SB(0, 1), cB + hstep, voffB); PG8_STAGE(PG8_SA(0, 0), cA, voffA); PG8_STAGE(PG8_SA(0, 1), cA + hstep, voffA);
        if (wr == 1) PG8_BAR;
        PG8_WAIT_V(2); PG8_BAR;
        PG8_STAGE(PG8_SB(1, 0), cB + kstep, voffB); PG8_STAGE(PG8_SA(1, 0), cA + kstep, voffA); PG8_STAGE(PG8_SB(1, 1), cB + hstep + kstep, voffB);
        PG8_WAIT_V(6); PG8_BAR;
    } else {
        PG8_STAGE(PG8_SB(0, 0), cB, voffB); PG8_STAGE(PG8_SA(0, 0), cA, voffA); PG8_STAGE(PG8_SB(0, 1), cB + hstep, voffB); PG8_STAGE(PG8_SA(0, 1), cA + hstep, voffA);
        if (wr == 1) PG8_BAR;
        PG8_WAIT_V(4); PG8_BAR;
        PG8_STAGE(PG8_SB(1, 0), cB + kstep, voffB); PG8_STAGE(PG8_SA(1, 0), cA + kstep, voffA); PG8_STAGE(PG8_SB(1, 1), cB + hstep + kstep, voffB);
        PG8_WAIT_V(6); PG8_BAR;
    }
    for (;;) {
        const bool has_next = S.next(ui + 1, nxt);
        const char* nA = has_next ? (const char*)g.A + (size_t)nxt.pm * tstep : cA; const char* nB = has_next ? (const char*)g.Bt + (size_t)nxt.pn * tstep : cB;
        for (int t = 0; t < nt; t += 2) {
            const bool last = (t == nt - 2);
            const char* a1 = cA + (size_t)(t + 1) * kstep;
            const char* a2 = last ? nA : cA + (size_t)(t + 2) * kstep; const char* b2 = last ? nB : cB + (size_t)(t + 2) * kstep;
            const char* a3 = a2 + kstep; const char* b3 = b2 + kstep;
            if (last && has_next) S.a_ready(nxt);
            if constexpr (SP2) {
            PG8_LDB(B0, 0, 0); PG8_LDB(B1, 0, 1); PG8_SCHED; PG8_LDA(At, 0, 0); PG8_STAGE(PG8_SA(1, 1), a1 + hstep, voffA);
            PG8_WAIT_V(8); PG8_WAIT_L(0); PG8_BAR; PG8_MMA(0, 0, At, B0); PG8_MMA(0, 1, At, B1); PG8_BAR; PG8_SCHED;
            PG8_LDA(At, 0, 1); PG8_STAGE(PG8_SB(0, 0), b2, voffB); PG8_STAGE(PG8_SB(0, 1), b2 + hstep, voffB); PG8_STAGE(PG8_SA(0, 0), a2, voffA);
            PG8_WAIT_V(8); PG8_WAIT_L(0); PG8_BAR; PG8_MMA(1, 0, At, B0); PG8_MMA(1, 1, At, B1); PG8_BAR; PG8_SCHED;
            PG8_LDB(B0, 1, 0); PG8_LDB(B1, 1, 1); PG8_SCHED; PG8_LDA(At, 1, 0); PG8_STAGE(PG8_SA(0, 1), a2 + hstep, voffA);
            PG8_WAIT_V(8); PG8_WAIT_L(0); PG8_BAR; PG8_MMA(0, 0, At, B0); PG8_MMA(0, 1, At, B1); PG8_BAR; PG8_SCHED;
            PG8_LDA(At, 1, 1); PG8_STAGE(PG8_SB(1, 0), b3, voffB); PG8_STAGE(PG8_SB(1, 1), b3 + hstep, voffB); PG8_STAGE(PG8_SA(1, 0), a3, voffA);
            PG8_WAIT_V(8); PG8_WAIT_L(0); PG8_BAR; PG8_MMA(1, 0, At, B0); PG8_MMA(1, 1, At, B1); PG8_BAR; PG8_SCHED;
            } else {
            PG8_LDB(B0, 0, 0); PG8_SCHED; PG8_LDA(At, 0, 0); PG8_STAGE(PG8_SA(1, 1), a1 + hstep, voffA);
            PG8_WAIT_L(8); PG8_BAR; PG8_WAIT_L(0); PG8_MMA(0, 0, At, B0); PG8_BAR; PG8_SCHED;
            PG8_LDB(B1, 0, 1); PG8_STAGE(PG8_SB(0, 0), b2, voffB);
            PG8_BAR; PG8_WAIT_L(0); PG8_MMA(0, 1, At, B1); PG8_BAR;
            PG8_LDA(At, 0, 1); PG8_STAGE(PG8_SA(0, 0), a2, voffA);
            PG8_BAR; PG8_WAIT_L(0); PG8_MMA(1, 0, At, B0); PG8_BAR; PG8_SCHED;
            PG8_STAGE(PG8_SB(0, 1), b2 + hstep, voffB);
            PG8_WAIT_V(6); PG8_BAR; PG8_MMA(1, 1, At, B1); PG8_BAR;
            PG8_LDB(B0, 1, 0); PG8_SCHED; PG8_LDA(At, 1, 0); PG8_STAGE(PG8_SA(0, 1), a2 + hstep, voffA);
            PG8_WAIT_L(8); PG8_BAR; PG8_WAIT_L(0); PG8_MMA(0, 0, At, B0); PG8_BAR; PG8_SCHED;
            PG8_LDB(B1, 1, 1); PG8_STAGE(PG8_SB(1, 0), b3, voffB);
            PG8_BAR; PG8_WAIT_L(0); PG8_MMA(0, 1, At, B1); PG8_BAR;
            PG8_LDA(At, 1, 1); PG8_STAGE(PG8_SA(1, 0), a3, voffA);
            PG8_BAR; PG8_WAIT_L(0); PG8_MMA(1, 0, At, B0); PG8_BAR; PG8_SCHED;
            PG8_STAGE(PG8_SB(1, 1), b3 + hstep, voffB);
            PG8_WAIT_V(6); PG8_BAR; PG8_MMA(1, 1, At, B1); PG8_BAR;
            }
        }
        if constexpr (ALIGN_EPI) { if (wr == 0) PG8_BAR; }
        if constexpr (!Epi::AFTER_DRAIN) { E(acc, cur, wr, wc, fr, fq); S.done(cur); }
        if (!has_next) break;
#pragma unroll
        for (int a = 0; a < 2; ++a)
#pragma unroll
            for (int b = 0; b < 2; ++b)
#pragma unroll
                for (int m = 0; m < 4; ++m)
#pragma unroll
                    for (int n = 0; n < 2; ++n) acc[a][b][m][n] = (f32x4){0.f, 0.f, 0.f, 0.f};
        cur = nxt; cA = nA; cB = nB; ++ui;
        if constexpr (ALIGN_EPI) { if (wr == 1) PG8_BAR; }
    }
    PG8_WAIT_V(0);
    if constexpr (!ALIGN_EPI) { if (wr == 0) PG8_BAR; }
    PG8_BAR;
    if constexpr (Epi::AFTER_DRAIN) { E.fused(acc, cur, wr, wc, fr, fq, lds, wid, lane); S.done(cur); }
#undef PG8_SA
#undef PG8_SB
#undef PG8_STAGE
#undef PG8_LDA
#undef PG8_LDB
#undef PG8_MMA
#undef PG8_WAIT_V
#undef PG8_WAIT_L
#undef PG8_BAR
#undef PG8_SCHED
}
}


#define LAS __attribute__((address_space(3)))
typedef unsigned short bf16;
typedef short bf16x8 __attribute__((ext_vector_type(8)));
typedef float f32x4 __attribute__((ext_vector_type(4)));
typedef float f32x16 __attribute__((ext_vector_type(16)));
typedef unsigned u32x4 __attribute__((ext_vector_type(4)));
typedef unsigned u32x2 __attribute__((ext_vector_type(2)));
typedef __bf16 bf16x2_t __attribute__((ext_vector_type(2)));
typedef float f32x2_t __attribute__((ext_vector_type(2)));
#define MFMA32(a, b, c) __builtin_amdgcn_mfma_f32_32x32x16_bf16((a), (b), (c), 0, 0, 0)
#define MFMA16(a, b, c) __builtin_amdgcn_mfma_f32_16x16x32_bf16((a), (b), (c), 0, 0, 0)
#define DI __device__ __forceinline__
#define LDS_BARRIER() do { asm volatile("s_waitcnt lgkmcnt(0)" ::: "memory"); __builtin_amdgcn_s_barrier(); asm volatile("" ::: "memory"); } while (0)

constexpr int DM = 1024, MROWS = 33792, MP = 32768;
constexpr float EPS = 1e-6f;
constexpr float LOG2E = 1.4426950408889634f;
constexpr float QSCALE = 0.125f * LOG2E;
constexpr size_t O_KWP = 34603008, O_VWP = 34865152, O_CONVP = 35127296, O_SSMP = 35201024, O_KWS = 36249600, O_VWS = 37298176, O_CONVS = 38346752, O_SSMS = 38641664;
constexpr size_t MiB = 1u << 20;
constexpr size_t WS_W1T = 1 * MiB, WS_WO1T = 6 * MiB, WS_W2T = 8 * MiB, WS_WO2T = 17 * MiB, WS_BA = 19 * MiB, WS_SS1 = 22 * MiB, WS_SS2 = 22 * MiB + 512 * 1024,
                 WS_HALO = 23 * MiB, WS_SCAL = 33 * MiB, WS_XN = 40 * MiB  , WS_BIG = 110 * MiB  , WS_OG = 374 * MiB, WS_KT = 440 * MiB, WS_END = 508 * MiB;
constexpr int LDS_BYTES = 143360;

DI unsigned pk2(float lo, float hi) { f32x2_t v = {lo, hi}; bf16x2_t b = __builtin_convertvector(v, bf16x2_t); return __builtin_bit_cast(unsigned, b); }
DI float bflo(unsigned u) { return __builtin_bit_cast(float, u << 16); }
DI float bfhi(unsigned u) { return __builtin_bit_cast(float, u & 0xffff0000u); }
DI float bf2f(bf16 u) { return __builtin_bit_cast(float, (unsigned)u << 16); }
DI bf16 f2bf(float f) { return (bf16)(pk2(f, 0.f) & 0xffffu); }
DI int crow(int i, int h) { return (i & 3) + 8 * (i >> 2) + 4 * h; }
DI float fexp2(float x) { return __builtin_amdgcn_exp2f(x); }
DI float silu(float x) { return x * __builtin_amdgcn_rcpf(1.f + __builtin_amdgcn_exp2f(-1.4426950408889634f * x)); }
DI float frsq(float x) { return __builtin_amdgcn_rsqf(x); }
DI float wave_sum(float v) {
#pragma unroll
    for (int o = 1; o < 64; o <<= 1) v += __shfl_xor(v, o);
    return v;
}
DI u32x4 pack8f(const float* p) { u32x4 r; r.x = pk2(p[0], p[1]); r.y = pk2(p[2], p[3]); r.z = pk2(p[4], p[5]); r.w = pk2(p[6], p[7]); return r; }
DI u32x4 ld8f_bf(const float* p) { const f32x4 a = *(const f32x4*)p, b = *(const f32x4*)(p + 4); u32x4 r; r.x = pk2(a.x, a.y); r.y = pk2(a.z, a.w); r.z = pk2(b.x, b.y); r.w = pk2(b.z, b.w); return r; }

#define XB_TMO      128
#define XB_XCNT(j)  (256  + 64 * (j))
#define XB_XSUB(j)  (1280 + 64 * (j))
#define XB_XGEN(j)  (2304 + 64 * (j))
#define XB_TOP      3328
#define XB_TOPGEN   3392
#define XCD_BAR_WORDS 3456
#define XB_SPIN_CAP (1u << 18)

__device__ __forceinline__ unsigned xb_ld(unsigned* p)              { return __hip_atomic_load(p, __ATOMIC_RELAXED, __HIP_MEMORY_SCOPE_AGENT); }
__device__ __forceinline__ unsigned xb_add(unsigned* p, unsigned v) { return __hip_atomic_fetch_add(p, v, __ATOMIC_RELAXED, __HIP_MEMORY_SCOPE_AGENT); }
__device__ __forceinline__ unsigned xb_xcc_id() { return (unsigned)__builtin_amdgcn_s_getreg((3 << 11) | 20) & 0xFu; }
#define XB_SPIN(cond, bar) do { unsigned _sp = 0; while (cond) { __builtin_amdgcn_s_sleep(1); \
    if ((++_sp & 255u) == 0u) { if (xb_ld(&(bar)[XB_TMO])) break; if (_sp > XB_SPIN_CAP) { atomicAdd(&(bar)[XB_TMO], 1u); break; } } } } while (0)

struct XcdBarrier {
    unsigned* bar; unsigned x;
    volatile LAS unsigned* st;
};

__device__ __forceinline__ XcdBarrier xcd_barrier_post(unsigned* bar, volatile LAS unsigned* st) {
    XcdBarrier b; b.bar = bar; b.x = xb_xcc_id(); b.st = st;
    if (threadIdx.x == 0) (void)xb_add(&bar[XB_XCNT(b.x)], 1u);
    return b;
}
__device__ __forceinline__ void xcd_barrier_complete(unsigned* bar, unsigned x, unsigned& nloc, unsigned& nx) {
    const unsigned G = gridDim.x * gridDim.y * gridDim.z;
    unsigned sum, cnt, mine, sp = 0u;
    for (;;) {
        sum = 0u; cnt = 0u; mine = 0u;
#pragma unroll
        for (unsigned j = 0; j < 16; ++j) { const unsigned c = xb_ld(&bar[XB_XCNT(j)]); sum += c; cnt += (c > 0u) ? 1u : 0u; mine = (j == x) ? c : mine; }
        if (sum == G) break;
        __builtin_amdgcn_s_sleep(1);
        if ((++sp & 255u) == 0u) { if (xb_ld(&bar[XB_TMO])) break; if (sp > XB_SPIN_CAP) { atomicAdd(&bar[XB_TMO], 1u); break; } }
    }
    nloc = mine > 0u ? mine : 1u; nx = cnt > 0u ? cnt : 1u;
}

__device__ __forceinline__ void xcd_barrier(const XcdBarrier& b) {
    asm volatile("s_waitcnt vmcnt(0)" ::: "memory");
    __syncthreads();
    if (threadIdx.x == 0) {
        unsigned* bar = b.bar;
        __builtin_amdgcn_s_waitcnt(0);
        unsigned nloc = b.st[0], nx = b.st[1];
        if (nloc == 0u) { xcd_barrier_complete(bar, b.x, nloc, nx); b.st[0] = nloc; b.st[1] = nx; }
        const unsigned old = xb_add(&bar[XB_XSUB(b.x)], 1u);
        const unsigned gen = old / nloc;
        if (old + 1u == (gen + 1u) * nloc) {
            __builtin_amdgcn_fence(__ATOMIC_RELEASE, "agent");
            asm volatile("s_waitcnt vmcnt(0)" ::: "memory");
            const unsigned og = xb_add(&bar[XB_TOP], 1u);
            const unsigned tg = og / nx;
            if (og + 1u == (tg + 1u) * nx) xb_add(&bar[XB_TOPGEN], 1u);
            else XB_SPIN(xb_ld(&bar[XB_TOPGEN]) == tg, bar);
            __builtin_amdgcn_fence(__ATOMIC_ACQUIRE, "agent");
            xb_add(&bar[XB_XGEN(b.x)], 1u);
            asm volatile("s_waitcnt vmcnt(0)" ::: "memory");
        } else {
            XB_SPIN(xb_ld(&bar[XB_XGEN(b.x)]) == gen, bar);
            __builtin_amdgcn_fence(__ATOMIC_ACQUIRE, "agent");
            asm volatile("s_waitcnt vmcnt(0)" ::: "memory");
        }
    }
    __syncthreads();
#undef ATT_LOAD
#undef ATT_DECODE
}

struct EpiQKVG {
    static constexpr bool PERM = true, AFTER_DRAIN = false;
    bf16* O; float* dout;
    DI void operator()(const pg8::f32x4 (&acc)[2][2][4][2], const pg8::Unit& u, int wr, int wc, int fr, int fq) const {
        const float sc = (u.pn < 4) ? QSCALE : 1.f;
        const bool kv = (u.pn == 4 || u.pn == 5);
#pragma unroll
        for (int ai = 0; ai < 2; ++ai)
#pragma unroll
            for (int m = 0; m < 4; ++m) {
                const int row = u.pm * 256 + ai * 128 + wr * 64 + m * 16 + fr;
                float* wdst = nullptr;
                if (kv) {
                    if (row < MP) { const int t = row & 4095; if (t >= 3968) wdst = dout + (u.pn == 4 ? O_KWP : O_VWP) + ((size_t)((row >> 12) * 128 + (t - 3968))) * 256; }
                    else { const int s = row - MP; wdst = dout + (u.pn == 4 ? O_KWS : O_VWS) + ((size_t)((s >> 5) * 128 + 96 + (s & 31))) * 256; }
                }
#pragma unroll
                for (int bj = 0; bj < 2; ++bj) {
                    const int cin = bj * 128 + wc * 32 + 8 * fq;
                    const f32x4 v0 = acc[ai][bj][m][0] * sc, v1 = acc[ai][bj][m][1] * sc;
                    u32x4 w; w.x = pk2(v0[0], v0[1]); w.y = pk2(v0[2], v0[3]); w.z = pk2(v1[0], v1[1]); w.w = pk2(v1[2], v1[3]);
                    *(u32x4*)(O + (size_t)row * 2560 + u.pn * 256 + cin) = w;
                    if (wdst) { *(f32x4*)(wdst + cin) = v0; *(f32x4*)(wdst + cin + 4) = v1; }
                }
            }
    }
};

struct EpiRes {
    static constexpr bool PERM = true, AFTER_DRAIN = false;
    const float* xp; const float* xs; float* y; bf16* XN; const float* g; float* ss; const bf16* xb; bf16* yb;
    DI void operator()(const pg8::f32x4 (&acc)[2][2][4][2], const pg8::Unit& u, int wr, int wc, int fr, int fq) const {
#pragma unroll
        for (int ai = 0; ai < 2; ++ai)
#pragma unroll
            for (int m = 0; m < 4; ++m) {
                const int row = u.pm * 256 + ai * 128 + wr * 64 + m * 16 + fr;
                const float* xr = (row < MP || xs == nullptr) ? xp + (size_t)row * DM : xs + (size_t)(row - MP) * DM;
                float s = 0.f;
#pragma unroll
                for (int bj = 0; bj < 2; ++bj) {
                    const int col = u.pn * 256 + bj * 128 + wc * 32 + 8 * fq;
                    f32x4 a0, a1;
                    if (xb) { const u32x4 xv = *(const u32x4*)(xb + (size_t)row * DM + col); a0 = (f32x4){bflo(xv.x), bfhi(xv.x), bflo(xv.y), bfhi(xv.y)}; a1 = (f32x4){bflo(xv.z), bfhi(xv.z), bflo(xv.w), bfhi(xv.w)}; }
                    else { a0 = *(const f32x4*)(xr + col); a1 = *(const f32x4*)(xr + col + 4); }
                    const f32x4 v0 = acc[ai][bj][m][0] + a0, v1 = acc[ai][bj][m][1] + a1;
                    if (y) { *(f32x4*)(y + (size_t)row * DM + col) = v0; *(f32x4*)(y + (size_t)row * DM + col + 4) = v1; }
                    if (yb) { u32x4 w; w.x = pk2(v0[0], v0[1]); w.y = pk2(v0[2], v0[3]); w.z = pk2(v1[0], v1[1]); w.w = pk2(v1[2], v1[3]); *(u32x4*)(yb + (size_t)row * DM + col) = w; }
                    s += (v0[0] * v0[0] + v0[1] * v0[1]) + (v0[2] * v0[2] + v0[3] * v0[3]) + (v1[0] * v1[0] + v1[1] * v1[1]) + (v1[2] * v1[2] + v1[3] * v1[3]);
                    if (XN) {
                        const f32x4 g0 = *(const f32x4*)(g + col), g1 = *(const f32x4*)(g + col + 4);
                        u32x4 w; w.x = pk2(v0[0] * g0[0], v0[1] * g0[1]); w.y = pk2(v0[2] * g0[2], v0[3] * g0[3]); w.z = pk2(v1[0] * g1[0], v1[1] * g1[1]); w.w = pk2(v1[2] * g1[2], v1[3] * g1[3]);
                        *(u32x4*)(XN + (size_t)row * DM + col) = w;
                    }
                }
                s += __shfl_xor(s, 16); s += __shfl_xor(s, 32);
                if (fq == 0) atomicAdd(ss + row, s);
            }
    }
};

struct EpiDN {
    static constexpr bool PERM = true, AFTER_DRAIN = false;
    bf16* O; bf16* halo; float* ba; const float* ss; float* dout; const float* ng;
    DI void operator()(const pg8::f32x4 (&acc)[2][2][4][2], const pg8::Unit& u, int wr, int wc, int fr, int fq) const {
#pragma unroll
        for (int ai = 0; ai < 2; ++ai)
#pragma unroll
            for (int m = 0; m < 4; ++m) {
                const int row = u.pm * 256 + ai * 128 + wr * 64 + m * 16 + fr;
                const float sc = rsqrtf(ss[row] * (1.f / DM) + EPS);
                if (u.pn < 16) {
                    bf16* hdst = nullptr; float* cdst = nullptr;
                    if (u.pn < 12) {
                        if (row < MP) { const int t = row & 63; if (t >= 61) hdst = halo + ((size_t)(row >> 6) * 3 + (t - 61)) * 3072;
                                        const int t4 = row & 4095; if (t4 >= 4093) cdst = dout + O_CONVP + ((size_t)(row >> 12) * 3 + (t4 - 4093)) * 3072; }
                        else { const int s = row - MP, t = s & 31; if (t >= 29) cdst = dout + O_CONVS + ((size_t)(s >> 5) * 3 + (t - 29)) * 3072; }
                    }
#pragma unroll
                    for (int bj = 0; bj < 2; ++bj) {
                        const int col = u.pn * 256 + bj * 128 + wc * 32 + 8 * fq;
                        f32x4 v0 = acc[ai][bj][m][0] * sc, v1 = acc[ai][bj][m][1] * sc;
                        if (u.pn >= 12) {
                            const f32x4 g0 = *(const f32x4*)(ng + (col & 127)), g1 = *(const f32x4*)(ng + (col & 127) + 4);
#pragma unroll
                            for (int e = 0; e < 4; ++e) { v0[e] = silu(v0[e]) * g0[e]; v1[e] = silu(v1[e]) * g1[e]; }
                        }
                        u32x4 w; w.x = pk2(v0[0], v0[1]); w.y = pk2(v0[2], v0[3]); w.z = pk2(v1[0], v1[1]); w.w = pk2(v1[2], v1[3]);
                        *(u32x4*)(O + (size_t)row * 4096 + col) = w;
                        if (hdst) *(u32x4*)(hdst + col) = w;
                        if (cdst) { *(f32x4*)(cdst + col) = v0; *(f32x4*)(cdst + col + 4) = v1; }
                    }
                } else if (wc == 0 && fq < 2) {
                    const f32x4 v0 = acc[ai][0][m][0] * sc, v1 = acc[ai][0][m][1] * sc;
                    *(f32x4*)(ba + (size_t)row * 16 + 8 * fq) = v0; *(f32x4*)(ba + (size_t)row * 16 + 8 * fq + 4) = v1;
                }
            }
    }
};

DI void p0_transpose_item(const float* W, int K, int ld, int nblk, bf16* WT, LAS float* scr, int item, int lane) {
    const int kb = item / nblk, nb = item % nblk, k0 = 64 * kb, n0 = 32 * nb;
#pragma unroll 8
    for (int i = 0; i < 32; ++i) { const int kk = 2 * i + (lane >> 5); scr[kk * 33 + (lane & 31)] = W[(size_t)(k0 + kk) * ld + n0 + (lane & 31)]; }
    asm volatile("s_waitcnt lgkmcnt(0)" ::: "memory");
    const int c = lane & 7;
#pragma unroll
    for (int j = 0; j < 4; ++j) { const int n = (lane >> 3) + 8 * j; const LAS float* s = scr + (8 * c) * 33 + n;
        u32x4 o; o.x = pk2(s[0 * 33], s[1 * 33]); o.y = pk2(s[2 * 33], s[3 * 33]); o.z = pk2(s[4 * 33], s[5 * 33]); o.w = pk2(s[6 * 33], s[7 * 33]);
        *(u32x4*)(WT + (size_t)(n0 + n) * K + k0 + 8 * c) = o; }
    asm volatile("s_waitcnt lgkmcnt(0)" ::: "memory");
}

struct Args { const float* in[17]; float* out; unsigned char* ws; };

DI void p0_prologue(const Args& a, LAS unsigned char* lds, int tid, int lane, int w) {
    LAS float* scr = (LAS float*)(lds + w * 16384);
    const int gw = blockIdx.x * 8 + w, NGW = gridDim.x * 8;
    const float* W1 = a.in[8]; const float* Wo1 = a.in[10]; const float* W2 = a.in[11]; const float* Wo2 = a.in[16];
    bf16* W1T = (bf16*)(a.ws + WS_W1T); bf16* WO1T = (bf16*)(a.ws + WS_WO1T); bf16* W2T = (bf16*)(a.ws + WS_W2T); bf16* WO2T = (bf16*)(a.ws + WS_WO2T);
    constexpr int I1 = 16 * 80, I2 = 16 * 32, I3 = 16 * 128, I4 = 16 * 32;
    for (int it = gw; it < I1 + I2 + I3 + I4; it += NGW) {
        int r = it;
        if (r < I1) { p0_transpose_item(W1, 1024, 2560, 80, W1T, scr, r, lane); continue; } r -= I1;
        if (r < I2) { p0_transpose_item(Wo1, 1024, 1024, 32, WO1T, scr, r, lane); continue; } r -= I2;
        if (r < I3) { p0_transpose_item(W2, 1024, 4112, 128, W2T, scr, r, lane); continue; } r -= I3;
        p0_transpose_item(Wo2, 1024, 1024, 32, WO2T, scr, r, lane);
    }
    const int gt = blockIdx.x * 512 + tid, NGT = gridDim.x * 512;
    for (int i = gt; i < 16 * 1024; i += NGT) { const int n = i >> 10, k = i & 1023; W2T[(size_t)(4096 + n) * 1024 + k] = f2bf(W2[(size_t)k * 4112 + 4096 + n]); }
    for (int i = gt; i < 240 * 1024 / 8; i += NGT) *(u32x4*)(W2T + (size_t)4112 * 1024 + (size_t)i * 8) = (u32x4){0u, 0u, 0u, 0u};
    float* ss1 = (float*)(a.ws + WS_SS1); float* ss2 = (float*)(a.ws + WS_SS2);
    for (int i = gt; i < MROWS; i += NGT) { ss1[i] = 0.f; ss2[i] = 0.f; }
    const float* ck = a.in[2]; const float* cv = a.in[3];
    for (int i = gt; i < 32 * 96 * 64; i += NGT) { const int sb = i / (96 * 64), rem = i % (96 * 64);
        *(f32x4*)(a.out + O_KWS + (size_t)sb * 32768 + (size_t)rem * 4) = *(const f32x4*)(ck + (size_t)sb * 32768 + 32 * 256 + (size_t)rem * 4);
        *(f32x4*)(a.out + O_VWS + (size_t)sb * 32768 + (size_t)rem * 4) = *(const f32x4*)(cv + (size_t)sb * 32768 + 32 * 256 + (size_t)rem * 4); }
    const float* g0 = a.in[6]; bf16* XN = (bf16*)(a.ws + WS_XN);
    f32x4 gv[4];
#pragma unroll
    for (int j = 0; j < 4; ++j) gv[j] = *(const f32x4*)(g0 + 4 * lane + 256 * j);
    for (int m0 = gw; m0 < MROWS; m0 += 2 * NGW) {
        f32x4 v[2][4];
#pragma unroll
        for (int r = 0; r < 2; ++r) { const int m = m0 + r * NGW, mc = m < MROWS ? m : m0;
            const float* xr = (mc < MP) ? a.in[0] + (size_t)mc * DM : a.in[1] + (size_t)(mc - MP) * DM;
#pragma unroll
            for (int j = 0; j < 4; ++j) v[r][j] = *(const f32x4*)(xr + 4 * lane + 256 * j); }
#pragma unroll
        for (int r = 0; r < 2; ++r) { const int m = m0 + r * NGW; float s = 0.f;
#pragma unroll
            for (int j = 0; j < 4; ++j) s += (v[r][j].x * v[r][j].x + v[r][j].y * v[r][j].y) + (v[r][j].z * v[r][j].z + v[r][j].w * v[r][j].w);
            const float rs = frsq(wave_sum(s) * (1.f / DM) + EPS);
            if (m < MROWS) {
#pragma unroll
                for (int j = 0; j < 4; ++j) { u32x2 o; o.x = pk2(v[r][j].x * rs * gv[j].x, v[r][j].y * rs * gv[j].y); o.y = pk2(v[r][j].z * rs * gv[j].z, v[r][j].w * rs * gv[j].w);
                    *(u32x2*)(XN + (size_t)m * DM + 4 * lane + 256 * j) = o; } } }
    }
}

DI void attn_phase(LAS unsigned char* lds, const bf16* QKVG, const float* cache_k, const float* cache_v, const float* sinks, bf16* OG, int tid, int lane, int w) {
    LAS bf16* Ks = (LAS bf16*)lds;
    LAS bf16* VT = (LAS bf16*)(lds + 192 * 72 * 2);
    for (int u = blockIdx.x; u < 2176; u += gridDim.x) {
        asm volatile("" : "+v"(lane), "+v"(tid));
        const int r = lane & 31, hh = lane >> 5;
        int kvh, jmin, jmax, qrow0, sb = 0; bool sample;
        if (u < 2048) { kvh = u & 3; const int bn = u >> 2, b = bn >> 6, n = bn & 63; qrow0 = b * 4096 + 64 * n; jmin = n < 2 ? 64 * (2 - n) : 0; jmax = 192; sample = false; }
        else { const int su = u - 2048; kvh = su & 3; sb = su >> 2; qrow0 = MP + 32 * sb; jmin = 0; jmax = 160; sample = true; }
        __syncthreads();
#pragma unroll
        for (int i = 0; i < 3; ++i) {
            const int id = tid + 512 * i, j = id >> 3, c8 = id & 7;
            u32x4 kv = (u32x4){0u, 0u, 0u, 0u}, vv = (u32x4){0u, 0u, 0u, 0u};
            if (!sample) {
                if (j >= jmin) { const size_t row = (size_t)(qrow0 - 128 + j); kv = *(const u32x4*)(QKVG + row * 2560 + 1024 + kvh * 64 + c8 * 8); vv = *(const u32x4*)(QKVG + row * 2560 + 1280 + kvh * 64 + c8 * 8); }
            } else {
                if (j < 128) { const size_t off = ((size_t)(sb * 128 + j) * 4 + kvh) * 64 + c8 * 8; kv = ld8f_bf(cache_k + off); vv = ld8f_bf(cache_v + off); }
                else if (j < 160) { const size_t row = (size_t)(qrow0 + j - 128); kv = *(const u32x4*)(QKVG + row * 2560 + 1024 + kvh * 64 + c8 * 8); vv = *(const u32x4*)(QKVG + row * 2560 + 1280 + kvh * 64 + c8 * 8); }
            }
            *(LAS u32x4*)(Ks + j * 72 + c8 * 8) = kv;
            const int pos = (j & ~31) | (((j >> 4) & 1) << 4) | (((j >> 2) & 1) << 3) | (((j >> 3) & 1) << 2) | (j & 3);
#pragma unroll
            for (int e = 0; e < 4; ++e) { VT[(c8 * 8 + 2 * e) * 200 + pos] = (bf16)(vv[e] & 0xffffu); VT[(c8 * 8 + 2 * e + 1) * 200 + pos] = (bf16)(vv[e] >> 16); }
        }
        __syncthreads();
        const int g = w >> 1, th = w & 1;
        if (!(sample && th == 1)) {
            const int head = kvh * 4 + g;
            const size_t qrow = (size_t)(qrow0 + 32 * th + r);
            bf16x8 qf[4];
#pragma unroll
            for (int s = 0; s < 4; ++s) qf[s] = *(const bf16x8*)(QKVG + qrow * 2560 + head * 64 + 16 * s + 8 * hh);
            f32x16 sc[6];
#pragma unroll
            for (int kt = 0; kt < 6; ++kt) {
#pragma unroll
                for (int i = 0; i < 16; ++i) sc[kt][i] = 0.f;
#pragma unroll
                for (int s = 0; s < 4; ++s) { const bf16x8 kf = *(const LAS bf16x8*)(Ks + (32 * kt + r) * 72 + 16 * s + 8 * hh); sc[kt] = MFMA32(kf, qf[s], sc[kt]); }
                __builtin_amdgcn_sched_barrier(0);
            }
            const float slope2 = fexp2(-0.5f * (float)(head + 1)) * LOG2E;
            const float sink2 = sinks[head] * LOG2E;
            const int t = 32 * th + r;
            float mx = sink2;
            const int tb = 128 + t - 4 * hh;
#pragma unroll
            for (int kt = 0; kt < 6; ++kt) {
                if (32 * kt >= jmin && 32 * kt + 32 <= jmax) {
#pragma unroll
                    for (int i = 0; i < 16; ++i) { const float dist = fabsf((float)(tb - (32 * kt + (i & 3) + 8 * (i >> 2))));
                        const float l = sc[kt][i] - slope2 * dist; sc[kt][i] = l; mx = fmaxf(mx, l); }
                } else {
#pragma unroll
                    for (int i = 0; i < 16; ++i) sc[kt][i] = -INFINITY;
                }
            }
            mx = fmaxf(mx, __shfl_xor(mx, 32));
            float sum = 0.f;
#pragma unroll
            for (int kt = 0; kt < 6; ++kt)
#pragma unroll
                for (int i = 0; i < 16; ++i) { const float p = fexp2(sc[kt][i] - mx); sc[kt][i] = p; sum += p; }
            sum += __shfl_xor(sum, 32);
            const float inv = 1.f / (sum + fexp2(sink2 - mx));
            f32x16 o[2];
#pragma unroll
            for (int i = 0; i < 16; ++i) { o[0][i] = 0.f; o[1][i] = 0.f; }
#pragma unroll
            for (int kt = 0; kt < 6; ++kt)
#pragma unroll
                for (int s = 0; s < 2; ++s) {
                    u32x4 pp; pp.x = pk2(sc[kt][8 * s], sc[kt][8 * s + 1]); pp.y = pk2(sc[kt][8 * s + 2], sc[kt][8 * s + 3]); pp.z = pk2(sc[kt][8 * s + 4], sc[kt][8 * s + 5]); pp.w = pk2(sc[kt][8 * s + 6], sc[kt][8 * s + 7]);
                    const bf16x8 pf = __builtin_bit_cast(bf16x8, pp);
#pragma unroll
                    for (int mt = 0; mt < 2; ++mt) { const bf16x8 vf = *(const LAS bf16x8*)(VT + (32 * mt + r) * 200 + 32 * kt + 16 * s + 8 * hh); o[mt] = MFMA32(vf, pf, o[mt]); }
                    __builtin_amdgcn_sched_barrier(0);
                }
#pragma unroll
            for (int mt = 0; mt < 2; ++mt)
#pragma unroll
                for (int i4 = 0; i4 < 4; ++i4) {
                    const int d0 = 32 * mt + 8 * i4 + 4 * hh;
                    const u32x2 gz = *(const u32x2*)(QKVG + qrow * 2560 + 1536 + head * 64 + d0);
                    const float o0 = o[mt][4 * i4] * inv * silu(bflo(gz.x)), o1 = o[mt][4 * i4 + 1] * inv * silu(bfhi(gz.x));
                    const float o2 = o[mt][4 * i4 + 2] * inv * silu(bflo(gz.y)), o3 = o[mt][4 * i4 + 3] * inv * silu(bfhi(gz.y));
                    u32x2 ov; ov.x = pk2(o0, o1); ov.y = pk2(o2, o3);
                    *(u32x2*)(OG + qrow * 1024 + head * 64 + d0) = ov;
                }
        }
    }
    __syncthreads();
}


DI u32x4 zero4() { return (u32x4){0u, 0u, 0u, 0u}; }
DI float bfe(const u32x4& v, int e) { const unsigned u = v[e >> 1]; return (e & 1) ? bfhi(u) : bflo(u); }

DI void dn_pre_phase(const Args& a, int lane, int w) {
    bf16* DNP = (bf16*)(a.ws + WS_BIG); const bf16* HALO = (const bf16*)(a.ws + WS_HALO); float* BA = (float*)(a.ws + WS_BA);
    const float* state_conv = a.in[4]; const float* conv_w = a.in[12]; const float* a_log = a.in[13]; const float* dt_bias = a.in[14];
    const int gw = blockIdx.x * 8 + w, NGW = gridDim.x * 8;
    for (int it = gw; it < 528 * 25; it += NGW) {
        asm volatile("" : "+v"(lane));
        const int ch = it / 25, sub = it % 25;
        if (sub == 24) {
            const size_t row = (size_t)64 * ch + lane; const int width = ch < 512 ? 64 : 32;
            float bv[8], gv[8];
#pragma unroll
            for (int hh = 0; hh < 8; ++hh) { bv[hh] = BA[row * 16 + hh]; gv[hh] = BA[row * 16 + 8 + hh]; }
#pragma unroll
            for (int hh = 0; hh < 8; ++hh) {
                const float beta = 1.f / (1.f + __expf(-bv[hh]));
                const float x = gv[hh] + dt_bias[hh]; const float sp = x > 20.f ? x : log1pf(expf(x));
                float gg = -expf(a_log[hh]) * sp;
#pragma unroll
                for (int d = 1; d < 64; d <<= 1) { const float t = __shfl_up(gg, d, 64); if ((lane & (width - 1)) >= d && d < width) gg += t; }
                BA[row * 16 + hh] = beta; BA[row * 16 + 8 + hh] = gg;
            }
            continue;
        }
        const int h = sub / 3, sec = sub % 3;
        const int g = lane >> 4, cl = lane & 15;
        const int col = sec * 1024 + h * 128 + 8 * cl;
        const size_t R0 = (size_t)64 * ch + 16 * g;
        u32x4 xin[19];
#pragma unroll
        for (int i = 0; i < 16; ++i) xin[3 + i] = *(const u32x4*)(DNP + (R0 + i) * 4096 + col);
        if (ch < 512) {
            if (g > 0) {
#pragma unroll
                for (int i = 0; i < 3; ++i) xin[i] = *(const u32x4*)(DNP + (R0 - 3 + i) * 4096 + col);
            } else if ((ch & 63) == 0) { xin[0] = zero4(); xin[1] = zero4(); xin[2] = zero4(); }
            else {
#pragma unroll
                for (int i = 0; i < 3; ++i) xin[i] = *(const u32x4*)(HALO + ((size_t)(ch - 1) * 3 + i) * 3072 + col);
            }
        } else {
            if (g & 1) {
#pragma unroll
                for (int i = 0; i < 3; ++i) xin[i] = *(const u32x4*)(DNP + (R0 - 3 + i) * 4096 + col);
            } else { const int sb = 2 * (ch - 512) + (g >> 1);
#pragma unroll
                for (int i = 0; i < 3; ++i) xin[i] = ld8f_bf(state_conv + ((size_t)sb * 3 + i) * 3072 + col);
            }
        }
        float wv[4][8];
#pragma unroll
        for (int j = 0; j < 4; ++j) { const f32x4 w0 = *(const f32x4*)(conv_w + (size_t)j * 3072 + col), w1 = *(const f32x4*)(conv_w + (size_t)j * 3072 + col + 4);
            wv[j][0] = w0.x; wv[j][1] = w0.y; wv[j][2] = w0.z; wv[j][3] = w0.w; wv[j][4] = w1.x; wv[j][5] = w1.y; wv[j][6] = w1.z; wv[j][7] = w1.w; }
        asm volatile("s_waitcnt vmcnt(0)" ::: "memory");
        const int clp = cl & 3, pos0 = 32 * (cl >> 2) + 16 * (clp & 1) + 4 * (clp >> 1);
        unsigned vp[4][4];
#pragma unroll
        for (int i = 0; i < 16; ++i) {
            float y[8]; float ssq = 0.f;
#pragma unroll
            for (int e = 0; e < 8; ++e) { float t = wv[0][e] * bfe(xin[i], e) + wv[1][e] * bfe(xin[i + 1], e) + wv[2][e] * bfe(xin[i + 2], e) + wv[3][e] * bfe(xin[i + 3], e);
                t = silu(t); y[e] = t; ssq += t * t; }
            if (sec < 2) {
                ssq += __shfl_xor(ssq, 1); ssq += __shfl_xor(ssq, 2); ssq += __shfl_xor(ssq, 4); ssq += __shfl_xor(ssq, 8);
                const float scl = frsq(ssq + EPS) * (sec == 0 ? 0.08838834764831845f : 1.f);
                u32x2 lo, hi; lo.x = pk2(y[0] * scl, y[1] * scl); lo.y = pk2(y[2] * scl, y[3] * scl); hi.x = pk2(y[4] * scl, y[5] * scl); hi.y = pk2(y[6] * scl, y[7] * scl);
                bf16* dst = DNP + (R0 + i) * 4096 + sec * 1024 + h * 128 + pos0;
                *(u32x2*)dst = lo; *(u32x2*)(dst + 8) = hi;
            } else {
                const u32x4 pk = pack8f(y);
                vp[i & 3][0] = pk.x; vp[i & 3][1] = pk.y; vp[i & 3][2] = pk.z; vp[i & 3][3] = pk.w;
                if ((i & 3) == 3) {
                    bf16* dst = DNP + ((size_t)64 * ch + 4 * (4 * g + (i >> 2)) + (cl >> 2)) * 4096 + 2048 + h * 128 + (cl & 3) * 32;
#pragma unroll
                    for (int j = 0; j < 4; ++j) { u32x4 o;
                        o.x = (vp[0][j] & 0xffffu) | (vp[1][j] << 16); o.y = (vp[2][j] & 0xffffu) | (vp[3][j] << 16);
                        o.z = (vp[0][j] >> 16) | (vp[1][j] & 0xffff0000u); o.w = (vp[2][j] >> 16) | (vp[3][j] & 0xffff0000u);
                        *(u32x4*)(dst + 8 * j) = o; }
                }
            }
        }
    }
}


template <int I> DI void fs_load_lo(f32x4 (&mb)[4], const LAS float* Ms) {
#pragma unroll
    for (int j4 = 0; j4 < 4; ++j4) if (4 * j4 < I) mb[j4] = *(const LAS f32x4*)(Ms + I * 64 + 4 * j4);
}
template <int I> DI void fs_load_hi(f32x4 (&mb)[12], const LAS float* Ms) {
#pragma unroll
    for (int j4 = 4; j4 < 16; ++j4) if (4 * j4 < I) mb[j4 - 4] = *(const LAS f32x4*)(Ms + I * 64 + 4 * j4);
}
template <int I> DI void fs_comp(float (&T)[64], const f32x4 (&lo)[4], const f32x4 (&hi)[12], int lane) {
    float a0 = (lane == I) ? 1.f : 0.f, a1 = 0.f, a2 = 0.f, a3 = 0.f;
#pragma unroll
    for (int j4 = 0; j4 < 4; ++j4) {
        if (4 * j4 + 0 < I) a0 -= lo[j4][0] * T[4 * j4 + 0];
        if (4 * j4 + 1 < I) a1 -= lo[j4][1] * T[4 * j4 + 1];
        if (4 * j4 + 2 < I) a2 -= lo[j4][2] * T[4 * j4 + 2];
        if (4 * j4 + 3 < I) a3 -= lo[j4][3] * T[4 * j4 + 3];
    }
#pragma unroll
    for (int j4 = 4; j4 < 16; ++j4) {
        if (4 * j4 + 0 < I) a0 -= hi[j4 - 4][0] * T[4 * j4 + 0];
        if (4 * j4 + 1 < I) a1 -= hi[j4 - 4][1] * T[4 * j4 + 1];
        if (4 * j4 + 2 < I) a2 -= hi[j4 - 4][2] * T[4 * j4 + 2];
        if (4 * j4 + 3 < I) a3 -= hi[j4 - 4][3] * T[4 * j4 + 3];
    }
    T[I] = (a0 + a1) + (a2 + a3);
}
template <int I> DI void fs_pipe(float (&T)[64], const LAS float* Ms, int lane, f32x4 (&cur)[4], f32x4 (&nxt)[4], f32x4 (&hi)[12]) {
    if constexpr (I < 64) {
        fs_load_hi<I>(hi, Ms);
        if constexpr (I + 1 < 64) fs_load_lo<I + 1>(nxt, Ms);
        fs_comp<I>(T, cur, hi, lane);
        fs_pipe<I + 1>(T, Ms, lane, nxt, cur, hi);
    }
}
template <int I> DI void tb_store(float (&T)[64], LAS bf16* TbI, int lane, float betal) {
    if constexpr (I < 64) { TbI[I * 64 + lane] = f2bf(T[I] * betal); tb_store<I + 1>(T, TbI, lane, betal); }
}
DI void dn_prep_phase(const Args& a, LAS unsigned char* lds, int lane, int w) {
    const bf16* DNP = (const bf16*)(a.ws + WS_BIG); const float* BA = (const float*)(a.ws + WS_BA);
    unsigned char* TBI = a.ws + WS_XN; unsigned char* KTG = a.ws + WS_KT; float* SCAL = (float*)(a.ws + WS_SCAL);
    LAS float* Ms = (LAS float*)(lds + w * 17408);
    LAS bf16* TbI = (LAS bf16*)Ms; LAS bf16* InI = TbI + 4096; LAS bf16* Kl = (LAS bf16*)Ms;
    const int gw = blockIdx.x * 8 + w, NGW = gridDim.x * 8;
    for (int slot = 0; slot < 3; ++slot) {
        int uid = gw + 2048 * slot; if (slot == 2) { if (w != 0 || (int)blockIdx.x >= 256) break; uid = 4096 + (int)blockIdx.x; } else if (uid >= 4096) continue;
        asm volatile("" : "+v"(lane));
        const int r = lane & 31, hh = lane >> 5;
        int h, nv; size_t R0;
        if (uid < 4096) { h = uid & 7; R0 = (size_t)64 * (uid >> 3); nv = 64; } else { const int su = uid - 4096; h = su & 7; R0 = (size_t)MP + 32 * (su >> 3); nv = 32; }
        const int lr = lane < nv ? lane : nv - 1;
        const float gcl = BA[(R0 + lr) * 16 + 8 + h];
        const float betal_ = BA[(R0 + lr) * 16 + h]; const float betal = lane < nv ? betal_ : 0.f;
        const bf16* kbase = DNP + R0 * 4096 + 1024 + h * 128; const bf16* qbase = DNP + R0 * 4096 + h * 128;
        const int row = lane & 15, quad = lane >> 4;
        {
            bf16x8 kf[2][8];
#pragma unroll
            for (int mt = 0; mt < 2; ++mt)
#pragma unroll
                for (int s = 0; s < 8; ++s) { const bool ok = 32 * mt + r < nv; const bf16x8 t = *(const bf16x8*)(kbase + (size_t)(ok ? 32 * mt + r : 0) * 4096 + 16 * s + 8 * hh); kf[mt][s] = ok ? t : (bf16x8){0, 0, 0, 0, 0, 0, 0, 0}; }
#pragma unroll
            for (int tl = 0; tl < 3; ++tl) {
                const int mt = tl > 0 ? 1 : 0, nt = tl > 1 ? 1 : 0;
                f32x16 kk;
#pragma unroll
                for (int i = 0; i < 16; ++i) kk[i] = 0.f;
#pragma unroll
                for (int s = 0; s < 8; ++s) kk = MFMA32(kf[mt][s], kf[nt][s], kk);
                const int j = 32 * nt + r; const float gcj = __shfl(gcl, j);
#pragma unroll
                for (int i = 0; i < 16; ++i) {
                    const int ii = 32 * mt + crow(i, hh);
                    const float gci = __shfl(gcl, ii), bi = __shfl(betal, ii);
                    Ms[ii * 64 + j] = (ii > j) ? kk[i] * bi * __expf(fminf(gci - gcj, 0.f)) : 0.f;
                }
            }
        }
        {
            float T[64]; f32x4 mbA[4], mbB[4], mbH[12];
            fs_pipe<0>(T, Ms, lane, mbA, mbB, mbH);
            tb_store<0>(T, TbI, lane, betal);
        }
#pragma unroll
        for (int f = 0; f < 8; ++f) {
            const int i = 16 * (f >> 1) + row, c0 = 32 * (f & 1) + 4 * quad;
            const u32x2 tlo = *(const LAS u32x2*)(TbI + i * 64 + c0), thi = *(const LAS u32x2*)(TbI + i * 64 + c0 + 16);
            *(u32x4*)(TBI + (size_t)uid * 16384 + (size_t)(f * 64 + lane) * 16) = (u32x4){tlo.x, tlo.y, thi.x, thi.y};
        }
        {
#pragma unroll
            for (int tl = 0; tl < 3; ++tl) {
                const int mt = tl > 0 ? 1 : 0, nt = tl > 1 ? 1 : 0;
                f32x16 qk;
#pragma unroll
                for (int i = 0; i < 16; ++i) qk[i] = 0.f;
#pragma unroll
                for (int s = 0; s < 8; ++s) {
                    const bool okq = 32 * mt + r < nv, okk = 32 * nt + r < nv;
                    const bf16x8 qt = *(const bf16x8*)(qbase + (size_t)(okq ? 32 * mt + r : 0) * 4096 + 16 * s + 8 * hh), kt_ = *(const bf16x8*)(kbase + (size_t)(okk ? 32 * nt + r : 0) * 4096 + 16 * s + 8 * hh);
                    const bf16x8 qf = okq ? qt : (bf16x8){0, 0, 0, 0, 0, 0, 0, 0}, kf = okk ? kt_ : (bf16x8){0, 0, 0, 0, 0, 0, 0, 0};
                    qk = MFMA32(qf, kf, qk);
                }
                const int j = 32 * nt + r; const float gcj = __shfl(gcl, j);
#pragma unroll
                for (int i = 0; i < 16; ++i) {
                    const int ii = 32 * mt + crow(i, hh);
                    const float gci = __shfl(gcl, ii);
                    InI[ii * 64 + j] = f2bf((ii >= j) ? qk[i] * __expf(fminf(gci - gcj, 0.f)) : 0.f);
                    if (tl == 0) InI[ii * 64 + 32 + r] = 0;
                }
            }
#pragma unroll
            for (int f = 0; f < 8; ++f) {
                const int i = 16 * (f >> 1) + row, c0 = 32 * (f & 1) + 4 * quad;
                const u32x2 ilo = *(const LAS u32x2*)(InI + i * 64 + c0), ihi = *(const LAS u32x2*)(InI + i * 64 + c0 + 16);
                *(u32x4*)(TBI + (size_t)uid * 16384 + 8192 + (size_t)(f * 64 + lane) * 16) = (u32x4){ilo.x, ilo.y, ihi.x, ihi.y};
            }
        }
#pragma unroll
        for (int i = 0; i < 16; ++i) { const int id = lane + 64 * i, rr = id >> 4, c16 = id & 15;
            const u32x4 vt_ = *(const u32x4*)(kbase + (size_t)(rr < nv ? rr : 0) * 4096 + 8 * c16); const u32x4 v = (rr < nv) ? vt_ : zero4();
            *(LAS u32x4*)(Kl + rr * 136 + 8 * c16) = v; }
#pragma unroll
        for (int f = 0; f < 16; ++f) {
            const int dk = 16 * (f >> 1) + row, dkp = dk & 31, pos = (dk & ~31) + 8 * ((dkp >> 2) & 3) + 4 * (dkp >> 4) + (dkp & 3);
            u32x4 o;
#pragma unroll
            for (int j2 = 0; j2 < 4; ++j2) { const int tok = 32 * (f & 1) + 16 * (j2 >> 1) + 4 * quad + 2 * (j2 & 1);
                o[j2] = (unsigned)Kl[tok * 136 + pos] | ((unsigned)Kl[(tok + 1) * 136 + pos] << 16); }
            *(u32x4*)(KTG + (size_t)uid * 16384 + (size_t)(f * 64 + lane) * 16) = o;
        }
        const float gl = __shfl(gcl, 63);
        SCAL[(size_t)uid * 256 + lane] = __expf(gcl); SCAL[(size_t)uid * 256 + 64 + lane] = __expf(gl - gcl);
        if (lane == 0) SCAL[(size_t)uid * 256 + 128] = __expf(gl);
    }
}

constexpr int SC_K = 0, SC_Q = 17408, SC_V = 34816, SC_TB = 52224, SC_IN = 60416, SC_KT = 68608, SC_SC = 84992, SC_OB = 86016, SC_OBSZ = 17408, SC_NG = 120832;
#define RAW_BARRIER() do { asm volatile("s_waitcnt lgkmcnt(0)" ::: "memory"); __builtin_amdgcn_s_barrier(); asm volatile("" ::: "memory"); } while (0)
struct QuarterOrder {
    int q, c, G;
    DI bool next(int i, pg8::Unit& u) const {
        const int L = i * G + c;
        if (L < 128) { u.pm = 16 * (L >> 4) + 4 * q + ((L >> 2) & 3); u.pn = L & 3; return true; }
        if (q == 3 && L < 144) { u.pm = 128 + ((L - 128) >> 2); u.pn = L & 3; return true; }
        return false;
    }
    DI void a_ready(const pg8::Unit&) const {}
    DI void done(const pg8::Unit&) const {}
};
struct SampleOrder {
    int c;
    DI bool next(int i, pg8::Unit& u) const { if (i > 0 || c < 0 || c >= 16) return false; u.pm = 128 + (c >> 2); u.pn = c & 3; return true; }
    DI void a_ready(const pg8::Unit&) const {}
    DI void done(const pg8::Unit&) const {}
};
DI void dn_scan_phase(const Args& a, LAS unsigned char* lds, int tid, int lane, int w, const XcdBarrier& xbar, int job_lo, int job_hi, bool midbar, int job_step) {
    const bf16* DNP = (const bf16*)(a.ws + WS_BIG); const unsigned char* TBI = a.ws + WS_XN; const unsigned char* KTG = a.ws + WS_KT; const float* SCAL = (const float*)(a.ws + WS_SCAL);
    bf16* OG = (bf16*)(a.ws + WS_OG); const float* state_ssm = a.in[5]; const float* ng = a.in[15];
    for (int job = job_lo; job < job_hi; job += job_step) {
        int h, nsteps, nv; size_t Rbase; int uid0, ustep; float* sout; const float* sin = nullptr;
        if (job < 64) { const int b = job >> 3; h = job & 7; nsteps = 64; nv = 64; Rbase = (size_t)b * 4096; uid0 = b * 512 + h; ustep = 8; sout = a.out + O_SSMP + (size_t)(b * 8 + h) * 16384; }
        else { const int s = job - 64, sb = s >> 3; h = s & 7; nsteps = 1; nv = 32; Rbase = (size_t)MP + 32 * sb; uid0 = 4096 + s; ustep = 0; sout = a.out + O_SSMS + (size_t)(sb * 8 + h) * 16384; sin = state_ssm + (size_t)(sb * 8 + h) * 16384; }
        if (w < 4) {
            f32x4 S[2][8];
            { const int col = lane & 15, quad = lane >> 4;
#pragma unroll
              for (int nt = 0; nt < 2; ++nt)
#pragma unroll
                for (int t = 0; t < 8; ++t)
#pragma unroll
                    for (int i = 0; i < 4; ++i) S[nt][t][i] = 0.f;
              if (sin) {
#pragma unroll
                for (int nt = 0; nt < 2; ++nt)
#pragma unroll
                  for (int t = 0; t < 8; ++t)
#pragma unroll
                    for (int i = 0; i < 4; ++i) S[nt][t][i] = sin[(size_t)(16 * t + 4 * quad + i) * 128 + 32 * w + 16 * nt + col];
              } }
#if defined(PROBE_IDLE) || defined(PROBE_REGION)
            unsigned long long idle_acc = 0;
#endif
#ifdef PROBE_WHOLE
            const unsigned long long tw0_ = __builtin_amdgcn_s_memrealtime();
#endif
            for (int n = 0; n < nsteps; ++n) {
                if (midbar && n == 17) xcd_barrier(xbar);
                asm volatile("" : "+v"(lane));
                const int col = lane & 15, quad = lane >> 4;
#if defined(PROBE_IDLE) && !defined(PROBE_REGION)
                const unsigned long long t0_ = __builtin_amdgcn_s_memrealtime();
#endif
                RAW_BARRIER();
                RAW_BARRIER();
#if defined(PROBE_IDLE) && !defined(PROBE_REGION)
                idle_acc += __builtin_amdgcn_s_memrealtime() - t0_;
#endif
#ifdef PROBE_REGION
                unsigned long long tr_ = 0;
#define RMARK(k) do { if ((k) == PROBE_REGION) { asm volatile("s_nop 0" ::: "memory"); tr_ = __builtin_amdgcn_s_memrealtime(); } if ((k) == PROBE_REGION + 1) { asm volatile("s_nop 0" ::: "memory"); idle_acc += __builtin_amdgcn_s_memrealtime() - tr_; } } while (0)
#else
#define RMARK(k) do { } while (0)
#endif
                RMARK(0);
#define BUILD_SB() do { _Pragma("unroll") for (int nt = 0; nt < 2; ++nt) _Pragma("unroll") for (int ks = 0; ks < 4; ++ks) { u32x4 p; p.x = pk2(S[nt][2 * ks][0], S[nt][2 * ks][1]); p.y = pk2(S[nt][2 * ks][2], S[nt][2 * ks][3]); \
                    p.z = pk2(S[nt][2 * ks + 1][0], S[nt][2 * ks + 1][1]); p.w = pk2(S[nt][2 * ks + 1][2], S[nt][2 * ks + 1][3]); sB[nt][ks] = __builtin_bit_cast(bf16x8, p); } } while (0)
#define SCHED_FENCE() __builtin_amdgcn_sched_barrier(0)
                f32x4 kS[2][4];
                bf16x8 ta[6];
                bf16x8 sB[2][4];
                {
                    bf16x8 ka[4][4];
#pragma unroll
                    for (int mt = 0; mt < 4; ++mt)
#pragma unroll
                        for (int ks = 0; ks < 4; ++ks) ka[mt][ks] = *(const LAS bf16x8*)(lds + SC_K + (16 * mt + col) * 272 + 64 * ks + 16 * quad);
#pragma unroll
                    for (int f = 0; f < 6; ++f) { const int mt = f < 2 ? f : 2 + ((f - 2) >> 1), k2 = f < 2 ? 0 : ((f - 2) & 1); ta[f] = *(const LAS bf16x8*)(lds + SC_TB + ((mt * 2 + k2) * 64 + lane) * 16); }
                    BUILD_SB();
                    SCHED_FENCE();
#ifndef PROBE_KREP
#define PROBE_KREP 1
#endif
                    for (int krep = 0; krep < PROBE_KREP; ++krep) {
                    asm volatile("" ::: "memory");
#pragma unroll
                    for (int mt = 0; mt < 4; ++mt)
#pragma unroll
                        for (int nt = 0; nt < 2; ++nt) kS[nt][mt] = (f32x4){0.f, 0.f, 0.f, 0.f};
#pragma unroll
                    for (int ks = 0; ks < 4; ++ks)
#pragma unroll
                        for (int mt = 0; mt < 4; ++mt)
#pragma unroll
                            for (int nt = 0; nt < 2; ++nt) kS[nt][mt] = MFMA16(ka[mt][ks], sB[nt][ks], kS[nt][mt]);
                    SCHED_FENCE();
                    }
                }
                RMARK(1);
#define EVL(mt) (*(const LAS f32x4*)(lds + SC_SC + (16 * (mt) + 4 * quad) * 4))
#define DVL(mt) (*(const LAS f32x4*)(lds + SC_SC + (64 + 16 * (mt) + 4 * quad) * 4))
                const float gam = *(const LAS float*)(lds + SC_SC + 128 * 4);
                bf16x8 vB[2][2], vdB[2][2];
                {
                    bf16x8 rB[2][2];
#pragma unroll
                    for (int nt = 0; nt < 2; ++nt) {
                        f32x4 rr4[4];
#pragma unroll
                        for (int mt = 0; mt < 4; ++mt) { const u32x2 vv = *(const LAS u32x2*)(lds + SC_V + (4 * (4 * mt + quad) + w) * 272 + (16 * nt + col) * 8); const f32x4 ev = EVL(mt);
                            rr4[mt][0] = bflo(vv.x) - ev[0] * kS[nt][mt][0]; rr4[mt][1] = bfhi(vv.x) - ev[1] * kS[nt][mt][1];
                            rr4[mt][2] = bflo(vv.y) - ev[2] * kS[nt][mt][2]; rr4[mt][3] = bfhi(vv.y) - ev[3] * kS[nt][mt][3]; }
#pragma unroll
                        for (int k2 = 0; k2 < 2; ++k2) { u32x4 p; p.x = pk2(rr4[2 * k2][0], rr4[2 * k2][1]); p.y = pk2(rr4[2 * k2][2], rr4[2 * k2][3]); p.z = pk2(rr4[2 * k2 + 1][0], rr4[2 * k2 + 1][1]); p.w = pk2(rr4[2 * k2 + 1][2], rr4[2 * k2 + 1][3]); rB[nt][k2] = __builtin_bit_cast(bf16x8, p); }
                    }
                    f32x4 vn[2][4];
#pragma unroll
                    for (int mt = 0; mt < 4; ++mt)
#pragma unroll
                        for (int nt = 0; nt < 2; ++nt) vn[nt][mt] = (f32x4){0.f, 0.f, 0.f, 0.f};
#pragma unroll
                    for (int f = 0; f < 6; ++f) { const int mt = f < 2 ? f : 2 + ((f - 2) >> 1), k2 = f < 2 ? 0 : ((f - 2) & 1);
#pragma unroll
                        for (int nt = 0; nt < 2; ++nt) vn[nt][mt] = MFMA16(ta[f], rB[nt][k2], vn[nt][mt]); }
#pragma unroll
                    for (int nt = 0; nt < 2; ++nt)
#pragma unroll
                        for (int k2 = 0; k2 < 2; ++k2) { u32x4 p, q; const f32x4 d0 = DVL(2 * k2), d1 = DVL(2 * k2 + 1);
                            p.x = pk2(vn[nt][2 * k2][0], vn[nt][2 * k2][1]); p.y = pk2(vn[nt][2 * k2][2], vn[nt][2 * k2][3]); p.z = pk2(vn[nt][2 * k2 + 1][0], vn[nt][2 * k2 + 1][1]); p.w = pk2(vn[nt][2 * k2 + 1][2], vn[nt][2 * k2 + 1][3]);
                            q.x = pk2(vn[nt][2 * k2][0] * d0[0], vn[nt][2 * k2][1] * d0[1]); q.y = pk2(vn[nt][2 * k2][2] * d0[2], vn[nt][2 * k2][3] * d0[3]);
                            q.z = pk2(vn[nt][2 * k2 + 1][0] * d1[0], vn[nt][2 * k2 + 1][1] * d1[1]); q.w = pk2(vn[nt][2 * k2 + 1][2] * d1[2], vn[nt][2 * k2 + 1][3] * d1[3]);
                            vB[nt][k2] = __builtin_bit_cast(bf16x8, p); vdB[nt][k2] = __builtin_bit_cast(bf16x8, q); }
                }
                RMARK(2);
                LAS bf16* OB = (LAS bf16*)(lds + SC_OB + (n & 1) * SC_OBSZ);
                {
#pragma unroll
                    for (int hf = 0; hf < 2; ++hf) {
                        bf16x8 qa[2][4], ia[3];
#pragma unroll
                        for (int m2 = 0; m2 < 2; ++m2)
#pragma unroll
                            for (int ks = 0; ks < 4; ++ks) qa[m2][ks] = *(const LAS bf16x8*)(lds + SC_Q + (16 * (2 * hf + m2) + col) * 272 + 64 * ks + 16 * quad);
                        if (hf == 0) { ia[0] = *(const LAS bf16x8*)(lds + SC_IN + ((0 * 2 + 0) * 64 + lane) * 16); ia[1] = *(const LAS bf16x8*)(lds + SC_IN + ((1 * 2 + 0) * 64 + lane) * 16); ia[2] = ia[1]; }
                        SCHED_FENCE();
                        f32x4 o[2][2];
#pragma unroll
                        for (int m2 = 0; m2 < 2; ++m2)
#pragma unroll
                            for (int nt = 0; nt < 2; ++nt) o[nt][m2] = (f32x4){0.f, 0.f, 0.f, 0.f};
#pragma unroll
                        for (int ks = 0; ks < 4; ++ks)
#pragma unroll
                            for (int m2 = 0; m2 < 2; ++m2)
#pragma unroll
                                for (int nt = 0; nt < 2; ++nt) o[nt][m2] = MFMA16(qa[m2][ks], sB[nt][ks], o[nt][m2]);
#pragma unroll
                        for (int m2 = 0; m2 < 2; ++m2) { const int mt = 2 * hf + m2; const f32x4 ev = EVL(mt);
#pragma unroll
                            for (int nt = 0; nt < 2; ++nt) o[nt][m2] = ev * o[nt][m2];
#pragma unroll
                            for (int k2 = 0; k2 < 2; ++k2) { if (k2 == 1 && mt < 2) continue;
                                const bf16x8 iaf = (hf == 0) ? ia[m2] : *(const LAS bf16x8*)(lds + SC_IN + ((mt * 2 + k2) * 64 + lane) * 16);
#pragma unroll
                                for (int nt = 0; nt < 2; ++nt) o[nt][m2] = MFMA16(iaf, vB[nt][k2], o[nt][m2]); }
#pragma unroll
                            for (int nt = 0; nt < 2; ++nt)
#pragma unroll
                                for (int i = 0; i < 4; ++i) OB[(16 * mt + 4 * quad + i) * 136 + 32 * w + 16 * nt + col] = f2bf(o[nt][m2][i]);
                        }
                        SCHED_FENCE();
                    }
                }
                RMARK(3);
                {
                    bf16x8 kt[8][2];
#pragma unroll
                    for (int t = 0; t < 8; ++t)
#pragma unroll
                        for (int k2 = 0; k2 < 2; ++k2) kt[t][k2] = *(const LAS bf16x8*)(lds + SC_KT + ((t * 2 + k2) * 64 + lane) * 16);
#pragma unroll
                    for (int t = 0; t < 8; ++t)
#pragma unroll
                        for (int nt = 0; nt < 2; ++nt) S[nt][t] = S[nt][t] * gam;
                    SCHED_FENCE();
#pragma unroll
                    for (int k2 = 0; k2 < 2; ++k2)
#pragma unroll
                        for (int t = 0; t < 8; ++t)
#pragma unroll
                            for (int nt = 0; nt < 2; ++nt) S[nt][t] = MFMA16(kt[t][k2], vdB[nt][k2], S[nt][t]);
                }
                RMARK(4);
            }
            RAW_BARRIER();
#if defined(PROBE_IDLE) || defined(PROBE_REGION)
#ifdef PROBE_WHOLE
            idle_acc = __builtin_amdgcn_s_memrealtime() - tw0_;
#endif
            if (blockIdx.x == 0 && job == 0) { const unsigned long long tend_ = __builtin_amdgcn_s_memrealtime() + PROBE_IDLE * idle_acc + PROBE_FIXED; while (__builtin_amdgcn_s_memrealtime() < tend_) __builtin_amdgcn_s_sleep(8); }
#endif
            { const int col = lane & 15, quad = lane >> 4;
#pragma unroll
              for (int nt = 0; nt < 2; ++nt)
#pragma unroll
                for (int t = 0; t < 8; ++t)
#pragma unroll
                    for (int i = 0; i < 4; ++i) sout[(size_t)(16 * t + 4 * quad + i) * 128 + 32 * w + 16 * nt + col] = S[nt][t][i]; }
        } else {
            const int nl = nsteps - 1;
#define CLAMPN(x) ((x) < nl ? (x) : nl)
            if (w < 6) {
                int st = tid - 256; asm volatile("" : "+v"(st));
                u32x4 pf[40]; float pfs0 = 0.f, pfs1 = 0.f; unsigned tch[6] = {0u, 0u, 0u, 0u, 0u, 0u}, tacc = 0u;
#define ST_TOUCH(n) do { const size_t R0_ = Rbase + (size_t)64 * (n); const int uid_ = uid0 + ustep * (n); \
                    _Pragma("unroll") for (int i_ = 0; i_ < 6; ++i_) { const int L_ = st + 128 * i_; const unsigned char* p_; \
                        if (L_ < 512) { const int sec_ = L_ >> 7, idx_ = L_ & 127; p_ = (const unsigned char*)(DNP + (R0_ + (idx_ >> 1)) * 4096 + sec_ * 1024 + h * 128 + (idx_ & 1) * 64); } \
                        else if (L_ < 640) p_ = TBI + (size_t)uid_ * 16384 + (size_t)(L_ - 512) * 128; \
                        else p_ = KTG + (size_t)uid_ * 16384 + (size_t)(L_ - 640) * 128; \
                        tch[i_] = *(const unsigned*)p_; } } while (0)
#define ST_PREFETCH(n) do { const size_t R0_ = Rbase + (size_t)64 * (n); const int uid_ = uid0 + ustep * (n); \
                    _Pragma("unroll") for (int i_ = 0; i_ < 8; ++i_) { const int id_ = st + 128 * i_, rr_ = id_ >> 4, c16_ = id_ & 15; const bool ok_ = rr_ < nv; \
                        const bf16* src_ = DNP + (R0_ + (ok_ ? rr_ : 0)) * 4096 + h * 128 + 8 * c16_; \
                        const u32x4 k_ = *(const u32x4*)(src_ + 1024); pf[i_] = ok_ ? k_ : zero4(); \
                        pf[24 + i_] = *(const u32x4*)(KTG + (size_t)uid_ * 16384 + (size_t)id_ * 16); } \
                    _Pragma("unroll") for (int i_ = 0; i_ < 4; ++i_) { pf[32 + i_] = *(const u32x4*)(TBI + (size_t)uid_ * 16384 + (size_t)(st + 128 * i_) * 16); pf[36 + i_] = *(const u32x4*)(TBI + (size_t)uid_ * 16384 + 8192 + (size_t)(st + 128 * i_) * 16); } \
                    pfs0 = SCAL[(size_t)uid_ * 256 + st]; pfs1 = SCAL[(size_t)uid_ * 256 + 128 + st]; } while (0)
#define ST_WRITE() do { \
                    _Pragma("unroll") for (int i = 0; i < 8; ++i) { const int id = st + 128 * i, rr = id >> 4, c16 = id & 15; const int off = rr * 272 + c16 * 16; \
                        *(LAS u32x4*)(lds + SC_K + off) = pf[i]; \
                        *(LAS u32x4*)(lds + SC_KT + id * 16) = pf[24 + i]; } \
                    _Pragma("unroll") for (int i = 0; i < 4; ++i) { *(LAS u32x4*)(lds + SC_TB + (st + 128 * i) * 16) = pf[32 + i]; *(LAS u32x4*)(lds + SC_IN + (st + 128 * i) * 16) = pf[36 + i]; } \
                    *(LAS float*)(lds + SC_SC + st * 4) = pfs0; *(LAS float*)(lds + SC_SC + (128 + st) * 4) = pfs1; } while (0)
                ST_PREFETCH(0);
                for (int nn = 0; nn < nsteps; ++nn) {
                    if (midbar && nn == 17) xcd_barrier(xbar);
                    asm volatile("" : "+v"(st));
                    RAW_BARRIER();
                    ST_WRITE();
                    RAW_BARRIER();
                    tacc ^= (tch[0] ^ tch[1]) ^ (tch[2] ^ tch[3]) ^ (tch[4] ^ tch[5]);
                    ST_PREFETCH(CLAMPN(nn + 1));
                }
                RAW_BARRIER();
                tacc ^= (tch[0] ^ tch[1]) ^ (tch[2] ^ tch[3]) ^ (tch[4] ^ tch[5]) ^ pf[0][0] ^ pf[39][3];
                if (tacc == 0x9e3779b9u && nv == 77) ((unsigned*)a.ws)[8192 + st] = tacc;
#undef ST_TOUCH
#undef ST_PREFETCH
#undef ST_WRITE
            } else {
                int et = tid - 384; asm volatile("" : "+v"(et));
                u32x4 zr[8], qv[16];
#define EP_QV_PREFETCH(n) do { const size_t R0_ = Rbase + (size_t)64 * (n); \
                    _Pragma("unroll") for (int i_ = 0; i_ < 8; ++i_) { const int id_ = et + 128 * i_, rr_ = id_ >> 4, c16_ = id_ & 15; const bool ok_ = rr_ < nv; \
                        const bf16* src_ = DNP + (R0_ + (ok_ ? rr_ : 0)) * 4096 + h * 128 + 8 * c16_; \
                        const u32x4 q_ = *(const u32x4*)(src_), v_ = *(const u32x4*)(src_ + 2048); qv[i_] = ok_ ? q_ : zero4(); qv[8 + i_] = ok_ ? v_ : zero4(); } } while (0)
#define EP_QV_WRITE() do { \
                    _Pragma("unroll") for (int i = 0; i < 8; ++i) { const int id = et + 128 * i, rr = id >> 4, c16 = id & 15; const int off = rr * 272 + c16 * 16; \
                        *(LAS u32x4*)(lds + SC_Q + off) = qv[i]; *(LAS u32x4*)(lds + SC_V + off) = qv[8 + i]; } } while (0)
#define EP_ZLOAD(n) do { const bool okz_ = (et >> 1) < nv; const bf16* zs_ = DNP + (Rbase + (size_t)64 * (n) + (okz_ ? (et >> 1) : 0)) * 4096 + 3072 + h * 128 + 64 * (et & 1); \
                      _Pragma("unroll") for (int j_ = 0; j_ < 8; ++j_) zr[j_] = *(const u32x4*)(zs_ + 8 * j_); } while (0)
#define EP_RUN(n) do { const LAS bf16* OB_ = (const LAS bf16*)(lds + SC_OB + ((n) & 1) * SC_OBSZ) + (et >> 1) * 136 + 64 * (et & 1); \
                    u32x4 ov_[8]; float ss_ = 0.f; \
                    _Pragma("unroll") for (int j_ = 0; j_ < 8; ++j_) { ov_[j_] = *(const LAS u32x4*)(OB_ + 8 * j_); \
                        _Pragma("unroll") for (int e_ = 0; e_ < 4; ++e_) { const float x0_ = bflo(ov_[j_][e_]), x1_ = bfhi(ov_[j_][e_]); ss_ += x0_ * x0_ + x1_ * x1_; } } \
                    ss_ += __shfl_xor(ss_, 1); \
                    const float rs_ = frsq(ss_ * (1.f / 128.f) + EPS); \
                    bf16* od_ = ((et >> 1) < nv) ? OG + (Rbase + (size_t)64 * (n) + (et >> 1)) * 1024 + h * 128 + 64 * (et & 1) : (bf16*)(a.ws + 65536 + (size_t)tid * 128); \
                    _Pragma("unroll") for (int j_ = 0; j_ < 8; ++j_) { u32x4 o_; \
                        _Pragma("unroll") for (int e_ = 0; e_ < 4; ++e_) o_[e_] = pk2(bflo(ov_[j_][e_]) * rs_ * bflo(zr[j_][e_]), bfhi(ov_[j_][e_]) * rs_ * bfhi(zr[j_][e_])); \
                        *(u32x4*)(od_ + 8 * j_) = o_; } } while (0)
                EP_QV_PREFETCH(0);
                {
                    RAW_BARRIER(); EP_QV_WRITE(); RAW_BARRIER();
                    EP_QV_PREFETCH(CLAMPN(1));
                    EP_ZLOAD(0);
                }
                for (int nn = 1; nn < nsteps; ++nn) {
                    if (midbar && nn == 17) xcd_barrier(xbar);
                    asm volatile("" : "+v"(et));
                    RAW_BARRIER();
                    EP_QV_WRITE();
                    RAW_BARRIER();
                    EP_QV_PREFETCH(CLAMPN(nn + 1));
                    EP_RUN(nn - 1);
                    EP_ZLOAD(nn);
                }
                RAW_BARRIER();
                EP_RUN(nsteps - 1);
#undef EP_ZLOAD
#undef EP_QV_PREFETCH
#undef EP_QV_WRITE
#undef EP_RUN
            }
#undef CLAMPN
        }
        __syncthreads();
    }
}

DI void final_norm_phase(const Args& a, int lane, int w) {
    const bf16* XG = (const bf16*)(a.ws + WS_XN); const float* ss2 = (const float*)(a.ws + WS_SS2);
    const int gw = blockIdx.x * 8 + w, NGW = gridDim.x * 8;
    for (int m0 = gw; m0 < MROWS; m0 += 4 * NGW) {
        u32x4 v[4][2]; float rs[4];
#pragma unroll
        for (int r = 0; r < 4; ++r) { const int m = m0 + r * NGW; const int mc = m < MROWS ? m : m0;
            rs[r] = frsq(ss2[mc] * (1.f / DM) + EPS);
            v[r][0] = *(const u32x4*)(XG + (size_t)mc * DM + 8 * lane); v[r][1] = *(const u32x4*)(XG + (size_t)mc * DM + 512 + 8 * lane); }
#pragma unroll
        for (int r = 0; r < 4; ++r) { const int m = m0 + r * NGW; if (m < MROWS) { float* yr = a.out + (size_t)m * DM;
#pragma unroll
            for (int hlf = 0; hlf < 2; ++hlf) { const u32x4 x = v[r][hlf];
                *(f32x4*)(yr + 512 * hlf + 8 * lane) = (f32x4){bflo(x.x) * rs[r], bfhi(x.x) * rs[r], bflo(x.y) * rs[r], bfhi(x.y) * rs[r]};
                *(f32x4*)(yr + 512 * hlf + 8 * lane + 4) = (f32x4){bflo(x.z) * rs[r], bfhi(x.z) * rs[r], bflo(x.w) * rs[r], bfhi(x.w) * rs[r]}; } } }
    }
}

#ifndef N_PHASES
#define N_PHASES 10
#endif
__global__ void __launch_bounds__(512, 2) mega_fwd(Args a, int ph_lo, int ph_hi, int coop) {
    extern __shared__ __attribute__((aligned(16))) unsigned char lds_raw[];
    LAS unsigned char* lds = (LAS unsigned char*)lds_raw;
    const int tid = threadIdx.x, lane = tid & 63, w = __builtin_amdgcn_readfirstlane(tid >> 6);
    cg::grid_group grid = cg::this_grid();
    unsigned* barw = (unsigned*)a.ws;
    volatile LAS unsigned* bst = (volatile LAS unsigned*)(lds + LDS_BYTES - 64);
    if (tid < 16) bst[tid] = 0u;
    __syncthreads();
    XcdBarrier xbar = xcd_barrier_post(barw, bst);
    bf16* XN = (bf16*)(a.ws + WS_XN); bf16* BIG = (bf16*)(a.ws + WS_BIG); bf16* OG = (bf16*)(a.ws + WS_OG);
    float* ss1 = (float*)(a.ws + WS_SS1); float* ss2 = (float*)(a.ws + WS_SS2);
#ifndef PH_MASK
#define PH_MASK 0x3ff
#endif
#define IN(k) (((PH_MASK >> (k)) & 1) && ph_lo <= (k) && (k) < ph_hi)
#define SEAM(k) do { if (coop && IN(k) && IN((k) + 1)) { if (coop == 2) grid.sync(); else xcd_barrier(xbar); } } while (0)
#ifndef REP_MASK
#define REP_MASK 0
#endif
#define REP(k) for (int rep_ = 0; rep_ < 1 + ((REP_MASK >> (k)) & 1); ++rep_)
#ifdef PROBE_PHASE
    unsigned long long tph_ = 0;
#define PH_BEGIN(k) do { if ((k) == PROBE_PHASE) tph_ = __builtin_amdgcn_s_memrealtime(); } while (0)
#define PH_END(k) do { if ((k) == PROBE_PHASE && blockIdx.x == PROBE_WG) { __syncthreads(); const unsigned long long now_ = __builtin_amdgcn_s_memrealtime(); const unsigned long long tend_ = now_ + (now_ - tph_); while (__builtin_amdgcn_s_memrealtime() < tend_) __builtin_amdgcn_s_sleep(8); } } while (0)
#else
#define PH_BEGIN(k) do { } while (0)
#define PH_END(k) do { } while (0)
#endif
    PH_BEGIN(0);
    if (IN(0)) REP(0) { p0_prologue(a, lds, tid, lane, w); }
    PH_END(0);
    SEAM(0);
#ifdef EXTRA_SYNCS
    if (coop) for (int es_ = 0; es_ < EXTRA_SYNCS; ++es_) grid.sync();
#endif
    PH_BEGIN(1);
    if (IN(1)) REP(1) { pg8::Gemm g{XN, (const bf16*)(a.ws + WS_W1T), MROWS, 2560, 1024}; pg8::StaticOrder S; S.init(MROWS, 2560, gridDim.x, blockIdx.x);
        EpiQKVG E{BIG, a.out}; pg8::gemm_phase<EpiQKVG, pg8::StaticOrder, true, true>(lds, g, S, E); }
    PH_END(1);
    SEAM(1);
    PH_BEGIN(2);
    if (IN(2)) REP(2) { attn_phase(lds, BIG, a.in[2], a.in[3], a.in[9], OG, tid, lane, w); }
    PH_END(2);
    SEAM(2);
    PH_BEGIN(3);
    if (IN(3)) { pg8::Gemm g{OG, (const bf16*)(a.ws + WS_WO1T), MROWS, 1024, 1024}; pg8::StaticOrder S; S.init(MROWS, 1024, gridDim.x, blockIdx.x);
        EpiRes E{a.in[0], a.in[1], nullptr, XN, a.in[6] + 1024, ss1, nullptr, (bf16*)a.out};     pg8::gemm_phase<EpiRes, pg8::StaticOrder, true, true>(lds, g, S, E); }
    PH_END(3);
    SEAM(3);
    PH_BEGIN(4);
    if (IN(4)) REP(4) { pg8::Gemm g{XN, (const bf16*)(a.ws + WS_W2T), MROWS, 4352, 1024}; pg8::StaticOrder S; S.init(MROWS, 4352, gridDim.x, blockIdx.x);
        EpiDN E{BIG, (bf16*)(a.ws + WS_HALO), (float*)(a.ws + WS_BA), ss1, a.out, a.in[15]}; pg8::gemm_phase<EpiDN, pg8::StaticOrder, true, true>(lds, g, S, E); }
    PH_END(4);
    SEAM(4);
    PH_BEGIN(5);
    if (IN(5)) { dn_pre_phase(a, lane, w); }
    PH_END(5);
    SEAM(5);
    PH_BEGIN(6);
    if (IN(6)) REP(6) { dn_prep_phase(a, lds, lane, w); }
    PH_END(6);
    SEAM(6);
    PH_BEGIN(7);
    if (IN(7)) {
        if (blockIdx.x < 64) dn_scan_phase(a, lds, tid, lane, w, xbar, (int)blockIdx.x, 64, true, 256);
        else {
            dn_scan_phase(a, lds, tid, lane, w, xbar, (int)blockIdx.x, 320, false, 192);
            xcd_barrier(xbar);
            if (blockIdx.x >= 240) { pg8::Gemm g{OG, (const bf16*)(a.ws + WS_WO2T), MROWS, 1024, 1024}; SampleOrder S{(int)blockIdx.x - 240};
                EpiRes E{a.in[0], nullptr, nullptr, XN, a.in[7], ss2, (const bf16*)a.out, nullptr}; pg8::gemm_phase<EpiRes, SampleOrder, true, true>(lds, g, S, E); }
        }
    }
    PH_END(7);
    SEAM(7);
    PH_BEGIN(8);
    if (IN(8)) { pg8::Gemm g{OG, (const bf16*)(a.ws + WS_WO2T), MP, 1024, 1024}; pg8::StaticOrder S; S.init(MP, 1024, gridDim.x, blockIdx.x);
        EpiRes E{a.in[0], nullptr, nullptr, XN, a.in[7], ss2, (const bf16*)a.out, nullptr}; pg8::gemm_phase<EpiRes, pg8::StaticOrder, true, true>(lds, g, S, E); }
    PH_END(8);
    SEAM(8);
    PH_BEGIN(9);
    if (IN(9)) { final_norm_phase(a, lane, w); }
    PH_END(9);
#undef IN
#undef SEAM
}

#ifndef MULTI_LAUNCH
#define MULTI_LAUNCH 0
#endif
extern "C" void kernel_launch(void* const* d_in, const int* in_sizes, int n_in, void* d_out, int out_size, void* d_ws, size_t ws_size, hipStream_t stream) {
    static int grid = 0;
    if (grid == 0) {
        int dev = 0, cus = 0, per_cu = 0;
        if (n_in != 17 || ws_size < WS_END) { fprintf(stderr, "kernel_launch: unexpected n_in %d / ws_size %zu\n", n_in, ws_size); grid = -1; return; }
        if (hipGetDevice(&dev) != hipSuccess || hipDeviceGetAttribute(&cus, hipDeviceAttributeMultiprocessorCount, dev) != hipSuccess) { grid = -1; return; }
        if (hipFuncSetAttribute((const void*)mega_fwd, hipFuncAttributeMaxDynamicSharedMemorySize, LDS_BYTES) != hipSuccess) { fprintf(stderr, "kernel_launch: hipFuncSetAttribute failed\n"); grid = -1; return; }
        if (hipOccupancyMaxActiveBlocksPerMultiprocessor(&per_cu, (const void*)mega_fwd, 512, LDS_BYTES) != hipSuccess || per_cu < 1) { fprintf(stderr, "kernel_launch: occupancy query gave %d\n", per_cu); per_cu = 1; }
        (void)hipGetLastError();
        grid = cus * (per_cu > 1 ? 1 : per_cu);
        if (grid < 64) grid = 64;
    }
    if (grid < 0) return;
    Args a{};
    for (int i = 0; i < 17; ++i) a.in[i] = (const float*)d_in[i];
    a.out = (float*)d_out; a.ws = (unsigned char*)d_ws;
#if MULTI_LAUNCH
    for (int p = 0; p < N_PHASES; ++p) { int lo = p, hi = p + 1, coop = 0; hipLaunchKernelGGL(mega_fwd, dim3(grid), dim3(512), LDS_BYTES, stream, a, lo, hi, coop); }
#else
    if (hipMemsetAsync(d_ws, 0, 16384, stream) != hipSuccess) { fprintf(stderr, "kernel_launch: memset of the barrier words failed\n"); return; }
    int lo = 0, hi = N_PHASES, coop = 1;
    void* args[] = {&a, &lo, &hi, &coop};
    hipError_t e = hipLaunchCooperativeKernel((const void*)mega_fwd, dim3(grid), dim3(512), args, LDS_BYTES, stream);
    if (e != hipSuccess) fprintf(stderr, "kernel_launch: cooperative launch failed: %s (grid %d)\n", hipGetErrorString(e), grid);
#endif
}
```

```cpp
#include <hip/hip_runtime.h>
#include <hip/hip_cooperative_groups.h>
#include <cstdio>
#include <cstdint>
namespace cg = cooperative_groups;
namespace pg8 {
#define PG8_LAS __attribute__((address_space(3)))
typedef unsigned short bf16_t;
typedef short bf16x8 __attribute__((ext_vector_type(8)));
typedef float f32x4 __attribute__((ext_vector_type(4)));
typedef unsigned u32x4 __attribute__((ext_vector_type(4)));
constexpr int BM = 256, BK = 64, HALF = 128, HTB = HALF * BK * 2  , STAGE_BYTES = 8 * HTB, NXCD = 8, WGM = 8;

__host__ __device__ __forceinline__ int lds_byte(int r, int c) { const int st = (r >> 4) * 2 + (c >> 5), rr = r & 15, cc = c & 31, ob = rr * 64 + cc * 2; return st * 1024 + (ob ^ (((ob >> 9) & 1) << 5)); }
__host__ __device__ __forceinline__ void stage_rc(int b, int& R, int& C) { const int st = b / 1024, sb = b % 1024, swz = sb ^ (((sb >> 9) & 1) << 5); R = (st >> 1) * 16 + swz / 64; C = (st & 1) * 32 + (swz % 64) / 2; }
__host__ __device__ __forceinline__ int perm32(int rho) { const int n = rho >> 4, i = rho & 15; return 8 * (i >> 2) + 4 * n + (i & 3); }

struct Unit { int pm, pn; };
struct Gemm { const bf16_t* A; const bf16_t* Bt; int M, N, K; };

struct StaticOrder {
    int nM, nN, nwg, G, c;
    __host__ __device__ void init(int M, int N, int G_, int c_) { nM = M / BM; nN = N / BM; nwg = nM * nN; G = G_; c = c_; }
    __host__ __device__ bool next(int i, Unit& u) const {
        const long L = (long)i * G + c; if (L >= nwg) return false;
        int wgid = (int)L; { const int q = nwg / NXCD, r = nwg % NXCD, xcd = wgid % NXCD, off = wgid / NXCD; wgid = (xcd < r ? xcd * (q + 1) : r * (q + 1) + (xcd - r) * q) + off; }
        const int nig = WGM * nN, gid = wgid / nig, fm = gid * WGM, gsz = (nM - fm) < WGM ? (nM - fm) : WGM;
        u.pm = fm + ((wgid % nig) % gsz); u.pn = (wgid % nig) / gsz; return true;
    }
    __device__ __forceinline__ void a_ready(const Unit&) const {}
    __device__ __forceinline__ void done(const Unit&) const {}
};

__device__ __forceinline__ unsigned cvt_pk_bf16(float lo, float hi) { unsigned r; asm volatile("v_cvt_pk_bf16_f32 %0, %1, %2" : "=v"(r) : "v"(lo), "v"(hi)); return r; }

template <class Epi, class Sched, bool ALIGN_EPI = false, bool SP2 = false>
__device__ __forceinline__ void gemm_phase(PG8_LAS unsigned char* lds, const Gemm g, const Sched& S, const Epi& E) {
    const int tid = threadIdx.x, wid = __builtin_amdgcn_readfirstlane(tid >> 6), lane = tid & 63, wr = wid >> 2, wc = wid & 3, fr = lane & 15, fq = lane >> 4;
    const int K = g.K, nt = K / BK;
    unsigned voffA[2], voffB[2];
#pragma unroll
    for (int i = 0; i < 2; ++i) { int R, C; stage_rc(tid * 16 + i * 8192, R, C); const int Rb = Epi::PERM ? ((R & ~31) + perm32(R & 31)) : R;
        voffA[i] = (unsigned)(R * K + C) * 2u; voffB[i] = (unsigned)(Rb * K + C) * 2u; }
    const size_t kstep = (size_t)(BK * 2);
    const size_t hstep = (size_t)HALF * K * 2;
    const size_t tstep = 2 * hstep;
    const unsigned ldsw = (unsigned)wid * 1024u;
    const int aoff = lds_byte(wr * 64 + fr, fq * 8), boff = lds_byte(wc * 32 + fr, fq * 8);
#define PG8_SA(b, h) (((b) * 2 + (h)) * HTB)
#define PG8_SB(b, h) ((4 + (b) * 2 + (h)) * HTB)
#define PG8_STAGE(bufoff, gbase, voff) do { _Pragma("unroll") for (int _i = 0; _i < 2; ++_i) \
        __builtin_amdgcn_global_load_lds((const unsigned*)((const char*)(gbase) + (voff)[_i]), (PG8_LAS unsigned*)(lds + (bufoff) + ldsw + _i * 8192), 16, 0, 0); } while (0)
#define PG8_LDA(dst, b, h) do { _Pragma("unroll") for (int m = 0; m < 4; ++m) _Pragma("unroll") for (int k = 0; k < 2; ++k) dst[m][k] = *(const PG8_LAS bf16x8*)(lds + PG8_SA(b, h) + aoff + m * 2048 + k * 1024); } while (0)
#define PG8_LDB(dst, b, h) do { _Pragma("unroll") for (int n = 0; n < 2; ++n) _Pragma("unroll") for (int k = 0; k < 2; ++k) dst[n][k] = *(const PG8_LAS bf16x8*)(lds + PG8_SB(b, h) + boff + n * 2048 + k * 1024); } while (0)
#define PG8_MMA(ai, bj, At, Bt) do { __builtin_amdgcn_s_setprio(1); _Pragma("unroll") for (int m = 0; m < 4; ++m) _Pragma("unroll") for (int n = 0; n < 2; ++n) _Pragma("unroll") for (int k = 0; k < 2; ++k) \
        acc[ai][bj][m][n] = __builtin_amdgcn_mfma_f32_16x16x32_bf16(Bt[n][k], At[m][k], acc[ai][bj][m][n], 0, 0, 0); __builtin_amdgcn_s_setprio(0); } while (0)
#define PG8_WAIT_V(n) asm volatile("s_waitcnt vmcnt(" #n ")" ::: "memory")
#define PG8_WAIT_L(n) asm volatile("s_waitcnt lgkmcnt(" #n ")" ::: "memory")
#define PG8_BAR __builtin_amdgcn_s_barrier()
#define PG8_SCHED __builtin_amdgcn_sched_barrier(0)
    Unit cur, nxt; int ui = 0;
    if (!S.next(0, cur)) return;
    f32x4 acc[2][2][4][2];
#pragma unroll
    for (int a = 0; a < 2; ++a)
#pragma unroll
        for (int b = 0; b < 2; ++b)
#pragma unroll
            for (int m = 0; m < 4; ++m)
#pragma unroll
                for (int n = 0; n < 2; ++n) acc[a][b][m][n] = (f32x4){0.f, 0.f, 0.f, 0.f};
    bf16x8 At[4][2], B0[2][2], B1[2][2];
    const char* cA = (const char*)g.A + (size_t)cur.pm * tstep; const char* cB = (const char*)g.Bt + (size_t)cur.pn * tstep;
    S.a_ready(cur);
    if constexpr (SP2) {
        PG8_STAGE(PG8_SB(0, 0), cB, voffB); PG8_STAGE(PG8_SB(0, 1), cB + hstep, voffB); PG8_STAGE(PG8_SA(0, 0), cA, voffA); PG8_STAGE(PG8_SA(0, 1), cA + hstep, voffA);
        if (wr == 1) PG8_BAR;
        PG8_WAIT_V(2); PG8_BAR;
        PG8_STAGE(PG8_SB(1, 0), cB + kstep, voffB); PG8_STAGE(PG8_SA(1, 0), cA + kstep, voffA); PG8_STAGE(PG8_SB(1, 1), cB + hstep + kstep, voffB);
        PG8_WAIT_V(6); PG8_BAR;
    } else {
        PG8_STAGE(PG8_SB(0, 0), cB, voffB); PG8_STAGE(PG8_SA(0, 0), cA, voffA); PG8_STAGE(PG8_SB(0, 1), cB + hstep, voffB); PG8_STAGE(PG8_SA(0, 1), cA + hstep, voffA);
        if (wr == 1) PG8_BAR;
        PG8_WAIT_V(4); PG8_BAR;
        PG8_STAGE(PG8_SB(1, 0), cB + kstep, voffB); PG8_STAGE(PG8_SA(1, 0), cA + kstep, voffA); PG8_STAGE(PG8_SB(1, 1), cB + hstep + kstep, voffB);
        PG8_WAIT_V(6); PG8_BAR;
    }
    for (;;) {
        const bool has_next = S.next(ui + 1, nxt);
        const char* nA = has_next ? (const char*)g.A + (size_t)nxt.pm * tstep : cA; const char* nB = has_next ? (const char*)g.Bt + (size_t)nxt.pn * tstep : cB;
        for (int t = 0; t < nt; t += 2) {
            const bool last = (t == nt - 2);
            const char* a1 = cA + (size_t)(t + 1) * kstep;
            const char* a2 = last ? nA : cA + (size_t)(t + 2) * kstep; const char* b2 = last ? nB : cB + (size_t)(t + 2) * kstep;
            const char* a3 = a2 + kstep; const char* b3 = b2 + kstep;
            if (last && has_next) S.a_ready(nxt);
            if constexpr (SP2) {
            PG8_LDB(B0, 0, 0); PG8_LDB(B1, 0, 1); PG8_SCHED; PG8_LDA(At, 0, 0); PG8_STAGE(PG8_SA(1, 1), a1 + hstep, voffA);
            PG8_WAIT_V(8); PG8_WAIT_L(0); PG8_BAR; PG8_MMA(0, 0, At, B0); PG8_MMA(0, 1, At, B1); PG8_BAR; PG8_SCHED;
            PG8_LDA(At, 0, 1); PG8_STAGE(PG8_SB(0, 0), b2, voffB); PG8_STAGE(PG8_SB(0, 1), b2 + hstep, voffB); PG8_STAGE(PG8_SA(0, 0), a2, voffA);
            PG8_WAIT_V(8); PG8_WAIT_L(0); PG8_BAR; PG8_MMA(1, 0, At, B0); PG8_MMA(1, 1, At, B1); PG8_BAR; PG8_SCHED;
            PG8_LDB(B0, 1, 0); PG8_LDB(B1, 1, 1); PG8_SCHED; PG8_LDA(At, 1, 0); PG8_STAGE(PG8_SA(0, 1), a2 + hstep, voffA);
            PG8_WAIT_V(8); PG8_WAIT_L(0); PG8_BAR; PG8_MMA(0, 0, At, B0); PG8_MMA(0, 1, At, B1); PG8_BAR; PG8_SCHED;
            PG8_LDA(At, 1, 1); PG8_STAGE(PG8_SB(1, 0), b3, voffB); PG8_STAGE(PG8_SB(1, 1), b3 + hstep, voffB); PG8_STAGE(PG8_SA(1, 0), a3, voffA);
            PG8_WAIT_V(8); PG8_WAIT_L(0); PG8_BAR; PG8_MMA(1, 0, At, B0); PG8_MMA(1, 1, At, B1); PG8_BAR; PG8_SCHED;
            } else {
            PG8_LDB(B0, 0, 0); PG8_SCHED; PG8_LDA(At, 0, 0); PG8_STAGE(PG8_SA(1, 1), a1 + hstep, voffA);
            PG8_WAIT_L(8); PG8_BAR; PG8_WAIT_L(0); PG8_MMA(0, 0, At, B0); PG8_BAR; PG8_SCHED;
            PG8_LDB(B1, 0, 1); PG8_STAGE(PG8_SB(0, 0), b2, voffB);
            PG8_BAR; PG8_WAIT_L(0); PG8_MMA(0, 1, At, B1); PG8_BAR;
            PG8_LDA(At, 0, 1); PG8_STAGE(PG8_SA(0, 0), a2, voffA);
            PG8_BAR; PG8_WAIT_L(0); PG8_MMA(1, 0, At, B0); PG8_BAR; PG8_SCHED;
            PG8_STAGE(PG8_SB(0, 1), b2 + hstep, voffB);
            PG8_WAIT_V(6); PG8_BAR; PG8_MMA(1, 1, At, B1); PG8_BAR;
            PG8_LDB(B0, 1, 0); PG8_SCHED; PG8_LDA(At, 1, 0); PG8_STAGE(PG8_SA(0, 1), a2 + hstep, voffA);
            PG8_WAIT_L(8); PG8_BAR; PG8_WAIT_L(0); PG8_MMA(0, 0, At, B0); PG8_BAR; PG8_SCHED;
            PG8_LDB(B1, 1, 1); PG8_STAGE(PG8_SB(1, 0), b3, voffB);
            PG8_BAR; PG8_WAIT_L(0); PG8_MMA(0, 1, At, B1); PG8_BAR;
            PG8_LDA(At, 1, 1); PG8_STAGE(PG8_SA(1, 0), a3, voffA);
            PG8_BAR; PG8_WAIT_L(0); PG8_MMA(1, 0, At, B0); PG8_BAR; PG8_SCHED;
            PG8_STAGE(PG8_SB(1, 1), b3 + hstep, voffB);
            PG8_WAIT_V(6); PG8_BAR; PG8_MMA(1, 1, At, B1); PG8_BAR;
            }
        }
        if constexpr (ALIGN_EPI) { if (wr == 0) PG8_BAR; }
        if constexpr (!Epi::AFTER_DRAIN) { E(acc, cur, wr, wc, fr, fq); S.done(cur); }
        if (!has_next) break;
#pragma unroll
        for (int a = 0; a < 2; ++a)
#pragma unroll
            for (int b = 0; b < 2; ++b)
#pragma unroll
                for (int m = 0; m < 4; ++m)
#pragma unroll
                    for (int n = 0; n < 2; ++n) acc[a][b][m][n] = (f32x4){0.f, 0.f, 0.f, 0.f};
        cur = nxt; cA = nA; cB = nB; ++ui;
        if constexpr (ALIGN_EPI) { if (wr == 1) PG8_BAR; }
    }
    PG8_WAIT_V(0);
    if constexpr (!ALIGN_EPI) { if (wr == 0) PG8_BAR; }
    PG8_BAR;
    if constexpr (Epi::AFTER_DRAIN) { E.fused(acc, cur, wr, wc, fr, fq, lds, wid, lane); S.done(cur); }
#undef PG8_SA
#undef PG8_SB
#undef PG8_STAGE
#undef PG8_LDA
#undef PG8_LDB
#undef PG8_MMA
#undef PG8_WAIT_V
#undef PG8_WAIT_L
#undef PG8_BAR
#undef PG8_SCHED
}
}


#define LAS __attribute__((address_space(3)))
typedef unsigned short bf16;
typedef short bf16x8 __attribute__((ext_vector_type(8)));
typedef float f32x4 __attribute__((ext_vector_type(4)));
typedef float f32x16 __attribute__((ext_vector_type(16)));
typedef unsigned u32x4 __attribute__((ext_vector_type(4)));
typedef unsigned u32x2 __attribute__((ext_vector_type(2)));
typedef __bf16 bf16x2_t __attribute__((ext_vector_type(2)));
typedef float f32x2_t __attribute__((ext_vector_type(2)));
#define MFMA32(a, b, c) __builtin_amdgcn_mfma_f32_32x32x16_bf16((a), (b), (c), 0, 0, 0)
#define MFMA16(a, b, c) __builtin_amdgcn_mfma_f32_16x16x32_bf16((a), (b), (c), 0, 0, 0)
#define DI __device__ __forceinline__
#define LDS_BARRIER() do { asm volatile("s_waitcnt lgkmcnt(0)" ::: "memory"); __builtin_amdgcn_s_barrier(); asm volatile("" ::: "memory"); } while (0)

constexpr int DM = 1024, MROWS = 33792, MP = 32768;
constexpr float EPS = 1e-6f;
constexpr float LOG2E = 1.4426950408889634f;
constexpr float QSCALE = 0.125f * LOG2E;
constexpr size_t O_KWP = 34603008, O_VWP = 34865152, O_CONVP = 35127296, O_SSMP = 35201024, O_KWS = 36249600, O_VWS = 37298176, O_CONVS = 38346752, O_SSMS = 38641664;
constexpr size_t MiB = 1u << 20;
constexpr size_t WS_W1T = 1 * MiB, WS_WO1T = 6 * MiB, WS_W2T = 8 * MiB, WS_WO2T = 17 * MiB, WS_BA = 19 * MiB, WS_SS1 = 22 * MiB, WS_SS2 = 22 * MiB + 512 * 1024,
                 WS_HALO = 23 * MiB, WS_SCAL = 33 * MiB, WS_XN = 40 * MiB  , WS_BIG = 110 * MiB  , WS_OG = 374 * MiB, WS_KT = 440 * MiB, WS_END = 508 * MiB;
constexpr int LDS_BYTES = 143360;

DI unsigned pk2(float lo, float hi) { f32x2_t v = {lo, hi}; bf16x2_t b = __builtin_convertvector(v, bf16x2_t); return __builtin_bit_cast(unsigned, b); }
DI float bflo(unsigned u) { return __builtin_bit_cast(float, u << 16); }
DI float bfhi(unsigned u) { return __builtin_bit_cast(float, u & 0xffff0000u); }
DI float bf2f(bf16 u) { return __builtin_bit_cast(float, (unsigned)u << 16); }
DI bf16 f2bf(float f) { return (bf16)(pk2(f, 0.f) & 0xffffu); }
DI int crow(int i, int h) { return (i & 3) + 8 * (i >> 2) + 4 * h; }
DI float fexp2(float x) { return __builtin_amdgcn_exp2f(x); }
DI float silu(float x) { return x * __builtin_amdgcn_rcpf(1.f + __builtin_amdgcn_exp2f(-1.4426950408889634f * x)); }
DI float frsq(float x) { return __builtin_amdgcn_rsqf(x); }
DI float wave_sum(float v) {
#pragma unroll
    for (int o = 1; o < 64; o <<= 1) v += __shfl_xor(v, o);
    return v;
}
DI u32x4 pack8f(const float* p) { u32x4 r; r.x = pk2(p[0], p[1]); r.y = pk2(p[2], p[3]); r.z = pk2(p[4], p[5]); r.w = pk2(p[6], p[7]); return r; }
DI u32x4 ld8f_bf(const float* p) { const f32x4 a = *(const f32x4*)p, b = *(const f32x4*)(p + 4); u32x4 r; r.x = pk2(a.x, a.y); r.y = pk2(a.z, a.w); r.z = pk2(b.x, b.y); r.w = pk2(b.z, b.w); return r; }

#define XB_TMO      128
#define XB_XCNT(j)  (256  + 64 * (j))
#define XB_XSUB(j)  (1280 + 64 * (j))
#define XB_XGEN(j)  (2304 + 64 * (j))
#define XB_TOP      3328
#define XB_TOPGEN   3392
#define XCD_BAR_WORDS 3456
#define XB_SPIN_CAP (1u << 18)

__device__ __forceinline__ unsigned xb_ld(unsigned* p)              { return __hip_atomic_load(p, __ATOMIC_RELAXED, __HIP_MEMORY_SCOPE_AGENT); }
__device__ __forceinline__ unsigned xb_add(unsigned* p, unsigned v) { return __hip_atomic_fetch_add(p, v, __ATOMIC_RELAXED, __HIP_MEMORY_SCOPE_AGENT); }
__device__ __forceinline__ unsigned xb_xcc_id() { return (unsigned)__builtin_amdgcn_s_getreg((3 << 11) | 20) & 0xFu; }
#define XB_SPIN(cond, bar) do { unsigned _sp = 0; while (cond) { __builtin_amdgcn_s_sleep(1); \
    if ((++_sp & 255u) == 0u) { if (xb_ld(&(bar)[XB_TMO])) break; if (_sp > XB_SPIN_CAP) { atomicAdd(&(bar)[XB_TMO], 1u); break; } } } } while (0)

struct XcdBarrier {
    unsigned* bar; unsigned x;
    volatile LAS unsigned* st;
};

__device__ __forceinline__ XcdBarrier xcd_barrier_post(unsigned* bar, volatile LAS unsigned* st) {
    XcdBarrier b; b.bar = bar; b.x = xb_xcc_id(); b.st = st;
    if (threadIdx.x == 0) (void)xb_add(&bar[XB_XCNT(b.x)], 1u);
    return b;
}
__device__ __forceinline__ void xcd_barrier_complete(unsigned* bar, unsigned x, unsigned& nloc, unsigned& nx) {
    const unsigned G = gridDim.x * gridDim.y * gridDim.z;
    unsigned sum, cnt, mine, sp = 0u;
    for (;;) {
        sum = 0u; cnt = 0u; mine = 0u;
#pragma unroll
        for (unsigned j = 0; j < 16; ++j) { const unsigned c = xb_ld(&bar[XB_XCNT(j)]); sum += c; cnt += (c > 0u) ? 1u : 0u; mine = (j == x) ? c : mine; }
        if (sum == G) break;
        __builtin_amdgcn_s_sleep(1);
        if ((++sp & 255u) == 0u) { if (xb_ld(&bar[XB_TMO])) break; if (sp > XB_SPIN_CAP) { atomicAdd(&bar[XB_TMO], 1u); break; } }
    }
    nloc = mine > 0u ? mine : 1u; nx = cnt > 0u ? cnt : 1u;
}

__device__ __forceinline__ void xcd_barrier(const XcdBarrier& b) {
    asm volatile("s_waitcnt vmcnt(0)" ::: "memory");
    __syncthreads();
    if (threadIdx.x == 0) {
        unsigned* bar = b.bar;
        __builtin_amdgcn_s_waitcnt(0);
        unsigned nloc = b.st[0], nx = b.st[1];
        if (nloc == 0u) { xcd_barrier_complete(bar, b.x, nloc, nx); b.st[0] = nloc; b.st[1] = nx; }
        const unsigned old = xb_add(&bar[XB_XSUB(b.x)], 1u);
        const unsigned gen = old / nloc;
        if (old + 1u == (gen + 1u) * nloc) {
            __builtin_amdgcn_fence(__ATOMIC_RELEASE, "agent");
            asm volatile("s_waitcnt vmcnt(0)" ::: "memory");
            const unsigned og = xb_add(&bar[XB_TOP], 1u);
            const unsigned tg = og / nx;
            if (og + 1u == (tg + 1u) * nx) xb_add(&bar[XB_TOPGEN], 1u);
            else XB_SPIN(xb_ld(&bar[XB_TOPGEN]) == tg, bar);
            __builtin_amdgcn_fence(__ATOMIC_ACQUIRE, "agent");
            xb_add(&bar[XB_XGEN(b.x)], 1u);
            asm volatile("s_waitcnt vmcnt(0)" ::: "memory");
        } else {
            XB_SPIN(xb_ld(&bar[XB_XGEN(b.x)]) == gen, bar);
            __builtin_amdgcn_fence(__ATOMIC_ACQUIRE, "agent");
            asm volatile("s_waitcnt vmcnt(0)" ::: "memory");
        }
    }
    __syncthreads();
#undef ATT_LOAD
#undef ATT_DECODE
}

struct EpiQKVG {
    static constexpr bool PERM = true, AFTER_DRAIN = false;
    bf16* O; float* dout;
    DI void operator()(const pg8::f32x4 (&acc)[2][2][4][2], const pg8::Unit& u, int wr, int wc, int fr, int fq) const {
        const float sc = (u.pn < 4) ? QSCALE : 1.f;
        const bool kv = (u.pn == 4 || u.pn == 5);
#pragma unroll
        for (int ai = 0; ai < 2; ++ai)
#pragma unroll
            for (int m = 0; m < 4; ++m) {
                const int row = u.pm * 256 + ai * 128 + wr * 64 + m * 16 + fr;
                float* wdst = nullptr;
                if (kv) {
                    if (row < MP) { const int t = row & 4095; if (t >= 3968) wdst = dout + (u.pn == 4 ? O_KWP : O_VWP) + ((size_t)((row >> 12) * 128 + (t - 3968))) * 256; }
                    else { const int s = row - MP; wdst = dout + (u.pn == 4 ? O_KWS : O_VWS) + ((size_t)((s >> 5) * 128 + 96 + (s & 31))) * 256; }
                }
#pragma unroll
                for (int bj = 0; bj < 2; ++bj) {
                    const int cin = bj * 128 + wc * 32 + 8 * fq;
                    const f32x4 v0 = acc[ai][bj][m][0] * sc, v1 = acc[ai][bj][m][1] * sc;
                    u32x4 w; w.x = pk2(v0[0], v0[1]); w.y = pk2(v0[2], v0[3]); w.z = pk2(v1[0], v1[1]); w.w = pk2(v1[2], v1[3]);
                    *(u32x4*)(O + (size_t)row * 2560 + u.pn * 256 + cin) = w;
                    if (wdst) { *(f32x4*)(wdst + cin) = v0; *(f32x4*)(wdst + cin + 4) = v1; }
                }
            }
    }
};

struct EpiRes {
    static constexpr bool PERM = true, AFTER_DRAIN = false;
    const float* xp; const float* xs; float* y; bf16* XN; const float* g; float* ss; const bf16* xb; bf16* yb;
    DI void operator()(const pg8::f32x4 (&acc)[2][2][4][2], const pg8::Unit& u, int wr, int wc, int fr, int fq) const {
#pragma unroll
        for (int ai = 0; ai < 2; ++ai)
#pragma unroll
            for (int m = 0; m < 4; ++m) {
                const int row = u.pm * 256 + ai * 128 + wr * 64 + m * 16 + fr;
                const float* xr = (row < MP || xs == nullptr) ? xp + (size_t)row * DM : xs + (size_t)(row - MP) * DM;
                float s = 0.f;
#pragma unroll
                for (int bj = 0; bj < 2; ++bj) {
                    const int col = u.pn * 256 + bj * 128 + wc * 32 + 8 * fq;
                    f32x4 a0, a1;
                    if (xb) { const u32x4 xv = *(const u32x4*)(xb + (size_t)row * DM + col); a0 = (f32x4){bflo(xv.x), bfhi(xv.x), bflo(xv.y), bfhi(xv.y)}; a1 = (f32x4){bflo(xv.z), bfhi(xv.z), bflo(xv.w), bfhi(xv.w)}; }
                    else { a0 = *(const f32x4*)(xr + col); a1 = *(const f32x4*)(xr + col + 4); }
                    const f32x4 v0 = acc[ai][bj][m][0] + a0, v1 = acc[ai][bj][m][1] + a1;
                    if (y) { *(f32x4*)(y + (size_t)row * DM + col) = v0; *(f32x4*)(y + (size_t)row * DM + col + 4) = v1; }
                    if (yb) { u32x4 w; w.x = pk2(v0[0], v0[1]); w.y = pk2(v0[2], v0[3]); w.z = pk2(v1[0], v1[1]); w.w = pk2(v1[2], v1[3]); *(u32x4*)(yb + (size_t)row * DM + col) = w; }
                    s += (v0[0] * v0[0] + v0[1] * v0[1]) + (v0[2] * v0[2] + v0[3] * v0[3]) + (v1[0] * v1[0] + v1[1] * v1[1]) + (v1[2] * v1[2] + v1[3] * v1[3]);
                    if (XN) {
                        const f32x4 g0 = *(const f32x4*)(g + col), g1 = *(const f32x4*)(g + col + 4);
                        u32x4 w; w.x = pk2(v0[0] * g0[0], v0[1] * g0[1]); w.y = pk2(v0[2] * g0[2], v0[3] * g0[3]); w.z = pk2(v1[0] * g1[0], v1[1] * g1[1]); w.w = pk2(v1[2] * g1[2], v1[3] * g1[3]);
                        *(u32x4*)(XN + (size_t)row * DM + col) = w;
                    }
                }
                s += __shfl_xor(s, 16); s += __shfl_xor(s, 32);
                if (fq == 0) atomicAdd(ss + row, s);
            }
    }
};

struct EpiDN {
    static constexpr bool PERM = true, AFTER_DRAIN = false;
    bf16* O; bf16* halo; float* ba; const float* ss; float* dout; const float* ng;
    DI void operator()(const pg8::f32x4 (&acc)[2][2][4][2], const pg8::Unit& u, int wr, int wc, int fr, int fq) const {
#pragma unroll
        for (int ai = 0; ai < 2; ++ai)
#pragma unroll
            for (int m = 0; m < 4; ++m) {
                const int row = u.pm * 256 + ai * 128 + wr * 64 + m * 16 + fr;
                const float sc = rsqrtf(ss[row] * (1.f / DM) + EPS);
                if (u.pn < 16) {
                    bf16* hdst = nullptr; float* cdst = nullptr;
                    if (u.pn < 12) {
                        if (row < MP) { const int t = row & 63; if (t >= 61) hdst = halo + ((size_t)(row >> 6) * 3 + (t - 61)) * 3072;
                                        const int t4 = row & 4095; if (t4 >= 4093) cdst = dout + O_CONVP + ((size_t)(row >> 12) * 3 + (t4 - 4093)) * 3072; }
                        else { const int s = row - MP, t = s & 31; if (t >= 29) cdst = dout + O_CONVS + ((size_t)(s >> 5) * 3 + (t - 29)) * 3072; }
                    }
#pragma unroll
                    for (int bj = 0; bj < 2; ++bj) {
                        const int col = u.pn * 256 + bj * 128 + wc * 32 + 8 * fq;
                        f32x4 v0 = acc[ai][bj][m][0] * sc, v1 = acc[ai][bj][m][1] * sc;
                        if (u.pn >= 12) {
                            const f32x4 g0 = *(const f32x4*)(ng + (col & 127)), g1 = *(const f32x4*)(ng + (col & 127) + 4);
#pragma unroll
                            for (int e = 0; e < 4; ++e) { v0[e] = silu(v0[e]) * g0[e]; v1[e] = silu(v1[e]) * g1[e]; }
                        }
                        u32x4 w; w.x = pk2(v0[0], v0[1]); w.y = pk2(v0[2], v0[3]); w.z = pk2(v1[0], v1[1]); w.w = pk2(v1[2], v1[3]);
                        *(u32x4*)(O + (size_t)row * 4096 + col) = w;
                        if (hdst) *(u32x4*)(hdst + col) = w;
                        if (cdst) { *(f32x4*)(cdst + col) = v0; *(f32x4*)(cdst + col + 4) = v1; }
                    }
                } else if (wc == 0 && fq < 2) {
                    const f32x4 v0 = acc[ai][0][m][0] * sc, v1 = acc[ai][0][m][1] * sc;
                    *(f32x4*)(ba + (size_t)row * 16 + 8 * fq) = v0; *(f32x4*)(ba + (size_t)row * 16 + 8 * fq + 4) = v1;
                }
            }
    }
};

DI void p0_transpose_item(const float* W, int K, int ld, int nblk, bf16* WT, LAS float* scr, int item, int lane) {
    const int kb = item / nblk, nb = item % nblk, k0 = 64 * kb, n0 = 32 * nb;
#pragma unroll 8
    for (int i = 0; i < 32; ++i) { const int kk = 2 * i + (lane >> 5); scr[kk * 33 + (lane & 31)] = W[(size_t)(k0 + kk) * ld + n0 + (lane & 31)]; }
    asm volatile("s_waitcnt lgkmcnt(0)" ::: "memory");
    const int c = lane & 7;
#pragma unroll
    for (int j = 0; j < 4; ++j) { const int n = (lane >> 3) + 8 * j; const LAS float* s = scr + (8 * c) * 33 + n;
        u32x4 o; o.x = pk2(s[0 * 33], s[1 * 33]); o.y = pk2(s[2 * 33], s[3 * 33]); o.z = pk2(s[4 * 33], s[5 * 33]); o.w = pk2(s[6 * 33], s[7 * 33]);
        *(u32x4*)(WT + (size_t)(n0 + n) * K + k0 + 8 * c) = o; }
    asm volatile("s_waitcnt lgkmcnt(0)" ::: "memory");
}

struct Args { const float* in[17]; float* out; unsigned char* ws; };

DI void p0_prologue(const Args& a, LAS unsigned char* lds, int tid, int lane, int w) {
    LAS float* scr = (LAS float*)(lds + w * 16384);
    const int gw = blockIdx.x * 8 + w, NGW = gridDim.x * 8;
    const float* W1 = a.in[8]; const float* Wo1 = a.in[10]; const float* W2 = a.in[11]; const float* Wo2 = a.in[16];
    bf16* W1T = (bf16*)(a.ws + WS_W1T); bf16* WO1T = (bf16*)(a.ws + WS_WO1T); bf16* W2T = (bf16*)(a.ws + WS_W2T); bf16* WO2T = (bf16*)(a.ws + WS_WO2T);
    constexpr int I1 = 16 * 80, I2 = 16 * 32, I3 = 16 * 128, I4 = 16 * 32;
    for (int it = gw; it < I1 + I2 + I3 + I4; it += NGW) {
        int r = it;
        if (r < I1) { p0_transpose_item(W1, 1024, 2560, 80, W1T, scr, r, lane); continue; } r -= I1;
        if (r < I2) { p0_transpose_item(Wo1, 1024, 1024, 32, WO1T, scr, r, lane); continue; } r -= I2;
        if (r < I3) { p0_transpose_item(W2, 1024, 4112, 128, W2T, scr, r, lane); continue; } r -= I3;
        p0_transpose_item(Wo2, 1024, 1024, 32, WO2T, scr, r, lane);
    }
    const int gt = blockIdx.x * 512 + tid, NGT = gridDim.x * 512;
    for (int i = gt; i < 16 * 1024; i += NGT) { const int n = i >> 10, k = i & 1023; W2T[(size_t)(4096 + n) * 1024 + k] = f2bf(W2[(size_t)k * 4112 + 4096 + n]); }
    for (int i = gt; i < 240 * 1024 / 8; i += NGT) *(u32x4*)(W2T + (size_t)4112 * 1024 + (size_t)i * 8) = (u32x4){0u, 0u, 0u, 0u};
    float* ss1 = (float*)(a.ws + WS_SS1); float* ss2 = (float*)(a.ws + WS_SS2);
    for (int i = gt; i < MROWS; i += NGT) { ss1[i] = 0.f; ss2[i] = 0.f; }
    const float* ck = a.in[2]; const float* cv = a.in[3];
    for (int i = gt; i < 32 * 96 * 64; i += NGT) { const int sb = i / (96 * 64), rem = i % (96 * 64);
        *(f32x4*)(a.out + O_KWS + (size_t)sb * 32768 + (size_t)rem * 4) = *(const f32x4*)(ck + (size_t)sb * 32768 + 32 * 256 + (size_t)rem * 4);
        *(f32x4*)(a.out + O_VWS + (size_t)sb * 32768 + (size_t)rem * 4) = *(const f32x4*)(cv + (size_t)sb * 32768 + 32 * 256 + (size_t)rem * 4); }
    const float* g0 = a.in[6]; bf16* XN = (bf16*)(a.ws + WS_XN);
    f32x4 gv[4];
#pragma unroll
    for (int j = 0; j < 4; ++j) gv[j] = *(const f32x4*)(g0 + 4 * lane + 256 * j);
    for (int m0 = gw; m0 < MROWS; m0 += 2 * NGW) {
        f32x4 v[2][4];
#pragma unroll
        for (int r = 0; r < 2; ++r) { const int m = m0 + r * NGW, mc = m < MROWS ? m : m0;
            const float* xr = (mc < MP) ? a.in[0] + (size_t)mc * DM : a.in[1] + (size_t)(mc - MP) * DM;
#pragma unroll
            for (int j = 0; j < 4; ++j) v[r][j] = *(const f32x4*)(xr + 4 * lane + 256 * j); }
#pragma unroll
        for (int r = 0; r < 2; ++r) { const int m = m0 + r * NGW; float s = 0.f;
#pragma unroll
            for (int j = 0; j < 4; ++j) s += (v[r][j].x * v[r][j].x + v[r][j].y * v[r][j].y) + (v[r][j].z * v[r][j].z + v[r][j].w * v[r][j].w);
            const float rs = frsq(wave_sum(s) * (1.f / DM) + EPS);
            if (m < MROWS) {
#pragma unroll
                for (int j = 0; j < 4; ++j) { u32x2 o; o.x = pk2(v[r][j].x * rs * gv[j].x, v[r][j].y * rs * gv[j].y); o.y = pk2(v[r][j].z * rs * gv[j].z, v[r][j].w * rs * gv[j].w);
                    *(u32x2*)(XN + (size_t)m * DM + 4 * lane + 256 * j) = o; } } }
    }
}

DI void attn_phase(LAS unsigned char* lds, const bf16* QKVG, const float* cache_k, const float* cache_v, const float* sinks, bf16* OG, int tid, int lane, int w) {
    LAS bf16* Ks = (LAS bf16*)lds;
    LAS bf16* VT = (LAS bf16*)(lds + 192 * 72 * 2);
    for (int u = blockIdx.x; u < 2176; u += gridDim.x) {
        asm volatile("" : "+v"(lane), "+v"(tid));
        const int r = lane & 31, hh = lane >> 5;
        int kvh, jmin, jmax, qrow0, sb = 0; bool sample;
        if (u < 2048) { kvh = u & 3; const int bn = u >> 2, b = bn >> 6, n = bn & 63; qrow0 = b * 4096 + 64 * n; jmin = n < 2 ? 64 * (2 - n) : 0; jmax = 192; sample = false; }
        else { const int su = u - 2048; kvh = su & 3; sb = su >> 2; qrow0 = MP + 32 * sb; jmin = 0; jmax = 160; sample = true; }
        __syncthreads();
#pragma unroll
        for (int i = 0; i < 3; ++i) {
            const int id = tid + 512 * i, j = id >> 3, c8 = id & 7;
            u32x4 kv = (u32x4){0u, 0u, 0u, 0u}, vv = (u32x4){0u, 0u, 0u, 0u};
            if (!sample) {
                if (j >= jmin) { const size_t row = (size_t)(qrow0 - 128 + j); kv = *(const u32x4*)(QKVG + row * 2560 + 1024 + kvh * 64 + c8 * 8); vv = *(const u32x4*)(QKVG + row * 2560 + 1280 + kvh * 64 + c8 * 8); }
            } else {
                if (j < 128) { const size_t off = ((size_t)(sb * 128 + j) * 4 + kvh) * 64 + c8 * 8; kv = ld8f_bf(cache_k + off); vv = ld8f_bf(cache_v + off); }
                else if (j < 160) { const size_t row = (size_t)(qrow0 + j - 128); kv = *(const u32x4*)(QKVG + row * 2560 + 1024 + kvh * 64 + c8 * 8); vv = *(const u32x4*)(QKVG + row * 2560 + 1280 + kvh * 64 + c8 * 8); }
            }
            *(LAS u32x4*)(Ks + j * 72 + c8 * 8) = kv;
            const int pos = (j & ~31) | (((j >> 4) & 1) << 4) | (((j >> 2) & 1) << 3) | (((j >> 3) & 1) << 2) | (j & 3);
#pragma unroll
            for (int e = 0; e < 4; ++e) { VT[(c8 * 8 + 2 * e) * 200 + pos] = (bf16)(vv[e] & 0xffffu); VT[(c8 * 8 + 2 * e + 1) * 200 + pos] = (bf16)(vv[e] >> 16); }
        }
        __syncthreads();
        const int g = w >> 1, th = w & 1;
        if (!(sample && th == 1)) {
            const int head = kvh * 4 + g;
            const size_t qrow = (size_t)(qrow0 + 32 * th + r);
            bf16x8 qf[4];
#pragma unroll
            for (int s = 0; s < 4; ++s) qf[s] = *(const bf16x8*)(QKVG + qrow * 2560 + head * 64 + 16 * s + 8 * hh);
            f32x16 sc[6];
#pragma unroll
            for (int kt = 0; kt < 6; ++kt) {
#pragma unroll
                for (int i = 0; i < 16; ++i) sc[kt][i] = 0.f;
#pragma unroll
                for (int s = 0; s < 4; ++s) { const bf16x8 kf = *(const LAS bf16x8*)(Ks + (32 * kt + r) * 72 + 16 * s + 8 * hh); sc[kt] = MFMA32(kf, qf[s], sc[kt]); }
                __builtin_amdgcn_sched_barrier(0);
            }
            const float slope2 = fexp2(-0.5f * (float)(head + 1)) * LOG2E;
            const float sink2 = sinks[head] * LOG2E;
            const int t = 32 * th + r;
            float mx = sink2;
            const int tb = 128 + t - 4 * hh;
#pragma unroll
            for (int kt = 0; kt < 6; ++kt) {
                if (32 * kt >= jmin && 32 * kt + 32 <= jmax) {
#pragma unroll
                    for (int i = 0; i < 16; ++i) { const float dist = fabsf((float)(tb - (32 * kt + (i & 3) + 8 * (i >> 2))));
                        const float l = sc[kt][i] - slope2 * dist; sc[kt][i] = l; mx = fmaxf(mx, l); }
                } else {
#pragma unroll
                    for (int i = 0; i < 16; ++i) sc[kt][i] = -INFINITY;
                }
            }
            mx = fmaxf(mx, __shfl_xor(mx, 32));
            float sum = 0.f;
#pragma unroll
            for (int kt = 0; kt < 6; ++kt)
#pragma unroll
                for (int i = 0; i < 16; ++i) { const float p = fexp2(sc[kt][i] - mx); sc[kt][i] = p; sum += p; }
            sum += __shfl_xor(sum, 32);
            const float inv = 1.f / (sum + fexp2(sink2 - mx));
            f32x16 o[2];
#pragma unroll
            for (int i = 0; i < 16; ++i) { o[0][i] = 0.f; o[1][i] = 0.f; }
#pragma unroll
            for (int kt = 0; kt < 6; ++kt)
#pragma unroll
                for (int s = 0; s < 2; ++s) {
                    u32x4 pp; pp.x = pk2(sc[kt][8 * s], sc[kt][8 * s + 1]); pp.y = pk2(sc[kt][8 * s + 2], sc[kt][8 * s + 3]); pp.z = pk2(sc[kt][8 * s + 4], sc[kt][8 * s + 5]); pp.w = pk2(sc[kt][8 * s + 6], sc[kt][8 * s + 7]);
                    const bf16x8 pf = __builtin_bit_cast(bf16x8, pp);
#pragma unroll
                    for (int mt = 0; mt < 2; ++mt) { const bf16x8 vf = *(const LAS bf16x8*)(VT + (32 * mt + r) * 200 + 32 * kt + 16 * s + 8 * hh); o[mt] = MFMA32(vf, pf, o[mt]); }
                    __builtin_amdgcn_sched_barrier(0);
                }
#pragma unroll
            for (int mt = 0; mt < 2; ++mt)
#pragma unroll
                for (int i4 = 0; i4 < 4; ++i4) {
                    const int d0 = 32 * mt + 8 * i4 + 4 * hh;
                    const u32x2 gz = *(const u32x2*)(QKVG + qrow * 2560 + 1536 + head * 64 + d0);
                    const float o0 = o[mt][4 * i4] * inv * silu(bflo(gz.x)), o1 = o[mt][4 * i4 + 1] * inv * silu(bfhi(gz.x));
                    const float o2 = o[mt][4 * i4 + 2] * inv * silu(bflo(gz.y)), o3 = o[mt][4 * i4 + 3] * inv * silu(bfhi(gz.y));
                    u32x2 ov; ov.x = pk2(o0, o1); ov.y = pk2(o2, o3);
                    *(u32x2*)(OG + qrow * 1024 + head * 64 + d0) = ov;
                }
        }
    }
    __syncthreads();
}


DI u32x4 zero4() { return (u32x4){0u, 0u, 0u, 0u}; }
DI float bfe(const u32x4& v, int e) { const unsigned u = v[e >> 1]; return (e & 1) ? bfhi(u) : bflo(u); }

DI void dn_pre_phase(const Args& a, int lane, int w) {
    bf16* DNP = (bf16*)(a.ws + WS_BIG); const bf16* HALO = (const bf16*)(a.ws + WS_HALO); float* BA = (float*)(a.ws + WS_BA);
    const float* state_conv = a.in[4]; const float* conv_w = a.in[12]; const float* a_log = a.in[13]; const float* dt_bias = a.in[14];
    const int gw = blockIdx.x * 8 + w, NGW = gridDim.x * 8;
    for (int it = gw; it < 528 * 25; it += NGW) {
        asm volatile("" : "+v"(lane));
        const int ch = it / 25, sub = it % 25;
        if (sub == 24) {
            const size_t row = (size_t)64 * ch + lane; const int width = ch < 512 ? 64 : 32;
            float bv[8], gv[8];
#pragma unroll
            for (int hh = 0; hh < 8; ++hh) { bv[hh] = BA[row * 16 + hh]; gv[hh] = BA[row * 16 + 8 + hh]; }
#pragma unroll
            for (int hh = 0; hh < 8; ++hh) {
                const float beta = 1.f / (1.f + __expf(-bv[hh]));
                const float x = gv[hh] + dt_bias[hh]; const float sp = x > 20.f ? x : log1pf(expf(x));
                float gg = -expf(a_log[hh]) * sp;
#pragma unroll
                for (int d = 1; d < 64; d <<= 1) { const float t = __shfl_up(gg, d, 64); if ((lane & (width - 1)) >= d && d < width) gg += t; }
                BA[row * 16 + hh] = beta; BA[row * 16 + 8 + hh] = gg;
            }
            continue;
        }
        const int h = sub / 3, sec = sub % 3;
        const int g = lane >> 4, cl = lane & 15;
        const int col = sec * 1024 + h * 128 + 8 * cl;
        const size_t R0 = (size_t)64 * ch + 16 * g;
        u32x4 xin[19];
#pragma unroll
        for (int i = 0; i < 16; ++i) xin[3 + i] = *(const u32x4*)(DNP + (R0 + i) * 4096 + col);
        if (ch < 512) {
            if (g > 0) {
#pragma unroll
                for (int i = 0; i < 3; ++i) xin[i] = *(const u32x4*)(DNP + (R0 - 3 + i) * 4096 + col);
            } else if ((ch & 63) == 0) { xin[0] = zero4(); xin[1] = zero4(); xin[2] = zero4(); }
            else {
#pragma unroll
                for (int i = 0; i < 3; ++i) xin[i] = *(const u32x4*)(HALO + ((size_t)(ch - 1) * 3 + i) * 3072 + col);
            }
        } else {
            if (g & 1) {
#pragma unroll
                for (int i = 0; i < 3; ++i) xin[i] = *(const u32x4*)(DNP + (R0 - 3 + i) * 4096 + col);
            } else { const int sb = 2 * (ch - 512) + (g >> 1);
#pragma unroll
                for (int i = 0; i < 3; ++i) xin[i] = ld8f_bf(state_conv + ((size_t)sb * 3 + i) * 3072 + col);
            }
        }
        float wv[4][8];
#pragma unroll
        for (int j = 0; j < 4; ++j) { const f32x4 w0 = *(const f32x4*)(conv_w + (size_t)j * 3072 + col), w1 = *(const f32x4*)(conv_w + (size_t)j * 3072 + col + 4);
            wv[j][0] = w0.x; wv[j][1] = w0.y; wv[j][2] = w0.z; wv[j][3] = w0.w; wv[j][4] = w1.x; wv[j][5] = w1.y; wv[j][6] = w1.z; wv[j][7] = w1.w; }
        asm volatile("s_waitcnt vmcnt(0)" ::: "memory");
        const int clp = cl & 3, pos0 = 32 * (cl >> 2) + 16 * (clp & 1) + 4 * (clp >> 1);
        unsigned vp[4][4];
#pragma unroll
        for (int i = 0; i < 16; ++i) {
            float y[8]; float ssq = 0.f;
#pragma unroll
            for (int e = 0; e < 8; ++e) { float t = wv[0][e] * bfe(xin[i], e) + wv[1][e] * bfe(xin[i + 1], e) + wv[2][e] * bfe(xin[i + 2], e) + wv[3][e] * bfe(xin[i + 3], e);
                t = silu(t); y[e] = t; ssq += t * t; }
            if (sec < 2) {
                ssq += __shfl_xor(ssq, 1); ssq += __shfl_xor(ssq, 2); ssq += __shfl_xor(ssq, 4); ssq += __shfl_xor(ssq, 8);
                const float scl = frsq(ssq + EPS) * (sec == 0 ? 0.08838834764831845f : 1.f);
                u32x2 lo, hi; lo.x = pk2(y[0] * scl, y[1] * scl); lo.y = pk2(y[2] * scl, y[3] * scl); hi.x = pk2(y[4] * scl, y[5] * scl); hi.y = pk2(y[6] * scl, y[7] * scl);
                bf16* dst = DNP + (R0 + i) * 4096 + sec * 1024 + h * 128 + pos0;
                *(u32x2*)dst = lo; *(u32x2*)(dst + 8) = hi;
            } else {
                const u32x4 pk = pack8f(y);
                vp[i & 3][0] = pk.x; vp[i & 3][1] = pk.y; vp[i & 3][2] = pk.z; vp[i & 3][3] = pk.w;
                if ((i & 3) == 3) {
                    bf16* dst = DNP + ((size_t)64 * ch + 4 * (4 * g + (i >> 2)) + (cl >> 2)) * 4096 + 2048 + h * 128 + (cl & 3) * 32;
#pragma unroll
                    for (int j = 0; j < 4; ++j) { u32x4 o;
                        o.x = (vp[0][j] & 0xffffu) | (vp[1][j] << 16); o.y = (vp[2][j] & 0xffffu) | (vp[3][j] << 16);
                        o.z = (vp[0][j] >> 16) | (vp[1][j] & 0xffff0000u); o.w = (vp[2][j] >> 16) | (vp[3][j] & 0xffff0000u);
                        *(u32x4*)(dst + 8 * j) = o; }
                }
            }
        }
    }
}


template <int I> DI void fs_load_lo(f32x4 (&mb)[4], const LAS float* Ms) {
#pragma unroll
    for (int j4 = 0; j4 < 4; ++j4) if (4 * j4 < I) mb[j4] = *(const LAS f32x4*)(Ms + I * 64 + 4 * j4);
}
template <int I> DI void fs_load_hi(f32x4 (&mb)[12], const LAS float* Ms) {
#pragma unroll
    for (int j4 = 4; j4 < 16; ++j4) if (4 * j4 < I) mb[j4 - 4] = *(const LAS f32x4*)(Ms + I * 64 + 4 * j4);
}
template <int I> DI void fs_comp(float (&T)[64], const f32x4 (&lo)[4], const f32x4 (&hi)[12], int lane) {
    float a0 = (lane == I) ? 1.f : 0.f, a1 = 0.f, a2 = 0.f, a3 = 0.f;
#pragma unroll
    for (int j4 = 0; j4 < 4; ++j4) {
        if (4 * j4 + 0 < I) a0 -= lo[j4][0] * T[4 * j4 + 0];
        if (4 * j4 + 1 < I) a1 -= lo[j4][1] * T[4 * j4 + 1];
        if (4 * j4 + 2 < I) a2 -= lo[j4][2] * T[4 * j4 + 2];
        if (4 * j4 + 3 < I) a3 -= lo[j4][3] * T[4 * j4 + 3];
    }
#pragma unroll
    for (int j4 = 4; j4 < 16; ++j4) {
        if (4 * j4 + 0 < I) a0 -= hi[j4 - 4][0] * T[4 * j4 + 0];
        if (4 * j4 + 1 < I) a1 -= hi[j4 - 4][1] * T[4 * j4 + 1];
        if (4 * j4 + 2 < I) a2 -= hi[j4 - 4][2] * T[4 * j4 + 2];
        if (4 * j4 + 3 < I) a3 -= hi[j4 - 4][3] * T[4 * j4 + 3];
    }
    T[I] = (a0 + a1) + (a2 + a3);
}
template <int I> DI void fs_pipe(float (&T)[64], const LAS float* Ms, int lane, f32x4 (&cur)[4], f32x4 (&nxt)[4], f32x4 (&hi)[12]) {
    if constexpr (I < 64) {
        fs_load_hi<I>(hi, Ms);
        if constexpr (I + 1 < 64) fs_load_lo<I + 1>(nxt, Ms);
        fs_comp<I>(T, cur, hi, lane);
        fs_pipe<I + 1>(T, Ms, lane, nxt, cur, hi);
    }
}
template <int I> DI void tb_store(float (&T)[64], LAS bf16* TbI, int lane, float betal) {
    if constexpr (I < 64) { TbI[I * 64 + lane] = f2bf(T[I] * betal); tb_store<I + 1>(T, TbI, lane, betal); }
}
DI void dn_prep_phase(const Args& a, LAS unsigned char* lds, int lane, int w) {
    const bf16* DNP = (const bf16*)(a.ws + WS_BIG); const float* BA = (const float*)(a.ws + WS_BA);
    unsigned char* TBI = a.ws + WS_XN; unsigned char* KTG = a.ws + WS_KT; float* SCAL = (float*)(a.ws + WS_SCAL);
    LAS float* Ms = (LAS float*)(lds + w * 17408);
    LAS bf16* TbI = (LAS bf16*)Ms; LAS bf16* InI = TbI + 4096; LAS bf16* Kl = (LAS bf16*)Ms;
    const int gw = blockIdx.x * 8 + w, NGW = gridDim.x * 8;
    for (int slot = 0; slot < 3; ++slot) {
        int uid = gw + 2048 * slot; if (slot == 2) { if (w != 0 || (int)blockIdx.x >= 256) break; uid = 4096 + (int)blockIdx.x; } else if (uid >= 4096) continue;
        asm volatile("" : "+v"(lane));
        const int r = lane & 31, hh = lane >> 5;
        int h, nv; size_t R0;
        if (uid < 4096) { h = uid & 7; R0 = (size_t)64 * (uid >> 3); nv = 64; } else { const int su = uid - 4096; h = su & 7; R0 = (size_t)MP + 32 * (su >> 3); nv = 32; }
        const int lr = lane < nv ? lane : nv - 1;
        const float gcl = BA[(R0 + lr) * 16 + 8 + h];
        const float betal_ = BA[(R0 + lr) * 16 + h]; const float betal = lane < nv ? betal_ : 0.f;
        const bf16* kbase = DNP + R0 * 4096 + 1024 + h * 128; const bf16* qbase = DNP + R0 * 4096 + h * 128;
        const int row = lane & 15, quad = lane >> 4;
        {
            bf16x8 kf[2][8];
#pragma unroll
            for (int mt = 0; mt < 2; ++mt)
#pragma unroll
                for (int s = 0; s < 8; ++s) { const bool ok = 32 * mt + r < nv; const bf16x8 t = *(const bf16x8*)(kbase + (size_t)(ok ? 32 * mt + r : 0) * 4096 + 16 * s + 8 * hh); kf[mt][s] = ok ? t : (bf16x8){0, 0, 0, 0, 0, 0, 0, 0}; }
#pragma unroll
            for (int tl = 0; tl < 3; ++tl) {
                const int mt = tl > 0 ? 1 : 0, nt = tl > 1 ? 1 : 0;
                f32x16 kk;
#pragma unroll
                for (int i = 0; i < 16; ++i) kk[i] = 0.f;
#pragma unroll
                for (int s = 0; s < 8; ++s) kk = MFMA32(kf[mt][s], kf[nt][s], kk);
                const int j = 32 * nt + r; const float gcj = __shfl(gcl, j);
#pragma unroll
                for (int i = 0; i < 16; ++i) {
                    const int ii = 32 * mt + crow(i, hh);
                    const float gci = __shfl(gcl, ii), bi = __shfl(betal, ii);
                    Ms[ii * 64 + j] = (ii > j) ? kk[i] * bi * __expf(fminf(gci - gcj, 0.f)) : 0.f;
                }
            }
        }
        {
            float T[64]; f32x4 mbA[4], mbB[4], mbH[12];
            fs_pipe<0>(T, Ms, lane, mbA, mbB, mbH);
            tb_store<0>(T, TbI, lane, betal);
        }
#pragma unroll
        for (int f = 0; f < 8; ++f) {
            const int i = 16 * (f >> 1) + row, c0 = 32 * (f & 1) + 4 * quad;
            const u32x2 tlo = *(const LAS u32x2*)(TbI + i * 64 + c0), thi = *(const LAS u32x2*)(TbI + i * 64 + c0 + 16);
            *(u32x4*)(TBI + (size_t)uid * 16384 + (size_t)(f * 64 + lane) * 16) = (u32x4){tlo.x, tlo.y, thi.x, thi.y};
        }
        {
#pragma unroll
            for (int tl = 0; tl < 3; ++tl) {
                const int mt = tl > 0 ? 1 : 0, nt = tl > 1 ? 1 : 0;
                f32x16 qk;
#pragma unroll
                for (int i = 0; i < 16; ++i) qk[i] = 0.f;
#pragma unroll
                for (int s = 0; s < 8; ++s) {
                    const bool okq = 32 * mt + r < nv, okk = 32 * nt + r < nv;
                    const bf16x8 qt = *(const bf16x8*)(qbase + (size_t)(okq ? 32 * mt + r : 0) * 4096 + 16 * s + 8 * hh), kt_ = *(const bf16x8*)(kbase + (size_t)(okk ? 32 * nt + r : 0) * 4096 + 16 * s + 8 * hh);
                    const bf16x8 qf = okq ? qt : (bf16x8){0, 0, 0, 0, 0, 0, 0, 0}, kf = okk ? kt_ : (bf16x8){0, 0, 0, 0, 0, 0, 0, 0};
                    qk = MFMA32(qf, kf, qk);
                }
                const int j = 32 * nt + r; const float gcj = __shfl(gcl, j);
#pragma unroll
                for (int i = 0; i < 16; ++i) {
                    const int ii = 32 * mt + crow(i, hh);
                    const float gci = __shfl(gcl, ii);
                    InI[ii * 64 + j] = f2bf((ii >= j) ? qk[i] * __expf(fminf(gci - gcj, 0.f)) : 0.f);
                    if (tl == 0) InI[ii * 64 + 32 + r] = 0;
                }
            }
#pragma unroll
            for (int f = 0; f < 8; ++f) {
                const int i = 16 * (f >> 1) + row, c0 = 32 * (f & 1) + 4 * quad;
                const u32x2 ilo = *(const LAS u32x2*)(InI + i * 64 + c0), ihi = *(const LAS u32x2*)(InI + i * 64 + c0 + 16);
                *(u32x4*)(TBI + (size_t)uid * 16384 + 8192 + (size_t)(f * 64 + lane) * 16) = (u32x4){ilo.x, ilo.y, ihi.x, ihi.y};
            }
        }
#pragma unroll
        for (int i = 0; i < 16; ++i) { const int id = lane + 64 * i, rr = id >> 4, c16 = id & 15;
            const u32x4 vt_ = *(const u32x4*)(kbase + (size_t)(rr < nv ? rr : 0) * 4096 + 8 * c16); const u32x4 v = (rr < nv) ? vt_ : zero4();
            *(LAS u32x4*)(Kl + rr * 136 + 8 * c16) = v; }
#pragma unroll
        for (int f = 0; f < 16; ++f) {
            const int dk = 16 * (f >> 1) + row, dkp = dk & 31, pos = (dk & ~31) + 8 * ((dkp >> 2) & 3) + 4 * (dkp >> 4) + (dkp & 3);
            u32x4 o;
#pragma unroll
            for (int j2 = 0; j2 < 4; ++j2) { const int tok = 32 * (f & 1) + 16 * (j2 >> 1) + 4 * quad + 2 * (j2 & 1);
                o[j2] = (unsigned)Kl[tok * 136 + pos] | ((unsigned)Kl[(tok + 1) * 136 + pos] << 16); }
            *(u32x4*)(KTG + (size_t)uid * 16384 + (size_t)(f * 64 + lane) * 16) = o;
        }
        const float gl = __shfl(gcl, 63);
        SCAL[(size_t)uid * 256 + lane] = __expf(gcl); SCAL[(size_t)uid * 256 + 64 + lane] = __expf(gl - gcl);
        if (lane == 0) SCAL[(size_t)uid * 256 + 128] = __expf(gl);
    }
}

constexpr int SC_K = 0, SC_Q = 17408, SC_V = 34816, SC_TB = 52224, SC_IN = 60416, SC_KT = 68608, SC_SC = 84992, SC_OB = 86016, SC_OBSZ = 17408, SC_NG = 120832;
#define RAW_BARRIER() do { asm volatile("s_waitcnt lgkmcnt(0)" ::: "memory"); __builtin_amdgcn_s_barrier(); asm volatile("" ::: "memory"); } while (0)
struct QuarterOrder {
    int q, c, G;
    DI bool next(int i, pg8::Unit& u) const {
        const int L = i * G + c;
        if (L < 128) { u.pm = 16 * (L >> 4) + 4 * q + ((L >> 2) & 3); u.pn = L & 3; return true; }
        if (q == 3 && L < 144) { u.pm = 128 + ((L - 128) >> 2); u.pn = L & 3; return true; }
        return false;
    }
    DI void a_ready(const pg8::Unit&) const {}
    DI void done(const pg8::Unit&) const {}
};
struct SampleOrder {
    int c;
    DI bool next(int i, pg8::Unit& u) const { if (i > 0 || c < 0 || c >= 16) return false; u.pm = 128 + (c >> 2); u.pn = c & 3; return true; }
    DI void a_ready(const pg8::Unit&) const {}
    DI void done(const pg8::Unit&) const {}
};
DI void dn_scan_phase(const Args& a, LAS unsigned char* lds, int tid, int lane, int w, const XcdBarrier& xbar, int job_lo, int job_hi, bool midbar, int job_step) {
    const bf16* DNP = (const bf16*)(a.ws + WS_BIG); const unsigned char* TBI = a.ws + WS_XN; const unsigned char* KTG = a.ws + WS_KT; const float* SCAL = (const float*)(a.ws + WS_SCAL);
    bf16* OG = (bf16*)(a.ws + WS_OG); const float* state_ssm = a.in[5]; const float* ng = a.in[15];
    for (int job = job_lo; job < job_hi; job += job_step) {
        int h, nsteps, nv; size_t Rbase; int uid0, ustep; float* sout; const float* sin = nullptr;
        if (job < 64) { const int b = job >> 3; h = job & 7; nsteps = 64; nv = 64; Rbase = (size_t)b * 4096; uid0 = b * 512 + h; ustep = 8; sout = a.out + O_SSMP + (size_t)(b * 8 + h) * 16384; }
        else { const int s = job - 64, sb = s >> 3; h = s & 7; nsteps = 1; nv = 32; Rbase = (size_t)MP + 32 * sb; uid0 = 4096 + s; ustep = 0; sout = a.out + O_SSMS + (size_t)(sb * 8 + h) * 16384; sin = state_ssm + (size_t)(sb * 8 + h) * 16384; }
        if (w < 4) {
            f32x4 S[2][8];
            { const int col = lane & 15, quad = lane >> 4;
#pragma unroll
              for (int nt = 0; nt < 2; ++nt)
#pragma unroll
                for (int t = 0; t < 8; ++t)
#pragma unroll
                    for (int i = 0; i < 4; ++i) S[nt][t][i] = 0.f;
              if (sin) {
#pragma unroll
                for (int nt = 0; nt < 2; ++nt)
#pragma unroll
                  for (int t = 0; t < 8; ++t)
#pragma unroll
                    for (int i = 0; i < 4; ++i) S[nt][t][i] = sin[(size_t)(16 * t + 4 * quad + i) * 128 + 32 * w + 16 * nt + col];
              } }
#if defined(PROBE_IDLE) || defined(PROBE_REGION)
            unsigned long long idle_acc = 0;
#endif
#ifdef PROBE_WHOLE
            const unsigned long long tw0_ = __builtin_amdgcn_s_memrealtime();
#endif
            for (int n = 0; n < nsteps; ++n) {
                if (midbar && n == 17) xcd_barrier(xbar);
                asm volatile("" : "+v"(lane));
                const int col = lane & 15, quad = lane >> 4;
#if defined(PROBE_IDLE) && !defined(PROBE_REGION)
                const unsigned long long t0_ = __builtin_amdgcn_s_memrealtime();
#endif
                RAW_BARRIER();
                RAW_BARRIER();
#if defined(PROBE_IDLE) && !defined(PROBE_REGION)
                idle_acc += __builtin_amdgcn_s_memrealtime() - t0_;
#endif
#ifdef PROBE_REGION
                unsigned long long tr_ = 0;
#define RMARK(k) do { if ((k) == PROBE_REGION) { asm volatile("s_nop 0" ::: "memory"); tr_ = __builtin_amdgcn_s_memrealtime(); } if ((k) == PROBE_REGION + 1) { asm volatile("s_nop 0" ::: "memory"); idle_acc += __builtin_amdgcn_s_memrealtime() - tr_; } } while (0)
#else
#define RMARK(k) do { } while (0)
#endif
                RMARK(0);
#define BUILD_SB() do { _Pragma("unroll") for (int nt = 0; nt < 2; ++nt) _Pragma("unroll") for (int ks = 0; ks < 4; ++ks) { u32x4 p; p.x = pk2(S[nt][2 * ks][0], S[nt][2 * ks][1]); p.y = pk2(S[nt][2 * ks][2], S[nt][2 * ks][3]); \
                    p.z = pk2(S[nt][2 * ks + 1][0], S[nt][2 * ks + 1][1]); p.w = pk2(S[nt][2 * ks + 1][2], S[nt][2 * ks + 1][3]); sB[nt][ks] = __builtin_bit_cast(bf16x8, p); } } while (0)
#define SCHED_FENCE() __builtin_amdgcn_sched_barrier(0)
                f32x4 kS[2][4];
                bf16x8 ta[6];
                bf16x8 sB[2][4];
                {
                    bf16x8 ka[4][4];
#pragma unroll
                    for (int mt = 0; mt < 4; ++mt)
#pragma unroll
                        for (int ks = 0; ks < 4; ++ks) ka[mt][ks] = *(const LAS bf16x8*)(lds + SC_K + (16 * mt + col) * 272 + 64 * ks + 16 * quad);
#pragma unroll
                    for (int f = 0; f < 6; ++f) { const int mt = f < 2 ? f : 2 + ((f - 2) >> 1), k2 = f < 2 ? 0 : ((f - 2) & 1); ta[f] = *(const LAS bf16x8*)(lds + SC_TB + ((mt * 2 + k2) * 64 + lane) * 16); }
                    BUILD_SB();
                    SCHED_FENCE();
#pragma unroll
                    for (int mt = 0; mt < 4; ++mt)
#pragma unroll
                        for (int nt = 0; nt < 2; ++nt) kS[nt][mt] = (f32x4){0.f, 0.f, 0.f, 0.f};
#pragma unroll
                    for (int ks = 0; ks < 4; ++ks)
#pragma unroll
                        for (int mt = 0; mt < 4; ++mt)
#pragma unroll
                            for (int nt = 0; nt < 2; ++nt) kS[nt][mt] = MFMA16(ka[mt][ks], sB[nt][ks], kS[nt][mt]);
                    SCHED_FENCE();
                }
                f32x4 oq0[2][2];
                {
                    bf16x8 qa[2][4];
#pragma unroll
                    for (int m2 = 0; m2 < 2; ++m2)
#pragma unroll
                        for (int ks = 0; ks < 4; ++ks) qa[m2][ks] = *(const LAS bf16x8*)(lds + SC_Q + (16 * m2 + col) * 272 + 64 * ks + 16 * quad);
#pragma unroll
                    for (int m2 = 0; m2 < 2; ++m2)
#pragma unroll
                        for (int nt = 0; nt < 2; ++nt) oq0[nt][m2] = (f32x4){0.f, 0.f, 0.f, 0.f};
#pragma unroll
                    for (int ks = 0; ks < 4; ++ks)
#pragma unroll
                        for (int m2 = 0; m2 < 2; ++m2)
#pragma unroll
                            for (int nt = 0; nt < 2; ++nt) oq0[nt][m2] = MFMA16(qa[m2][ks], sB[nt][ks], oq0[nt][m2]);
                }
                RMARK(1);
#define EVL(mt) (*(const LAS f32x4*)(lds + SC_SC + (16 * (mt) + 4 * quad) * 4))
#define DVL(mt) (*(const LAS f32x4*)(lds + SC_SC + (64 + 16 * (mt) + 4 * quad) * 4))
                const float gam = *(const LAS float*)(lds + SC_SC + 128 * 4);
                bf16x8 vB[2][2], vdB[2][2];
                {
                    bf16x8 rB[2][2];
#pragma unroll
                    for (int nt = 0; nt < 2; ++nt) {
                        f32x4 rr4[4];
#pragma unroll
                        for (int mt = 0; mt < 4; ++mt) { const u32x2 vv = *(const LAS u32x2*)(lds + SC_V + (4 * (4 * mt + quad) + w) * 272 + (16 * nt + col) * 8); const f32x4 ev = EVL(mt);
                            rr4[mt][0] = bflo(vv.x) - ev[0] * kS[nt][mt][0]; rr4[mt][1] = bfhi(vv.x) - ev[1] * kS[nt][mt][1];
                            rr4[mt][2] = bflo(vv.y) - ev[2] * kS[nt][mt][2]; rr4[mt][3] = bfhi(vv.y) - ev[3] * kS[nt][mt][3]; }
#pragma unroll
                        for (int k2 = 0; k2 < 2; ++k2) { u32x4 p; p.x = pk2(rr4[2 * k2][0], rr4[2 * k2][1]); p.y = pk2(rr4[2 * k2][2], rr4[2 * k2][3]); p.z = pk2(rr4[2 * k2 + 1][0], rr4[2 * k2 + 1][1]); p.w = pk2(rr4[2 * k2 + 1][2], rr4[2 * k2 + 1][3]); rB[nt][k2] = __builtin_bit_cast(bf16x8, p); }
                    }
                    f32x4 vn[2][4];
#pragma unroll
                    for (int mt = 0; mt < 4; ++mt)
#pragma unroll
                        for (int nt = 0; nt < 2; ++nt) vn[nt][mt] = (f32x4){0.f, 0.f, 0.f, 0.f};
#pragma unroll
                    for (int f = 0; f < 6; ++f) { const int mt = f < 2 ? f : 2 + ((f - 2) >> 1), k2 = f < 2 ? 0 : ((f - 2) & 1);
#pragma unroll
                        for (int nt = 0; nt < 2; ++nt) vn[nt][mt] = MFMA16(ta[f], rB[nt][k2], vn[nt][mt]); }
#pragma unroll
                    for (int nt = 0; nt < 2; ++nt)
#pragma unroll
                        for (int k2 = 0; k2 < 2; ++k2) { u32x4 p, q; const f32x4 d0 = DVL(2 * k2), d1 = DVL(2 * k2 + 1);
                            p.x = pk2(vn[nt][2 * k2][0], vn[nt][2 * k2][1]); p.y = pk2(vn[nt][2 * k2][2], vn[nt][2 * k2][3]); p.z = pk2(vn[nt][2 * k2 + 1][0], vn[nt][2 * k2 + 1][1]); p.w = pk2(vn[nt][2 * k2 + 1][2], vn[nt][2 * k2 + 1][3]);
                            q.x = pk2(vn[nt][2 * k2][0] * d0[0], vn[nt][2 * k2][1] * d0[1]); q.y = pk2(vn[nt][2 * k2][2] * d0[2], vn[nt][2 * k2][3] * d0[3]);
                            q.z = pk2(vn[nt][2 * k2 + 1][0] * d1[0], vn[nt][2 * k2 + 1][1] * d1[1]); q.w = pk2(vn[nt][2 * k2 + 1][2] * d1[2], vn[nt][2 * k2 + 1][3] * d1[3]);
                            vB[nt][k2] = __builtin_bit_cast(bf16x8, p); vdB[nt][k2] = __builtin_bit_cast(bf16x8, q); }
                }
                RMARK(2);
                LAS bf16* OB = (LAS bf16*)(lds + SC_OB + (n & 1) * SC_OBSZ);
                {
#pragma unroll
                    for (int hf = 0; hf < 2; ++hf) {
                        bf16x8 qa[2][4], ia[3];
                        if (hf == 1) {
#pragma unroll
                        for (int m2 = 0; m2 < 2; ++m2)
#pragma unroll
                            for (int ks = 0; ks < 4; ++ks) qa[m2][ks] = *(const LAS bf16x8*)(lds + SC_Q + (16 * (2 * hf + m2) + col) * 272 + 64 * ks + 16 * quad);
                        }
                        if (hf == 0) { ia[0] = *(const LAS bf16x8*)(lds + SC_IN + ((0 * 2 + 0) * 64 + lane) * 16); ia[1] = *(const LAS bf16x8*)(lds + SC_IN + ((1 * 2 + 0) * 64 + lane) * 16); ia[2] = ia[1]; }
                        SCHED_FENCE();
                        f32x4 o[2][2];
#pragma unroll
                        for (int m2 = 0; m2 < 2; ++m2)
#pragma unroll
                            for (int nt = 0; nt < 2; ++nt) o[nt][m2] = (hf == 0) ? oq0[nt][m2] : (f32x4){0.f, 0.f, 0.f, 0.f};
                        if (hf == 1) {
#pragma unroll
                        for (int ks = 0; ks < 4; ++ks)
#pragma unroll
                            for (int m2 = 0; m2 < 2; ++m2)
#pragma unroll
                                for (int nt = 0; nt < 2; ++nt) o[nt][m2] = MFMA16(qa[m2][ks], sB[nt][ks], o[nt][m2]);
                        }
#pragma unroll
                        for (int m2 = 0; m2 < 2; ++m2) { const int mt = 2 * hf + m2; const f32x4 ev = EVL(mt);
#pragma unroll
                            for (int nt = 0; nt < 2; ++nt) o[nt][m2] = ev * o[nt][m2];
#pragma unroll
                            for (int k2 = 0; k2 < 2; ++k2) { if (k2 == 1 && mt < 2) continue;
                                const bf16x8 iaf = (hf == 0) ? ia[m2] : *(const LAS bf16x8*)(lds + SC_IN + ((mt * 2 + k2) * 64 + lane) * 16);
#pragma unroll
                                for (int nt = 0; nt < 2; ++nt) o[nt][m2] = MFMA16(iaf, vB[nt][k2], o[nt][m2]); }
#pragma unroll
                            for (int nt = 0; nt < 2; ++nt)
#pragma unroll
                                for (int i = 0; i < 4; ++i) OB[(16 * mt + 4 * quad + i) * 136 + 32 * w + 16 * nt + col] = f2bf(o[nt][m2][i]);
                        }
                        SCHED_FENCE();
                    }
                }
                RMARK(3);
                {
                    bf16x8 kt[8][2];
#pragma unroll
                    for (int t = 0; t < 8; ++t)
#pragma unroll
                        for (int k2 = 0; k2 < 2; ++k2) kt[t][k2] = *(const LAS bf16x8*)(lds + SC_KT + ((t * 2 + k2) * 64 + lane) * 16);
#pragma unroll
                    for (int t = 0; t < 8; ++t)
#pragma unroll
                        for (int nt = 0; nt < 2; ++nt) S[nt][t] = S[nt][t] * gam;
                    SCHED_FENCE();
#pragma unroll
                    for (int k2 = 0; k2 < 2; ++k2)
#pragma unroll
                        for (int t = 0; t < 8; ++t)
#pragma unroll
                            for (int nt = 0; nt < 2; ++nt) S[nt][t] = MFMA16(kt[t][k2], vdB[nt][k2], S[nt][t]);
                }
                RMARK(4);
            }
            RAW_BARRIER();
#if defined(PROBE_IDLE) || defined(PROBE_REGION)
#ifdef PROBE_WHOLE
            idle_acc = __builtin_amdgcn_s_memrealtime() - tw0_;
#endif
            if (blockIdx.x == 0 && job == 0) { const unsigned long long tend_ = __builtin_amdgcn_s_memrealtime() + PROBE_IDLE * idle_acc + PROBE_FIXED; while (__builtin_amdgcn_s_memrealtime() < tend_) __builtin_amdgcn_s_sleep(8); }
#endif
            { const int col = lane & 15, quad = lane >> 4;
#pragma unroll
              for (int nt = 0; nt < 2; ++nt)
#pragma unroll
                for (int t = 0; t < 8; ++t)
#pragma unroll
                    for (int i = 0; i < 4; ++i) sout[(size_t)(16 * t + 4 * quad + i) * 128 + 32 * w + 16 * nt + col] = S[nt][t][i]; }
        } else {
            const int nl = nsteps - 1;
#define CLAMPN(x) ((x) < nl ? (x) : nl)
            if (w < 6) {
                int st = tid - 256; asm volatile("" : "+v"(st));
                u32x4 pf[40]; float pfs0 = 0.f, pfs1 = 0.f; unsigned tch[6] = {0u, 0u, 0u, 0u, 0u, 0u}, tacc = 0u;
#define ST_TOUCH(n) do { const size_t R0_ = Rbase + (size_t)64 * (n); const int uid_ = uid0 + ustep * (n); \
                    _Pragma("unroll") for (int i_ = 0; i_ < 6; ++i_) { const int L_ = st + 128 * i_; const unsigned char* p_; \
                        if (L_ < 512) { const int sec_ = L_ >> 7, idx_ = L_ & 127; p_ = (const unsigned char*)(DNP + (R0_ + (idx_ >> 1)) * 4096 + sec_ * 1024 + h * 128 + (idx_ & 1) * 64); } \
                        else if (L_ < 640) p_ = TBI + (size_t)uid_ * 16384 + (size_t)(L_ - 512) * 128; \
                        else p_ = KTG + (size_t)uid_ * 16384 + (size_t)(L_ - 640) * 128; \
                        tch[i_] = *(const unsigned*)p_; } } while (0)
#define ST_PREFETCH(n) do { const size_t R0_ = Rbase + (size_t)64 * (n); const int uid_ = uid0 + ustep * (n); \
                    _Pragma("unroll") for (int i_ = 0; i_ < 8; ++i_) { const int id_ = st + 128 * i_, rr_ = id_ >> 4, c16_ = id_ & 15; const bool ok_ = rr_ < nv; \
                        const bf16* src_ = DNP + (R0_ + (ok_ ? rr_ : 0)) * 4096 + h * 128 + 8 * c16_; \
                        const u32x4 k_ = *(const u32x4*)(src_ + 1024); pf[i_] = ok_ ? k_ : zero4(); \
                        pf[24 + i_] = *(const u32x4*)(KTG + (size_t)uid_ * 16384 + (size_t)id_ * 16); } \
                    _Pragma("unroll") for (int i_ = 0; i_ < 4; ++i_) { pf[32 + i_] = *(const u32x4*)(TBI + (size_t)uid_ * 16384 + (size_t)(st + 128 * i_) * 16); pf[36 + i_] = *(const u32x4*)(TBI + (size_t)uid_ * 16384 + 8192 + (size_t)(st + 128 * i_) * 16); } \
                    pfs0 = SCAL[(size_t)uid_ * 256 + st]; pfs1 = SCAL[(size_t)uid_ * 256 + 128 + st]; } while (0)
#define ST_WRITE() do { \
                    _Pragma("unroll") for (int i = 0; i < 8; ++i) { const int id = st + 128 * i, rr = id >> 4, c16 = id & 15; const int off = rr * 272 + c16 * 16; \
                        *(LAS u32x4*)(lds + SC_K + off) = pf[i]; \
                        *(LAS u32x4*)(lds + SC_KT + id * 16) = pf[24 + i]; } \
                    _Pragma("unroll") for (int i = 0; i < 4; ++i) { *(LAS u32x4*)(lds + SC_TB + (st + 128 * i) * 16) = pf[32 + i]; *(LAS u32x4*)(lds + SC_IN + (st + 128 * i) * 16) = pf[36 + i]; } \
                    *(LAS float*)(lds + SC_SC + st * 4) = pfs0; *(LAS float*)(lds + SC_SC + (128 + st) * 4) = pfs1; } while (0)
                ST_PREFETCH(0);
                for (int nn = 0; nn < nsteps; ++nn) {
                    if (midbar && nn == 17) xcd_barrier(xbar);
                    asm volatile("" : "+v"(st));
                    RAW_BARRIER();
                    ST_WRITE();
                    RAW_BARRIER();
                    tacc ^= (tch[0] ^ tch[1]) ^ (tch[2] ^ tch[3]) ^ (tch[4] ^ tch[5]);
                    ST_PREFETCH(CLAMPN(nn + 1));
                }
                RAW_BARRIER();
                tacc ^= (tch[0] ^ tch[1]) ^ (tch[2] ^ tch[3]) ^ (tch[4] ^ tch[5]) ^ pf[0][0] ^ pf[39][3];
                if (tacc == 0x9e3779b9u && nv == 77) ((unsigned*)a.ws)[8192 + st] = tacc;
#undef ST_TOUCH
#undef ST_PREFETCH
#undef ST_WRITE
            } else {
                int et = tid - 384; asm volatile("" : "+v"(et));
                u32x4 zr[8], qv[16];
#define EP_QV_PREFETCH(n) do { const size_t R0_ = Rbase + (size_t)64 * (n); \
                    _Pragma("unroll") for (int i_ = 0; i_ < 8; ++i_) { const int id_ = et + 128 * i_, rr_ = id_ >> 4, c16_ = id_ & 15; const bool ok_ = rr_ < nv; \
                        const bf16* src_ = DNP + (R0_ + (ok_ ? rr_ : 0)) * 4096 + h * 128 + 8 * c16_; \
                        const u32x4 q_ = *(const u32x4*)(src_), v_ = *(const u32x4*)(src_ + 2048); qv[i_] = ok_ ? q_ : zero4(); qv[8 + i_] = ok_ ? v_ : zero4(); } } while (0)
#define EP_QV_WRITE() do { \
                    _Pragma("unroll") for (int i = 0; i < 8; ++i) { const int id = et + 128 * i, rr = id >> 4, c16 = id & 15; const int off = rr * 272 + c16 * 16; \
                        *(LAS u32x4*)(lds + SC_Q + off) = qv[i]; *(LAS u32x4*)(lds + SC_V + off) = qv[8 + i]; } } while (0)
#define EP_ZLOAD(n) do { const bool okz_ = (et >> 1) < nv; const bf16* zs_ = DNP + (Rbase + (size_t)64 * (n) + (okz_ ? (et >> 1) : 0)) * 4096 + 3072 + h * 128 + 64 * (et & 1); \
                      _Pragma("unroll") for (int j_ = 0; j_ < 8; ++j_) zr[j_] = *(const u32x4*)(zs_ + 8 * j_); } while (0)
#define EP_RUN(n) do { const LAS bf16* OB_ = (const LAS bf16*)(lds + SC_OB + ((n) & 1) * SC_OBSZ) + (et >> 1) * 136 + 64 * (et & 1); \
                    u32x4 ov_[8]; float ss_ = 0.f; \
                    _Pragma("unroll") for (int j_ = 0; j_ < 8; ++j_) { ov_[j_] = *(const LAS u32x4*)(OB_ + 8 * j_); \
                        _Pragma("unroll") for (int e_ = 0; e_ < 4; ++e_) { const float x0_ = bflo(ov_[j_][e_]), x1_ = bfhi(ov_[j_][e_]); ss_ += x0_ * x0_ + x1_ * x1_; } } \
                    ss_ += __shfl_xor(ss_, 1); \
                    const float rs_ = frsq(ss_ * (1.f / 128.f) + EPS); \
                    bf16* od_ = ((et >> 1) < nv) ? OG + (Rbase + (size_t)64 * (n) + (et >> 1)) * 1024 + h * 128 + 64 * (et & 1) : (bf16*)(a.ws + 65536 + (size_t)tid * 128); \
                    _Pragma("unroll") for (int j_ = 0; j_ < 8; ++j_) { u32x4 o_; \
                        _Pragma("unroll") for (int e_ = 0; e_ < 4; ++e_) o_[e_] = pk2(bflo(ov_[j_][e_]) * rs_ * bflo(zr[j_][e_]), bfhi(ov_[j_][e_]) * rs_ * bfhi(zr[j_][e_])); \
                        *(u32x4*)(od_ + 8 * j_) = o_; } } while (0)
                EP_QV_PREFETCH(0);
                {
                    RAW_BARRIER(); EP_QV_WRITE(); RAW_BARRIER();
                    EP_QV_PREFETCH(CLAMPN(1));
                    EP_ZLOAD(0);
                }
                for (int nn = 1; nn < nsteps; ++nn) {
                    if (midbar && nn == 17) xcd_barrier(xbar);
                    asm volatile("" : "+v"(et));
                    RAW_BARRIER();
                    EP_QV_WRITE();
                    RAW_BARRIER();
                    EP_QV_PREFETCH(CLAMPN(nn + 1));
                    EP_RUN(nn - 1);
                    EP_ZLOAD(nn);
                }
                RAW_BARRIER();
                EP_RUN(nsteps - 1);
#undef EP_ZLOAD
#undef EP_QV_PREFETCH
#undef EP_QV_WRITE
#undef EP_RUN
            }
#undef CLAMPN
        }
        __syncthreads();
    }
}

DI void final_norm_phase(const Args& a, int lane, int w) {
    const bf16* XG = (const bf16*)(a.ws + WS_XN); const float* ss2 = (const float*)(a.ws + WS_SS2);
    const int gw = blockIdx.x * 8 + w, NGW = gridDim.x * 8;
    for (int m0 = gw; m0 < MROWS; m0 += 4 * NGW) {
        u32x4 v[4][2]; float rs[4];
#pragma unroll
        for (int r = 0; r < 4; ++r) { const int m = m0 + r * NGW; const int mc = m < MROWS ? m : m0;
            rs[r] = frsq(ss2[mc] * (1.f / DM) + EPS);
            v[r][0] = *(const u32x4*)(XG + (size_t)mc * DM + 8 * lane); v[r][1] = *(const u32x4*)(XG + (size_t)mc * DM + 512 + 8 * lane); }
#pragma unroll
        for (int r = 0; r < 4; ++r) { const int m = m0 + r * NGW; if (m < MROWS) { float* yr = a.out + (size_t)m * DM;
#pragma unroll
            for (int hlf = 0; hlf < 2; ++hlf) { const u32x4 x = v[r][hlf];
                *(f32x4*)(yr + 512 * hlf + 8 * lane) = (f32x4){bflo(x.x) * rs[r], bfhi(x.x) * rs[r], bflo(x.y) * rs[r], bfhi(x.y) * rs[r]};
                *(f32x4*)(yr + 512 * hlf + 8 * lane + 4) = (f32x4){bflo(x.z) * rs[r], bfhi(x.z) * rs[r], bflo(x.w) * rs[r], bfhi(x.w) * rs[r]}; } } }
    }
}

#ifndef N_PHASES
#define N_PHASES 10
#endif
__global__ void __launch_bounds__(512, 2) mega_fwd(Args a, int ph_lo, int ph_hi, int coop) {
    extern __shared__ __attribute__((aligned(16))) unsigned char lds_raw[];
    LAS unsigned char* lds = (LAS unsigned char*)lds_raw;
    const int tid = threadIdx.x, lane = tid & 63, w = __builtin_amdgcn_readfirstlane(tid >> 6);
    cg::grid_group grid = cg::this_grid();
    unsigned* barw = (unsigned*)a.ws;
    volatile LAS unsigned* bst = (volatile LAS unsigned*)(lds + LDS_BYTES - 64);
    if (tid < 16) bst[tid] = 0u;
    __syncthreads();
    XcdBarrier xbar = xcd_barrier_post(barw, bst);
    bf16* XN = (bf16*)(a.ws + WS_XN); bf16* BIG = (bf16*)(a.ws + WS_BIG); bf16* OG = (bf16*)(a.ws + WS_OG);
    float* ss1 = (float*)(a.ws + WS_SS1); float* ss2 = (float*)(a.ws + WS_SS2);
#ifndef PH_MASK
#define PH_MASK 0x3ff
#endif
#define IN(k) (((PH_MASK >> (k)) & 1) && ph_lo <= (k) && (k) < ph_hi)
#define SEAM(k) do { if (coop && IN(k) && IN((k) + 1)) { if (coop == 2) grid.sync(); else xcd_barrier(xbar); } } while (0)
#ifndef REP_MASK
#define REP_MASK 0
#endif
#define REP(k) for (int rep_ = 0; rep_ < 1 + ((REP_MASK >> (k)) & 1); ++rep_)
#ifdef PROBE_PHASE
    unsigned long long tph_ = 0;
#define PH_BEGIN(k) do { if ((k) == PROBE_PHASE) tph_ = __builtin_amdgcn_s_memrealtime(); } while (0)
#define PH_END(k) do { if ((k) == PROBE_PHASE && blockIdx.x == PROBE_WG) { __syncthreads(); const unsigned long long now_ = __builtin_amdgcn_s_memrealtime(); const unsigned long long tend_ = now_ + (now_ - tph_); while (__builtin_amdgcn_s_memrealtime() < tend_) __builtin_amdgcn_s_sleep(8); } } while (0)
#else
#define PH_BEGIN(k) do { } while (0)
#define PH_END(k) do { } while (0)
#endif
    PH_BEGIN(0);
    if (IN(0)) REP(0) { p0_prologue(a, lds, tid, lane, w); }
    PH_END(0);
    SEAM(0);
#ifdef EXTRA_SYNCS
    if (coop) for (int es_ = 0; es_ < EXTRA_SYNCS; ++es_) grid.sync();
#endif
    PH_BEGIN(1);
    if (IN(1)) REP(1) { pg8::Gemm g{XN, (const bf16*)(a.ws + WS_W1T), MROWS, 2560, 1024}; pg8::StaticOrder S; S.init(MROWS, 2560, gridDim.x, blockIdx.x);
        EpiQKVG E{BIG, a.out}; pg8::gemm_phase<EpiQKVG, pg8::StaticOrder, true, true>(lds, g, S, E); }
    PH_END(1);
    SEAM(1);
    PH_BEGIN(2);
    if (IN(2)) REP(2) { attn_phase(lds, BIG, a.in[2], a.in[3], a.in[9], OG, tid, lane, w); }
    PH_END(2);
    SEAM(2);
    PH_BEGIN(3);
    if (IN(3)) { pg8::Gemm g{OG, (const bf16*)(a.ws + WS_WO1T), MROWS, 1024, 1024}; pg8::StaticOrder S; S.init(MROWS, 1024, gridDim.x, blockIdx.x);
        EpiRes E{a.in[0], a.in[1], nullptr, XN, a.in[6] + 1024, ss1, nullptr, (bf16*)a.out};     pg8::gemm_phase<EpiRes, pg8::StaticOrder, true, true>(lds, g, S, E); }
    PH_END(3);
    SEAM(3);
    PH_BEGIN(4);
    if (IN(4)) REP(4) { pg8::Gemm g{XN, (const bf16*)(a.ws + WS_W2T), MROWS, 4352, 1024}; pg8::StaticOrder S; S.init(MROWS, 4352, gridDim.x, blockIdx.x);
        EpiDN E{BIG, (bf16*)(a.ws + WS_HALO), (float*)(a.ws + WS_BA), ss1, a.out, a.in[15]}; pg8::gemm_phase<EpiDN, pg8::StaticOrder, true, true>(lds, g, S, E); }
    PH_END(4);
    SEAM(4);
    PH_BEGIN(5);
    if (IN(5)) { dn_pre_phase(a, lane, w); }
    PH_END(5);
    SEAM(5);
    PH_BEGIN(6);
    if (IN(6)) REP(6) { dn_prep_phase(a, lds, lane, w); }
    PH_END(6);
    SEAM(6);
    PH_BEGIN(7);
    if (IN(7)) {
        if (blockIdx.x < 64) dn_scan_phase(a, lds, tid, lane, w, xbar, (int)blockIdx.x, 64, true, 256);
        else {
            dn_scan_phase(a, lds, tid, lane, w, xbar, (int)blockIdx.x, 320, false, 192);
            xcd_barrier(xbar);
            if (blockIdx.x >= 240) { pg8::Gemm g{OG, (const bf16*)(a.ws + WS_WO2T), MROWS, 1024, 1024}; SampleOrder S{(int)blockIdx.x - 240};
                EpiRes E{a.in[0], nullptr, nullptr, XN, a.in[7], ss2, (const bf16*)a.out, nullptr}; pg8::gemm_phase<EpiRes, SampleOrder, true, true>(lds, g, S, E); }
        }
    }
    PH_END(7);
    SEAM(7);
    PH_BEGIN(8);
    if (IN(8)) { pg8::Gemm g{OG, (const bf16*)(a.ws + WS_WO2T), MP, 1024, 1024}; pg8::StaticOrder S; S.init(MP, 1024, gridDim.x, blockIdx.x);
        EpiRes E{a.in[0], nullptr, nullptr, XN, a.in[7], ss2, (const bf16*)a.out, nullptr}; pg8::gemm_phase<EpiRes, pg8::StaticOrder, true, true>(lds, g, S, E); }
    PH_END(8);
    SEAM(8);
    PH_BEGIN(9);
    if (IN(9)) { final_norm_phase(a, lane, w); }
    PH_END(9);
#undef IN
#undef SEAM
}

#ifndef MULTI_LAUNCH
#define MULTI_LAUNCH 0
#endif
extern "C" void kernel_launch(void* const* d_in, const int* in_sizes, int n_in, void* d_out, int out_size, void* d_ws, size_t ws_size, hipStream_t stream) {
    static int grid = 0;
    if (grid == 0) {
        int dev = 0, cus = 0, per_cu = 0;
        if (n_in != 17 || ws_size < WS_END) { fprintf(stderr, "kernel_launch: unexpected n_in %d / ws_size %zu\n", n_in, ws_size); grid = -1; return; }
        if (hipGetDevice(&dev) != hipSuccess || hipDeviceGetAttribute(&cus, hipDeviceAttributeMultiprocessorCount, dev) != hipSuccess) { grid = -1; return; }
        if (hipFuncSetAttribute((const void*)mega_fwd, hipFuncAttributeMaxDynamicSharedMemorySize, LDS_BYTES) != hipSuccess) { fprintf(stderr, "kernel_launch: hipFuncSetAttribute failed\n"); grid = -1; return; }
        if (hipOccupancyMaxActiveBlocksPerMultiprocessor(&per_cu, (const void*)mega_fwd, 512, LDS_BYTES) != hipSuccess || per_cu < 1) { fprintf(stderr, "kernel_launch: occupancy query gave %d\n", per_cu); per_cu = 1; }
        (void)hipGetLastError();
        grid = cus * (per_cu > 1 ? 1 : per_cu);
        if (grid < 64) grid = 64;
    }
    if (grid < 0) return;
    Args a{};
    for (int i = 0; i < 17; ++i) a.in[i] = (const float*)d_in[i];
    a.out = (float*)d_out; a.ws = (unsigned char*)d_ws;
#if MULTI_LAUNCH
    for (int p = 0; p < N_PHASES; ++p) { int lo = p, hi = p + 1, coop = 0; hipLaunchKernelGGL(mega_fwd, dim3(grid), dim3(512), LDS_BYTES, stream, a, lo, hi, coop); }
#else
    if (hipMemsetAsync(d_ws, 0, 16384, stream) != hipSuccess) { fprintf(stderr, "kernel_launch: memset of the barrier words failed\n"); return; }
    int lo = 0, hi = N_PHASES, coop = 1;
    void* args[] = {&a, &lo, &hi, &coop};
    hipError_t e = hipLaunchCooperativeKernel((const void*)mega_fwd, dim3(grid), dim3(512), args, LDS_BYTES, stream);
    if (e != hipSuccess) fprintf(stderr, "kernel_launch: cooperative launch failed: %s (grid %d)\n", hipGetErrorString(e), grid);
#endif
}
```
